# Optimizing an MI355X kernel written in HIP

```python
import math
import jax, jax.numpy as jnp
from jax import lax
import numpy as np

D_MODEL = 1024
BATCH = 4
SEQ = 4096
DEPTH = 1
DEC_BATCH = 16
DEC_SEQ = 4096
PAST_LEN = 128

GLA_HEADS = 4
GLA_DK = 64
GLA_DV = 128
GLA_QK = GLA_HEADS * GLA_DK
GLA_V = GLA_HEADS * GLA_DV
GLA_GATE_RANK = 16
GLA_GATE_NORM = 16.0
GLA_CHUNK = 64
SSM_HEAD_DIM = 64
SSM_INNER = 1024
SSM_HEADS = SSM_INNER // SSM_HEAD_DIM
SSM_GROUPS = 4
SSM_HPG = SSM_HEADS // SSM_GROUPS
SSM_STATE = 64
SSM_CONV = 5
SSM_CHUNK = 128
SSM_XBC = SSM_INNER + 2 * SSM_GROUPS * SSM_STATE
D_FF = ((8 * D_MODEL // 3 + 255) // 256) * 256
EPS = 1e-6
IN_SIZES = (GLA_QK, GLA_QK, GLA_V, GLA_V, GLA_GATE_RANK, GLA_GATE_RANK,
            SSM_INNER, SSM_XBC, SSM_HEADS, SSM_HEADS, D_MODEL, D_MODEL)
IN_COLS = sum(IN_SIZES)

kernel_name = "bidir_gla_ssd_gated_hybrid"


def rmsnorm(x, w):
    xf = x.astype(jnp.float32)
    xf = xf * lax.rsqrt(jnp.mean(xf * xf, axis=-1, keepdims=True) + EPS)
    return (xf * w.astype(jnp.float32)).astype(x.dtype)


def split_cols(t, sizes):
    idx = np.cumsum(np.array(sizes))[:-1].tolist()
    return jnp.split(t, idx, axis=-1)


def bidir(fn, fwd_args, bwd_args):
    rev = lambda t: jnp.flip(t, axis=1)
    return fn(*fwd_args, True) + rev(fn(*[rev(a) for a in bwd_args], False))


def gla_scan(q, k, v, log_g, inclusive):
    b, L, h, dk = q.shape
    dv = v.shape[-1]
    Q = GLA_CHUNK
    c = L // Q
    q = q.reshape(b, c, Q, h, dk)
    k = k.reshape(b, c, Q, h, dk)
    v = v.reshape(b, c, Q, h, dv)
    g_cs = jnp.cumsum(log_g.reshape(b, c, Q, h, dk), axis=2)
    q_dec = q * jnp.exp(g_cs)
    att = jnp.einsum('bclhd,bcshd->bchls', q_dec, k * jnp.exp(-g_cs))
    mask = jnp.tril(jnp.ones((Q, Q), dtype=bool), 0 if inclusive else -1)
    att = jnp.where(mask, att, 0.0)
    o = jnp.einsum('bchls,bcshv->bclhv', att, v)
    g_end = g_cs[:, :, -1]
    states = jnp.einsum('bclhd,bclhv->bchdv', k * jnp.exp(g_end[:, :, None] - g_cs), v)

    def step(s, inp):
        dec, st = inp
        return dec[..., None] * s + st, s

    _, s_in = lax.scan(step, jnp.zeros((b, h, dk, dv), q.dtype),
                       (jnp.moveaxis(jnp.exp(g_end), 1, 0), jnp.moveaxis(states, 1, 0)))
    o = o + jnp.einsum('bclhd,cbhdv->bclhv', q_dec, s_in)
    return o.reshape(b, L, h, dv)


def ssd_scan(xh, log_a, bm, cm, inclusive):
    b, L, g, j, p = xh.shape
    n = bm.shape[-1]
    Q = SSM_CHUNK
    c = L // Q
    xh = xh.reshape(b, c, Q, g, j, p)
    bm = bm.reshape(b, c, Q, g, n)
    cm = cm.reshape(b, c, Q, g, n)
    a_cs = jnp.cumsum(log_a.reshape(b, c, Q, g, j), axis=2)
    a_t = jnp.moveaxis(a_cs, 2, -1)
    mask = jnp.tril(jnp.ones((Q, Q), dtype=bool), 0 if inclusive else -1)
    decay = jnp.exp(jnp.where(mask, a_t[..., :, None] - a_t[..., None, :], -jnp.inf))
    cb = jnp.einsum('bclgn,bcsgn->bcgls', cm, bm)
    y = jnp.einsum('bcgls,bcgjls,bcsgjp->bclgjp', cb, decay, xh)
    a_end = a_cs[:, :, -1]
    states = jnp.einsum('bclgn,bclgj,bclgjp->bcgjpn', bm, jnp.exp(a_end[:, :, None] - a_cs), xh)

    def step(s, inp):
        dec, st = inp
        return dec[..., None, None] * s + st, s

    _, s_in = lax.scan(step, jnp.zeros((b, g, j, p, n), xh.dtype),
                       (jnp.moveaxis(jnp.exp(a_end), 1, 0), jnp.moveaxis(states, 1, 0)))
    y = y + jnp.einsum('bclgn,cbgjpn,bclgj->bclgjp', cm, s_in, jnp.exp(a_cs))
    return y.reshape(b, L, g, j, p)


def mixer(u, w_in, gla_up_f, gla_bias_f, gla_up_b, gla_bias_b, gla_norm_w, conv_w, conv_b,
          dt_bias_f, dt_bias_b, a_log_f, a_log_b, d_skip, ssm_norm_w, w_br_gla, w_br_ssm, w_out):
    b, L, _ = u.shape
    proj = (u @ w_in).astype(jnp.float32)
    q, k, v, og, rf, rb, z, xbc, dtf, dtb, gate_gla, gate_ssm = split_cols(proj, IN_SIZES)

    q = q.reshape(b, L, GLA_HEADS, GLA_DK) * (GLA_DK ** -0.5)
    k = k.reshape(b, L, GLA_HEADS, GLA_DK)
    v = v.reshape(b, L, GLA_HEADS, GLA_DV)
    lg_f = (jax.nn.log_sigmoid(rf @ gla_up_f + gla_bias_f) / GLA_GATE_NORM).reshape(b, L, GLA_HEADS, GLA_DK)
    lg_b = (jax.nn.log_sigmoid(rb @ gla_up_b + gla_bias_b) / GLA_GATE_NORM).reshape(b, L, GLA_HEADS, GLA_DK)
    lg_f = lg_f.astype(jnp.float32)
    lg_b = lg_b.astype(jnp.float32)
    o_gla = bidir(gla_scan, (q, k, v, lg_f), (q, k, v, lg_b))
    o_gla = rmsnorm(o_gla, gla_norm_w).reshape(b, L, GLA_V) * jax.nn.silu(og)

    xbc = lax.conv_general_dilated(
        xbc, conv_w[:, None, :].astype(jnp.float32),
        window_strides=(1,),
        padding=((SSM_CONV // 2, SSM_CONV // 2),),
        dimension_numbers=('NWC', 'WIO', 'NWC'),
        feature_group_count=SSM_XBC)
    xbc = jax.nn.silu(xbc + conv_b)
    xs, bm, cm = split_cols(xbc, (SSM_INNER, SSM_GROUPS * SSM_STATE, SSM_GROUPS * SSM_STATE))
    xs = xs.reshape(b, L, SSM_GROUPS, SSM_HPG, SSM_HEAD_DIM)
    bm = bm.reshape(b, L, SSM_GROUPS, SSM_STATE)
    cm = cm.reshape(b, L, SSM_GROUPS, SSM_STATE)

    def dir_inputs(dt_raw, dt_bias, a_log):
        dt = jax.nn.softplus(dt_raw + dt_bias).astype(jnp.float32).reshape(b, L, SSM_GROUPS, SSM_HPG)
        a = -jnp.exp(a_log.astype(jnp.float32)).reshape(SSM_GROUPS, SSM_HPG)
        return (xs * dt[..., None], dt * a, bm, cm)

    y = bidir(ssd_scan, dir_inputs(dtf, dt_bias_f, a_log_f), dir_inputs(dtb, dt_bias_b, a_log_b))
    y = y + d_skip.reshape(SSM_GROUPS, SSM_HPG)[:, :, None] * xs
    y = rmsnorm(y.reshape(b, L, SSM_INNER) * jax.nn.silu(z), ssm_norm_w)

    m = jax.nn.sigmoid(gate_gla) * (o_gla @ w_br_gla) + jax.nn.sigmoid(gate_ssm) * (y @ w_br_ssm)
    return (m @ w_out).astype(u.dtype)


def swiglu(u, w_gate, w_up, w_down):
    return (jax.nn.silu(u @ w_gate) * (u @ w_up)) @ w_down


def setup_inputs(seed: int = 0) -> dict:
    key = jax.random.key(seed)
    ks = iter(jax.random.split(key, 32))
    f32 = jnp.float32

    def nrm(shape, scale):
        return jax.random.normal(next(ks), shape, f32) * scale

    def gain(shape):
        return 1.0 + 0.02 * jax.random.normal(next(ks), shape, f32)

    def dt_bias(shape):
        dt = jnp.exp(jax.random.uniform(next(ks), shape, f32, math.log(1e-3), math.log(1e-1)))
        return dt + jnp.log(-jnp.expm1(-dt))

    def a_log(shape):
        return jnp.log(jax.random.uniform(next(ks), shape, f32, 1.0, 16.0))

    Dp = DEPTH
    return {
        "x_prompt": jax.random.normal(next(ks), (BATCH, SEQ, D_MODEL), f32),
        "x_sample": jax.random.normal(next(ks), (DEC_BATCH, DEC_SEQ, D_MODEL), f32),
        "norm_mix_w": gain((Dp, D_MODEL)),
        "w_in": nrm((Dp, D_MODEL, IN_COLS), D_MODEL ** -0.5),
        "gla_up_f": nrm((Dp, GLA_GATE_RANK, GLA_QK), GLA_GATE_RANK ** -0.5),
        "gla_bias_f": nrm((Dp, GLA_QK), 0.1),
        "gla_up_b": nrm((Dp, GLA_GATE_RANK, GLA_QK), GLA_GATE_RANK ** -0.5),
        "gla_bias_b": nrm((Dp, GLA_QK), 0.1),
        "gla_norm_w": gain((Dp, GLA_DV)),
        "conv_w": nrm((Dp, SSM_CONV, SSM_XBC), SSM_CONV ** -0.5),
        "conv_b": nrm((Dp, SSM_XBC), 0.02),
        "dt_bias_f": dt_bias((Dp, SSM_HEADS)),
        "dt_bias_b": dt_bias((Dp, SSM_HEADS)),
        "a_log_f": a_log((Dp, SSM_HEADS)),
        "a_log_b": a_log((Dp, SSM_HEADS)),
        "d_skip": gain((Dp, SSM_HEADS)),
        "ssm_norm_w": gain((Dp, SSM_INNER)),
        "w_br_gla": nrm((Dp, GLA_V, D_MODEL), GLA_V ** -0.5),
        "w_br_ssm": nrm((Dp, SSM_INNER, D_MODEL), SSM_INNER ** -0.5),
        "w_out": nrm((Dp, D_MODEL, D_MODEL), D_MODEL ** -0.5),
        "norm_ffn_w": gain((Dp, D_MODEL)),
        "w_ffn_gate": nrm((Dp, D_MODEL, D_FF), D_MODEL ** -0.5),
        "w_ffn_up": nrm((Dp, D_MODEL, D_FF), D_MODEL ** -0.5),
        "w_ffn_down": nrm((Dp, D_FF, D_MODEL), D_FF ** -0.5),
        "norm_final_w": gain((D_MODEL,)),
    }


def reference(x_prompt, x_sample, norm_mix_w, w_in, gla_up_f, gla_bias_f, gla_up_b, gla_bias_b,
              gla_norm_w, conv_w, conv_b, dt_bias_f, dt_bias_b, a_log_f, a_log_b, d_skip,
              ssm_norm_w, w_br_gla, w_br_ssm, w_out, norm_ffn_w, w_ffn_gate, w_ffn_up,
              w_ffn_down, norm_final_w):
    def run(x):
        for l in range(DEPTH):
            u = rmsnorm(x, norm_mix_w[l])
            x = x + mixer(u, w_in[l], gla_up_f[l], gla_bias_f[l], gla_up_b[l], gla_bias_b[l],
                          gla_norm_w[l], conv_w[l], conv_b[l], dt_bias_f[l], dt_bias_b[l],
                          a_log_f[l], a_log_b[l], d_skip[l], ssm_norm_w[l], w_br_gla[l],
                          w_br_ssm[l], w_out[l])
            x = x + swiglu(rmsnorm(x, norm_ffn_w[l]), w_ffn_gate[l], w_ffn_up[l], w_ffn_down[l]).astype(x.dtype)
        return rmsnorm(x, norm_final_w)

    y_prompt = run(x_prompt)
    y_sample = run(x_sample)
    return (y_prompt, y_sample)
```

```cpp
#include <hip/hip_runtime.h>
#include <hip/hip_cooperative_groups.h>
#include <cstdio>
namespace cg = cooperative_groups;

namespace pg8 {
#define PG8_LAS __attribute__((address_space(3)))
typedef unsigned short bf16_t;
typedef short bf16x8 __attribute__((ext_vector_type(8)));
typedef float f32x4 __attribute__((ext_vector_type(4)));
typedef unsigned u32x4 __attribute__((ext_vector_type(4)));
constexpr int BM = 256, BK = 64, HALF = 128, HTB = HALF * BK * 2  , STAGE_BYTES = 8 * HTB, NXCD = 8, WGM = 8;

__host__ __device__ __forceinline__ int lds_byte(int r, int c) { const int st = (r >> 4) * 2 + (c >> 5), rr = r & 15, cc = c & 31, ob = rr * 64 + cc * 2; return st * 1024 + (ob ^ (((ob >> 9) & 1) << 5)); }
__host__ __device__ __forceinline__ void stage_rc(int b, int& R, int& C) { const int st = b / 1024, sb = b % 1024, swz = sb ^ (((sb >> 9) & 1) << 5); R = (st >> 1) * 16 + swz / 64; C = (st & 1) * 32 + (swz % 64) / 2; }
__host__ __device__ __forceinline__ int perm32(int rho) { const int n = rho >> 4, i = rho & 15; return 8 * (i >> 2) + 4 * n + (i & 3); }

struct Unit { int pm, pn; };
struct Gemm { const bf16_t* A; const bf16_t* Bt; int M, N, K; };

struct StaticOrder {
    int nM, nN, nwg, G, c;
    __host__ __device__ void init(int M, int N, int G_, int c_) { nM = M / BM; nN = N / BM; nwg = nM * nN; G = G_; c = c_; }
    __host__ __device__ bool next(int i, Unit& u) const {
        const long L = (long)i * G + c; if (L >= nwg) return false;
        int wgid = (int)L; { const int q = nwg / NXCD, r = nwg % NXCD, xcd = wgid % NXCD, off = wgid / NXCD; wgid = (xcd < r ? xcd * (q + 1) : r * (q + 1) + (xcd - r) * q) + off; }
        const int nig = WGM * nN, gid = wgid / nig, fm = gid * WGM, gsz = (nM - fm) < WGM ? (nM - fm) : WGM;
        u.pm = fm + ((wgid % nig) % gsz); u.pn = (wgid % nig) / gsz; return true;
    }
    __device__ __forceinline__ void a_ready(const Unit&) const {}
    __device__ __forceinline__ void done(const Unit&) const {}
};
typedef float f32x2_t_ __attribute__((ext_vector_type(2)));
typedef __bf16 bf16x2_t_ __attribute__((ext_vector_type(2)));
__device__ __forceinline__ unsigned cvt_pk_bf16(float lo, float hi) { const f32x2_t_ v = {lo, hi}; const bf16x2_t_ b = __builtin_convertvector(v, bf16x2_t_); return __builtin_bit_cast(unsigned, b); }
template <class Epi, class Sched, bool ALIGN_EPI = false, bool SP2 = false>
__device__ __forceinline__ void gemm_phase(PG8_LAS unsigned char* lds, const Gemm g, const Sched& S, const Epi& E) {
    int tid_ = threadIdx.x; asm volatile("" : "+v"(tid_)); const int tid = tid_, wid = __builtin_amdgcn_readfirstlane(tid >> 6), lane = tid & 63, wr = wid >> 2, wc = wid & 3, fr = lane & 15, fq = lane >> 4;
    const int K = g.K, nt = K / BK;
    unsigned voffA[2], voffB[2];
#pragma unroll
    for (int i = 0; i < 2; ++i) { int R, C; stage_rc(tid * 16 + i * 8192, R, C); const int Rb = Epi::PERM ? ((R & ~31) + perm32(R & 31)) : R;
        voffA[i] = (unsigned)(R * K + C) * 2u; voffB[i] = (unsigned)(Rb * K + C) * 2u; }
    const size_t kstep = (size_t)(BK * 2);
    const size_t hstep = (size_t)HALF * K * 2;
    const size_t tstep = 2 * hstep;
    const unsigned ldsw = (unsigned)wid * 1024u;
    const int aoff = lds_byte(wr * 64 + fr, fq * 8), boff = lds_byte(wc * 32 + fr, fq * 8);
#define PG8_SA(b, h) (((b) * 2 + (h)) * HTB)
#define PG8_SB(b, h) ((4 + (b) * 2 + (h)) * HTB)
#define PG8_STAGE(bufoff, gbase, voff) do { _Pragma("unroll") for (int _i = 0; _i < 2; ++_i) \
        __builtin_amdgcn_global_load_lds((const unsigned*)((const char*)(gbase) + (voff)[_i]), (PG8_LAS unsigned*)(lds + (bufoff) + ldsw + _i * 8192), 16, 0, 0); } while (0)
#define PG8_LDA(dst, b, h) do { _Pragma("unroll") for (int m = 0; m < 4; ++m) _Pragma("unroll") for (int k = 0; k < 2; ++k) dst[m][k] = *(const PG8_LAS bf16x8*)(lds + PG8_SA(b, h) + aoff + m * 2048 + k * 1024); } while (0)
#define PG8_LDB(dst, b, h) do { _Pragma("unroll") for (int n = 0; n < 2; ++n) _Pragma("unroll") for (int k = 0; k < 2; ++k) dst[n][k] = *(const PG8_LAS bf16x8*)(lds + PG8_SB(b, h) + boff + n * 2048 + k * 1024); } while (0)
#define PG8_MMA(ai, bj, At, Bt) do { __builtin_amdgcn_s_setprio(1); _Pragma("unroll") for (int m = 0; m < 4; ++m) _Pragma("unroll") for (int n = 0; n < 2; ++n) _Pragma("unroll") for (int k = 0; k < 2; ++k) \
        acc[ai][bj][m][n] = __builtin_amdgcn_mfma_f32_16x16x32_bf16(Bt[n][k], At[m][k], acc[ai][bj][m][n], 0, 0, 0); __builtin_amdgcn_s_setprio(0); } while (0)
#define PG8_WAIT_V(n) asm volatile("s_waitcnt vmcnt(" #n ")" ::: "memory")
#define PG8_WAIT_L(n) asm volatile("s_waitcnt lgkmcnt(" #n ")" ::: "memory")
#define PG8_BAR __builtin_amdgcn_s_barrier()
#define PG8_SCHED __builtin_amdgcn_sched_barrier(0)
    Unit cur, nxt; int ui = 0;
    if (!S.next(0, cur)) return;
    f32x4 acc[2][2][4][2];
#pragma unroll
    for (int a = 0; a < 2; ++a)
#pragma unroll
        for (int b = 0; b < 2; ++b)
#pragma unroll
            for (int m = 0; m < 4; ++m)
#pragma unroll
                for (int n = 0; n < 2; ++n) acc[a][b][m][n] = (f32x4){0.f, 0.f, 0.f, 0.f};
    bf16x8 At[4][2], B0[2][2], B1[2][2];
    const char* cA = (const char*)g.A + (size_t)cur.pm * tstep; const char* cB = (const char*)g.Bt + (size_t)cur.pn * tstep;
    S.a_ready(cur);
    if constexpr (SP2) {
        PG8_STAGE(PG8_SB(0, 0), cB, voffB); PG8_STAGE(PG8_SB(0, 1), cB + hstep, voffB); PG8_STAGE(PG8_SA(0, 0), cA, voffA); PG8_STAGE(PG8_SA(0, 1), cA + hstep, voffA);
        if (wr == 1) PG8_BAR;
        PG8_WAIT_V(2); PG8_BAR;
        PG8_STAGE(PG8_SB(1, 0), cB + kstep, voffB); PG8_STAGE(PG8_SA(1, 0), cA + kstep, voffA); PG8_STAGE(PG8_SB(1, 1), cB + hstep + kstep, voffB);
        PG8_WAIT_V(6); PG8_BAR;
    } else {
        PG8_STAGE(PG8_SB(0, 0), cB, voffB); PG8_STAGE(PG8_SA(0, 0), cA, voffA); PG8_STAGE(PG8_SB(0, 1), cB + hstep, voffB); PG8_STAGE(PG8_SA(0, 1), cA + hstep, voffA);
        if (wr == 1) PG8_BAR;
        PG8_WAIT_V(4); PG8_BAR;
        PG8_STAGE(PG8_SB(1, 0), cB + kstep, voffB); PG8_STAGE(PG8_SA(1, 0), cA + kstep, voffA); PG8_STAGE(PG8_SB(1, 1), cB + hstep + kstep, voffB);
        PG8_WAIT_V(6); PG8_BAR;
    }
    for (;;) {
        const bool has_next = S.next(ui + 1, nxt);
        const char* nA = has_next ? (const char*)g.A + (size_t)nxt.pm * tstep : cA; const char* nB = has_next ? (const char*)g.Bt + (size_t)nxt.pn * tstep : cB;
        for (int t = 0; t < nt; t += 2) {
            const bool last = (t == nt - 2);
            const char* a1 = cA + (size_t)(t + 1) * kstep;
            const char* a2 = last ? nA : cA + (size_t)(t + 2) * kstep; const char* b2 = last ? nB : cB + (size_t)(t + 2) * kstep;
            const char* a3 = a2 + kstep; const char* b3 = b2 + kstep;
            if (last && has_next) S.a_ready(nxt);
            if constexpr (SP2) {
            PG8_LDB(B0, 0, 0); PG8_LDB(B1, 0, 1); PG8_SCHED; PG8_LDA(At, 0, 0); PG8_STAGE(PG8_SA(1, 1), a1 + hstep, voffA);
            PG8_WAIT_V(8); PG8_WAIT_L(0); PG8_BAR; PG8_MMA(0, 0, At, B0); PG8_MMA(0, 1, At, B1); PG8_BAR; PG8_SCHED;
            PG8_LDA(At, 0, 1); PG8_STAGE(PG8_SB(0, 0), b2, voffB); PG8_STAGE(PG8_SB(0, 1), b2 + hstep, voffB); PG8_STAGE(PG8_SA(0, 0), a2, voffA);
            PG8_WAIT_V(8); PG8_WAIT_L(0); PG8_BAR; PG8_MMA(1, 0, At, B0); PG8_MMA(1, 1, At, B1); PG8_BAR; PG8_SCHED;
            PG8_LDB(B0, 1, 0); PG8_LDB(B1, 1, 1); PG8_SCHED; PG8_LDA(At, 1, 0); PG8_STAGE(PG8_SA(0, 1), a2 + hstep, voffA);
            PG8_WAIT_V(8); PG8_WAIT_L(0); PG8_BAR; PG8_MMA(0, 0, At, B0); PG8_MMA(0, 1, At, B1); PG8_BAR; PG8_SCHED;
            PG8_LDA(At, 1, 1); PG8_STAGE(PG8_SB(1, 0), b3, voffB); PG8_STAGE(PG8_SB(1, 1), b3 + hstep, voffB); PG8_STAGE(PG8_SA(1, 0), a3, voffA);
            PG8_WAIT_V(8); PG8_WAIT_L(0); PG8_BAR; PG8_MMA(1, 0, At, B0); PG8_MMA(1, 1, At, B1); PG8_BAR; PG8_SCHED;
            } else {
            PG8_LDB(B0, 0, 0); PG8_SCHED; PG8_LDA(At, 0, 0); PG8_STAGE(PG8_SA(1, 1), a1 + hstep, voffA);
            PG8_WAIT_L(8); PG8_BAR; PG8_WAIT_L(0); PG8_MMA(0, 0, At, B0); PG8_BAR; PG8_SCHED;
            PG8_LDB(B1, 0, 1); PG8_STAGE(PG8_SB(0, 0), b2, voffB);
            PG8_BAR; PG8_WAIT_L(0); PG8_MMA(0, 1, At, B1); PG8_BAR;
            PG8_LDA(At, 0, 1); PG8_STAGE(PG8_SA(0, 0), a2, voffA);
            PG8_BAR; PG8_WAIT_L(0); PG8_MMA(1, 0, At, B0); PG8_BAR; PG8_SCHED;
            PG8_STAGE(PG8_SB(0, 1), b2 + hstep, voffB);
            PG8_WAIT_V(6); PG8_BAR; PG8_MMA(1, 1, At, B1); PG8_BAR;
            PG8_LDB(B0, 1, 0); PG8_SCHED; PG8_LDA(At, 1, 0); PG8_STAGE(PG8_SA(0, 1), a2 + hstep, voffA);
            PG8_WAIT_L(8); PG8_BAR; PG8_WAIT_L(0); PG8_MMA(0, 0, At, B0); PG8_BAR; PG8_SCHED;
            PG8_LDB(B1, 1, 1); PG8_STAGE(PG8_SB(1, 0), b3, voffB);
            PG8_BAR; PG8_WAIT_L(0); PG8_MMA(0, 1, At, B1); PG8_BAR;
            PG8_LDA(At, 1, 1); PG8_STAGE(PG8_SA(1, 0), a3, voffA);
            PG8_BAR; PG8_WAIT_L(0); PG8_MMA(1, 0, At, B0); PG8_BAR; PG8_SCHED;
            PG8_STAGE(PG8_SB(1, 1), b3 + hstep, voffB);
            PG8_WAIT_V(6); PG8_BAR; PG8_MMA(1, 1, At, B1); PG8_BAR;
            }
        }
        if constexpr (ALIGN_EPI) { if (wr == 0) PG8_BAR; }
        if constexpr (!Epi::AFTER_DRAIN) { E(acc, cur, wr, wc, fr, fq); S.done(cur); }
        if (!has_next) break;
#pragma unroll
        for (int a = 0; a < 2; ++a)
#pragma unroll
            for (int b = 0; b < 2; ++b)
#pragma unroll
                for (int m = 0; m < 4; ++m)
#pragma unroll
                    for (int n = 0; n < 2; ++n) acc[a][b][m][n] = (f32x4){0.f, 0.f, 0.f, 0.f};
        cur = nxt; cA = nA; cB = nB; ++ui;
        if constexpr (ALIGN_EPI) { if (wr == 1) PG8_BAR; }
    }
    PG8_WAIT_V(0);
    if constexpr (!ALIGN_EPI) { if (wr == 0) PG8_BAR; }
    PG8_BAR;
    if constexpr (Epi::AFTER_DRAIN) { E.fused(acc, cur, wr, wc, fr, fq, lds, wid, lane); S.done(cur); }
#undef PG8_SA
#undef PG8_SB
#undef PG8_STAGE
#undef PG8_LDA
#undef PG8_LDB
#undef PG8_MMA
#undef PG8_WAIT_V
#undef PG8_WAIT_L
#undef PG8_BAR
#undef PG8_SCHED
}
}


#define LAS __attribute__((address_space(3)))
typedef unsigned short bf16_t;
typedef short bf16x8 __attribute__((ext_vector_type(8)));
typedef float f32x4 __attribute__((ext_vector_type(4)));
typedef unsigned u32x4 __attribute__((ext_vector_type(4)));
typedef unsigned u32x2 __attribute__((ext_vector_type(2)));
typedef unsigned short u16x4 __attribute__((ext_vector_type(4)));
using pg8::cvt_pk_bf16;

constexpr int DM = 1024, NTOK = 81920, MH = 49152  , NSEQH = 12, NPTOK = 16384, PC = 6208, DFF = 2816;
constexpr int PASS_ROW0[2] = {0, 49152}, PASS_ROWS[2] = {49152, 32768}, PASS_SEQ[2] = {12, 8};
constexpr int C_Q = 0, C_K = 256, C_V = 512, C_OG = 1024, C_RF = 1536, C_Z = 1568, C_XBC = 2592, C_BM = 3616, C_CM = 3872, C_DTF = 4128, C_DTB = 4144, C_G1 = 4160, C_G2 = 5184;
constexpr float EPS = 1e-6f;
constexpr int XCD_BAR_WORDS_ = 3456;

constexpr size_t WS_WIN = 0;
constexpr size_t WS_WB1 = WS_WIN + (size_t)6400 * 1024 * 2;
constexpr size_t WS_WB2 = WS_WB1 + (size_t)1024 * 512 * 2;
constexpr size_t WS_WOUT = WS_WB2 + (size_t)1024 * 1024 * 2;
constexpr size_t WS_WGU = WS_WOUT + (size_t)1024 * 1024 * 2;
constexpr size_t WS_WD = WS_WGU + (size_t)5632 * 1024 * 2;
constexpr size_t WS_RSS1 = WS_WD + (size_t)1024 * 2816 * 2;
constexpr size_t WS_RSS2 = WS_RSS1 + (size_t)NTOK * 4;
constexpr size_t WS_RSSY = WS_RSS2 + (size_t)NTOK * 4;
constexpr size_t WS_GDEC = WS_RSSY + (size_t)NTOK * 4;
constexpr size_t WS_SDEC = WS_GDEC + (size_t)NSEQH * 64 * 2 * 4 * 64 * 4;
constexpr size_t WS_PROJ = WS_SDEC + (size_t)NSEQH * 32 * 2 * 16 * 4;
constexpr size_t WS_U = WS_PROJ + (size_t)MH * PC * 2;
constexpr size_t WS_OG = WS_U;
constexpr size_t WS_Y = WS_U + (size_t)MH * 512 * 2;
constexpr size_t WS_ST = WS_U + (size_t)MH * 1536 * 2;
constexpr size_t WS_GS = WS_ST;
constexpr size_t WS_SS = WS_ST + (size_t)MH * 2048;
constexpr size_t WS_T = WS_ST;
constexpr size_t WS_MM = WS_ST + (size_t)MH * 2048;
constexpr size_t WS_X1B = WS_U;
constexpr size_t WS_BAR = WS_ST + (size_t)MH * 4096;
constexpr size_t WS_END = WS_BAR + (size_t)XCD_BAR_WORDS_ * 4;
static_assert(WS_PROJ % 256 == 0 && WS_U % 256 == 0 && WS_ST % 256 == 0 && WS_END < (size_t)1020 * 1000 * 1000, "ws map");

struct Params {
    const float* xp; const float* xs; const float* norm_mix_w; const float* w_in; const float* gla_up_f; const float* gla_bias_f; const float* gla_up_b; const float* gla_bias_b;
    const float* gla_norm_w; const float* conv_w; const float* conv_b; const float* dt_bias_f; const float* dt_bias_b; const float* a_log_f; const float* a_log_b; const float* d_skip;
    const float* ssm_norm_w; const float* w_br_gla; const float* w_br_ssm; const float* w_out; const float* norm_ffn_w; const float* w_ffn_gate; const float* w_ffn_up; const float* w_ffn_down;
    const float* norm_final_w; float* out; unsigned char* ws;
};

__device__ __forceinline__ float bf2f(unsigned short b) { return __uint_as_float(((unsigned)b) << 16); }
__device__ __forceinline__ float bflo(unsigned u) { return __uint_as_float(u << 16); }
__device__ __forceinline__ float bfhi(unsigned u) { return __uint_as_float(u & 0xffff0000u); }
__device__ __forceinline__ unsigned short f2bf(float f) { return (unsigned short)(cvt_pk_bf16(f, 0.f) & 0xffffu); }
__device__ __forceinline__ float sigmoidf_(float x) { return __builtin_amdgcn_rcpf(1.0f + __expf(-x)); }
__device__ __forceinline__ float siluf_(float x) { return x * __builtin_amdgcn_rcpf(1.0f + __expf(-x)); }
typedef float f32x2 __attribute__((ext_vector_type(2)));
__device__ __forceinline__ f32x2 sigmoid2(f32x2 x) { const f32x2 t = x * -1.4426950408889634f; f32x2 e; e.x = __builtin_amdgcn_exp2f(t.x); e.y = __builtin_amdgcn_exp2f(t.y); const f32x2 d = e + 1.0f;
    f32x2 r; r.x = __builtin_amdgcn_rcpf(d.x); r.y = __builtin_amdgcn_rcpf(d.y); return r; }
__device__ __forceinline__ f32x2 bfpair(unsigned w) { return (f32x2){bflo(w), bfhi(w)}; }
__device__ __forceinline__ float softplusf_(float x) { return fmaxf(x, 0.f) + log1pf(__expf(-fabsf(x))); }
__device__ __forceinline__ const float* xrow(const Params& p, int grow) { return grow < NPTOK ? p.xp + (size_t)grow * DM : p.xs + (size_t)(grow - NPTOK) * DM; }
__device__ __forceinline__ void unpack8(const u32x4 v, float* o) { o[0] = bflo(v.x); o[1] = bfhi(v.x); o[2] = bflo(v.y); o[3] = bfhi(v.y); o[4] = bflo(v.z); o[5] = bfhi(v.z); o[6] = bflo(v.w); o[7] = bfhi(v.w); }
__device__ __forceinline__ u32x4 pack8(const float* o) { u32x4 w; w.x = cvt_pk_bf16(o[0], o[1]); w.y = cvt_pk_bf16(o[2], o[3]); w.z = cvt_pk_bf16(o[4], o[5]); w.w = cvt_pk_bf16(o[6], o[7]); return w; }
__device__ __forceinline__ float shfl_idx(float x, int src_lane) { return __int_as_float(__builtin_amdgcn_ds_bpermute(src_lane << 2, __float_as_int(x))); }
__device__ __forceinline__ float bcast_lane63(float x) { return __int_as_float(__builtin_amdgcn_readlane(__float_as_int(x), 63)); }
template <int N> __device__ __forceinline__ float dpp_row_shr(float x) { return __int_as_float(__builtin_amdgcn_update_dpp(0, __float_as_int(x), 0x110 + N, 0xf, 0xf, true)); }
__device__ __forceinline__ float wave_incl_scan_tot(float x, int lane, float& tot) {
    x += dpp_row_shr<1>(x); x += dpp_row_shr<2>(x); x += dpp_row_shr<4>(x); x += dpp_row_shr<8>(x);
    const float t0 = __int_as_float(__builtin_amdgcn_readlane(__float_as_int(x), 15)), t1 = __int_as_float(__builtin_amdgcn_readlane(__float_as_int(x), 31));
    const float t2 = __int_as_float(__builtin_amdgcn_readlane(__float_as_int(x), 47)), t3 = __int_as_float(__builtin_amdgcn_readlane(__float_as_int(x), 63));
    const int row = lane >> 4;
    const float add = (row >= 1 ? t0 : 0.f) + (row >= 2 ? t1 : 0.f) + (row >= 3 ? t2 : 0.f);
    tot = (t0 + t1) + (t2 + t3);
    return x + add;
}
__device__ __forceinline__ bf16x8 frag_row(const LAS unsigned char* base, int RS, int row0, int k0, int lane) {
    return *(const LAS bf16x8*)(base + (row0 + (lane & 15)) * RS + (k0 + 8 * (lane >> 4)) * 2);
}
__device__ __forceinline__ bf16x8 frag_tr(unsigned base_addr, int RS, int k0, int c0, int lane) {
    const int g = lane >> 4, q = (lane & 15) >> 2, pp = lane & 3;
    const unsigned a0 = base_addr + (unsigned)((k0 + 8 * g + q) * RS + (c0 + 4 * pp) * 2), a1 = a0 + 4u * (unsigned)RS;
    u16x4 lo, hi;
    asm volatile("ds_read_b64_tr_b16 %0, %2\n\tds_read_b64_tr_b16 %1, %3\n\ts_waitcnt lgkmcnt(0)" : "=&v"(lo), "=&v"(hi) : "v"(a0), "v"(a1) : "memory");
    bf16x8 r; r[0] = (short)lo[0]; r[1] = (short)lo[1]; r[2] = (short)lo[2]; r[3] = (short)lo[3]; r[4] = (short)hi[0]; r[5] = (short)hi[1]; r[6] = (short)hi[2]; r[7] = (short)hi[3];
    return r;
}
#define MFMA16(a, b, c) __builtin_amdgcn_mfma_f32_16x16x32_bf16(a, b, c, 0, 0, 0)
__device__ __forceinline__ void frag_tr4(bf16x8 (&r)[4], unsigned base_addr, int RS, int k0, int c0, int cstep, int lane) {
    const int g = lane >> 4, q = (lane & 15) >> 2, pp = lane & 3;
    const unsigned a0 = base_addr + (unsigned)((k0 + 8 * g + q) * RS + (c0 + 4 * pp) * 2), a1 = a0 + 4u * (unsigned)RS; const unsigned cs = (unsigned)cstep * 2u;
    u16x4 lo[4], hi[4];
#pragma unroll
    for (int i = 0; i < 4; ++i) { asm volatile("ds_read_b64_tr_b16 %0, %1" : "=&v"(lo[i]) : "v"(a0 + cs * i) : "memory"); asm volatile("ds_read_b64_tr_b16 %0, %1" : "=&v"(hi[i]) : "v"(a1 + cs * i) : "memory"); }
    asm volatile("s_waitcnt lgkmcnt(0)" : "+v"(lo[0]), "+v"(lo[1]), "+v"(lo[2]), "+v"(lo[3]), "+v"(hi[0]), "+v"(hi[1]), "+v"(hi[2]), "+v"(hi[3]) :: "memory");
#pragma unroll
    for (int i = 0; i < 4; ++i) { r[i][0] = (short)lo[i][0]; r[i][1] = (short)lo[i][1]; r[i][2] = (short)lo[i][2]; r[i][3] = (short)lo[i][3]; r[i][4] = (short)hi[i][0]; r[i][5] = (short)hi[i][1]; r[i][6] = (short)hi[i][2]; r[i][7] = (short)hi[i][3]; }
}


#define XB_TMO      128
#define XB_XCNT(j)  (256  + 64 * (j))
#define XB_XSUB(j)  (1280 + 64 * (j))
#define XB_XGEN(j)  (2304 + 64 * (j))
#define XB_TOP      3328
#define XB_TOPGEN   3392
#define XCD_BAR_WORDS 3456
#define XB_SPIN_CAP (1u << 18)

__device__ __forceinline__ unsigned xb_tid() { unsigned t_ = threadIdx.x; asm volatile("" : "+v"(t_)); return t_; }
__device__ __forceinline__ unsigned xb_ld(unsigned* p)              { return __hip_atomic_load(p, __ATOMIC_RELAXED, __HIP_MEMORY_SCOPE_AGENT); }
__device__ __forceinline__ unsigned xb_add(unsigned* p, unsigned v) { return __hip_atomic_fetch_add(p, v, __ATOMIC_RELAXED, __HIP_MEMORY_SCOPE_AGENT); }
__device__ __forceinline__ unsigned xb_xcc_id() { return (unsigned)__builtin_amdgcn_s_getreg((3 << 11) | 20) & 0xFu; }
#define XB_SPIN(cond, bar) do { unsigned _sp = 0; while (cond) { __builtin_amdgcn_s_sleep(1); \
    if ((++_sp & 255u) == 0u) { if (xb_ld(&(bar)[XB_TMO])) break; if (_sp > XB_SPIN_CAP) { atomicAdd(&(bar)[XB_TMO], 1u); break; } } } } while (0)

struct XcdBarrier {
    unsigned* bar; unsigned x;
    volatile LAS unsigned* st;
};

__device__ __forceinline__ XcdBarrier xcd_barrier_post(unsigned* bar, volatile LAS unsigned* st) {
    XcdBarrier b; b.bar = bar; b.x = xb_xcc_id(); b.st = st;
    if (xb_tid() == 0) (void)xb_add(&bar[XB_XCNT(b.x)], 1u);
    return b;
}
__device__ __forceinline__ void xcd_barrier_complete(unsigned* bar, unsigned x, unsigned& nloc, unsigned& nx) {
    const unsigned G = gridDim.x * gridDim.y * gridDim.z;
    unsigned sum, cnt, mine, sp = 0u;
    for (;;) {
        sum = 0u; cnt = 0u; mine = 0u;
#pragma unroll
        for (unsigned j = 0; j < 16; ++j) { const unsigned c = xb_ld(&bar[XB_XCNT(j)]); sum += c; cnt += (c > 0u) ? 1u : 0u; mine = (j == x) ? c : mine; }
        if (sum == G) break;
        __builtin_amdgcn_s_sleep(1);
        if ((++sp & 255u) == 0u) { if (xb_ld(&bar[XB_TMO])) break; if (sp > XB_SPIN_CAP) { atomicAdd(&bar[XB_TMO], 1u); break; } }
    }
    nloc = mine > 0u ? mine : 1u; nx = cnt > 0u ? cnt : 1u;
}

__device__ __forceinline__ void xcd_barrier(const XcdBarrier& b) {
    asm volatile("s_waitcnt vmcnt(0)" ::: "memory");
    __syncthreads();
    if (xb_tid() == 0) {
        unsigned* bar = b.bar;
        __builtin_amdgcn_s_waitcnt(0);
        unsigned nloc = b.st[0], nx = b.st[1];
        if (nloc == 0u) { xcd_barrier_complete(bar, b.x, nloc, nx); b.st[0] = nloc; b.st[1] = nx; }
        const unsigned old = xb_add(&bar[XB_XSUB(b.x)], 1u);
        const unsigned gen = old / nloc;
        if (old + 1u == (gen + 1u) * nloc) {
            __builtin_amdgcn_fence(__ATOMIC_RELEASE, "agent");
            asm volatile("s_waitcnt vmcnt(0)" ::: "memory");
            const unsigned og = xb_add(&bar[XB_TOP], 1u);
            const unsigned tg = og / nx;
            if (og + 1u == (tg + 1u) * nx) xb_add(&bar[XB_TOPGEN], 1u);
            else XB_SPIN(xb_ld(&bar[XB_TOPGEN]) == tg, bar);
            __builtin_amdgcn_fence(__ATOMIC_ACQUIRE, "agent");
            xb_add(&bar[XB_XGEN(b.x)], 1u);
            asm volatile("s_waitcnt vmcnt(0)" ::: "memory");
        } else {
            XB_SPIN(xb_ld(&bar[XB_XGEN(b.x)]) == gen, bar);
            __builtin_amdgcn_fence(__ATOMIC_ACQUIRE, "agent");
            asm volatile("s_waitcnt vmcnt(0)" ::: "memory");
        }
    }
    __syncthreads();
}

struct EpiProj {
    static constexpr bool PERM = true, AFTER_DRAIN = false;
    bf16_t* O;
    __device__ __forceinline__ void operator()(const f32x4 (&acc)[2][2][4][2], const pg8::Unit& u, int wr, int wc, int fr, int fq) const {
        const int row0 = u.pm * 256 + wr * 64 + fr, col0 = u.pn * 256 + wc * 32 + 8 * fq;
#pragma unroll
        for (int ai = 0; ai < 2; ++ai)
#pragma unroll
            for (int m = 0; m < 4; ++m) { bf16_t* rowp = O + (size_t)(row0 + ai * 128 + m * 16) * PC;
#pragma unroll
                for (int bj = 0; bj < 2; ++bj) { const int c = col0 + bj * 128; const f32x4 v0 = acc[ai][bj][m][0], v1 = acc[ai][bj][m][1];
                    u32x4 w; w.x = cvt_pk_bf16(v0[0], v0[1]); w.y = cvt_pk_bf16(v0[2], v0[3]); w.z = cvt_pk_bf16(v1[0], v1[1]); w.w = cvt_pk_bf16(v1[2], v1[3]);
                    if (c < PC) *(u32x4*)(rowp + c) = w; } }
    }
};
struct EpiM1 {
    static constexpr bool PERM = true, AFTER_DRAIN = false;
    const bf16_t* proj; bf16_t* T;
    __device__ __forceinline__ void operator()(const f32x4 (&acc)[2][2][4][2], const pg8::Unit& u, int wr, int wc, int fr, int fq) const {
        const int row0 = u.pm * 256 + wr * 64 + fr, col0 = u.pn * 256 + wc * 32 + 8 * fq;
#pragma unroll
        for (int ai = 0; ai < 2; ++ai) {
            u32x4 gq[4][2];
#pragma unroll
            for (int m = 0; m < 4; ++m)
#pragma unroll
                for (int bj = 0; bj < 2; ++bj) gq[m][bj] = *(const u32x4*)(proj + (size_t)(row0 + ai * 128 + m * 16) * PC + C_G1 + col0 + bj * 128);
#pragma unroll
            for (int m = 0; m < 4; ++m) { const int row = row0 + ai * 128 + m * 16;
#pragma unroll
                for (int bj = 0; bj < 2; ++bj) { const int c = col0 + bj * 128; const u32x4 gw = gq[m][bj]; const f32x4 a0 = acc[ai][bj][m][0], a1 = acc[ai][bj][m][1];
                    const f32x2 o0 = sigmoid2(bfpair(gw.x)) * (f32x2){a0[0], a0[1]}, o1 = sigmoid2(bfpair(gw.y)) * (f32x2){a0[2], a0[3]}, o2 = sigmoid2(bfpair(gw.z)) * (f32x2){a1[0], a1[1]}, o3 = sigmoid2(bfpair(gw.w)) * (f32x2){a1[2], a1[3]};
                    u32x4 w; w.x = cvt_pk_bf16(o0.x, o0.y); w.y = cvt_pk_bf16(o1.x, o1.y); w.z = cvt_pk_bf16(o2.x, o2.y); w.w = cvt_pk_bf16(o3.x, o3.y);
                    *(u32x4*)(T + (size_t)row * DM + c) = w; } }
        }
    }
};
struct EpiM2 {
    static constexpr bool PERM = true, AFTER_DRAIN = false;
    const bf16_t* proj; const bf16_t* T; bf16_t* MMo; const float* rssy;
    __device__ __forceinline__ void operator()(const f32x4 (&acc)[2][2][4][2], const pg8::Unit& u, int wr, int wc, int fr, int fq) const {
        const int row0 = u.pm * 256 + wr * 64 + fr, col0 = u.pn * 256 + wc * 32 + 8 * fq;
#pragma unroll
        for (int ai = 0; ai < 2; ++ai)
#pragma unroll
            for (int mh = 0; mh < 2; ++mh) {
                u32x4 gq[2][2], tq[2][2]; float rsv[2];
#pragma unroll
                for (int mm = 0; mm < 2; ++mm) { const int row = row0 + ai * 128 + (2 * mh + mm) * 16; rsv[mm] = rssy[row];
#pragma unroll
                    for (int bj = 0; bj < 2; ++bj) { const int c = col0 + bj * 128; gq[mm][bj] = *(const u32x4*)(proj + (size_t)row * PC + C_G2 + c); tq[mm][bj] = *(const u32x4*)(T + (size_t)row * DM + c); } }
#pragma unroll
                for (int mm = 0; mm < 2; ++mm) { const int m = 2 * mh + mm, row = row0 + ai * 128 + m * 16; const float rs = rsqrtf(rsv[mm] * (1.0f / 1024.0f) + EPS);
#pragma unroll
                    for (int bj = 0; bj < 2; ++bj) { const int c = col0 + bj * 128; const u32x4 gw = gq[mm][bj], tw = tq[mm][bj]; const f32x4 a0 = acc[ai][bj][m][0] * rs, a1 = acc[ai][bj][m][1] * rs;
                        const f32x2 o0 = sigmoid2(bfpair(gw.x)) * (f32x2){a0[0], a0[1]} + bfpair(tw.x), o1 = sigmoid2(bfpair(gw.y)) * (f32x2){a0[2], a0[3]} + bfpair(tw.y),
                                    o2 = sigmoid2(bfpair(gw.z)) * (f32x2){a1[0], a1[1]} + bfpair(tw.z), o3 = sigmoid2(bfpair(gw.w)) * (f32x2){a1[2], a1[3]} + bfpair(tw.w);
                        u32x4 w; w.x = cvt_pk_bf16(o0.x, o0.y); w.y = cvt_pk_bf16(o1.x, o1.y); w.z = cvt_pk_bf16(o2.x, o2.y); w.w = cvt_pk_bf16(o3.x, o3.y);
                        *(u32x4*)(MMo + (size_t)row * DM + c) = w; } }
            }
    }
};
struct EpiOut {
    static constexpr bool PERM = true, AFTER_DRAIN = false;
    Params p; int grow0; bf16_t* X1B; float* rss;
    __device__ __forceinline__ void operator()(const f32x4 (&acc)[2][2][4][2], const pg8::Unit& u, int wr, int wc, int fr, int fq) const {
        const int row0 = u.pm * 256 + wr * 64 + fr, col0 = u.pn * 256 + wc * 32 + 8 * fq, ln_ = fq * 16 + fr;
#pragma unroll
        for (int ai = 0; ai < 2; ++ai)
#pragma unroll
            for (int mh = 0; mh < 2; ++mh) {
                f32x4 xa[2][2][2];
#pragma unroll
                for (int mm = 0; mm < 2; ++mm) { const float* xr = xrow(p, grow0 + row0 + ai * 128 + (2 * mh + mm) * 16);
#pragma unroll
                    for (int bj = 0; bj < 2; ++bj) { xa[mm][bj][0] = *(const f32x4*)(xr + col0 + bj * 128); xa[mm][bj][1] = *(const f32x4*)(xr + col0 + bj * 128 + 4); } }
#pragma unroll
                for (int mm = 0; mm < 2; ++mm) { const int m = 2 * mh + mm, row = row0 + ai * 128 + m * 16, grow = grow0 + row; float* orow = p.out + (size_t)grow * DM; float ss = 0.f;
#pragma unroll
                    for (int bj = 0; bj < 2; ++bj) { const int c = col0 + bj * 128;
                        const f32x4 a = xa[mm][bj][0] + acc[ai][bj][m][0], b = xa[mm][bj][1] + acc[ai][bj][m][1];
                        *(f32x4*)(orow + c) = a; *(f32x4*)(orow + c + 4) = b;
                        ss += a[0] * a[0] + a[1] * a[1] + a[2] * a[2] + a[3] * a[3] + b[0] * b[0] + b[1] * b[1] + b[2] * b[2] + b[3] * b[3];
                        u32x4 w; w.x = cvt_pk_bf16(a[0], a[1]); w.y = cvt_pk_bf16(a[2], a[3]); w.z = cvt_pk_bf16(b[0], b[1]); w.w = cvt_pk_bf16(b[2], b[3]);
                        *(u32x4*)(X1B + (size_t)row * DM + c) = w; }
                    ss += shfl_idx(ss, ln_ ^ 16); ss += shfl_idx(ss, ln_ ^ 32);
                    if (fq == 0) atomicAdd(rss + grow, ss); }
            }
    }
};
struct EpiSwi {
    static constexpr bool PERM = true, AFTER_DRAIN = false;
    const float* rss; bf16_t* H;
    __device__ __forceinline__ void operator()(const f32x4 (&acc)[2][2][4][2], const pg8::Unit& u, int wr, int wc, int fr, int fq) const {
        const int row0 = u.pm * 256 + wr * 64 + fr, hc = u.pn * 128 + wc * 32 + 8 * fq;
        float rsv[2][4];
#pragma unroll
        for (int ai = 0; ai < 2; ++ai)
#pragma unroll
            for (int m = 0; m < 4; ++m) rsv[ai][m] = rss[row0 + ai * 128 + m * 16];
#pragma unroll
        for (int ai = 0; ai < 2; ++ai)
#pragma unroll
            for (int m = 0; m < 4; ++m) { const int row = row0 + ai * 128 + m * 16; const float rs = rsqrtf(rsv[ai][m] * (1.0f / 1024.0f) + EPS); u32x4 w;
#pragma unroll
                for (int n = 0; n < 2; ++n) { const f32x4 g4 = acc[ai][0][m][n] * rs, u4 = acc[ai][1][m][n] * rs;
                    const f32x2 ga = {g4[0], g4[1]}, gb = {g4[2], g4[3]}, ua = {u4[0], u4[1]}, ub = {u4[2], u4[3]};
                    const f32x2 ha = (ga * sigmoid2(ga)) * ua, hb = (gb * sigmoid2(gb)) * ub;
                    if (n == 0) { w.x = cvt_pk_bf16(ha.x, ha.y); w.y = cvt_pk_bf16(hb.x, hb.y); } else { w.z = cvt_pk_bf16(ha.x, ha.y); w.w = cvt_pk_bf16(hb.x, hb.y); } }
                *(u32x4*)(H + (size_t)row * DFF + hc) = w; }
    }
};
struct EpiDown {
    static constexpr bool PERM = true, AFTER_DRAIN = false;
    float* out; int grow0; float* rss;
    __device__ __forceinline__ void operator()(const f32x4 (&acc)[2][2][4][2], const pg8::Unit& u, int wr, int wc, int fr, int fq) const {
        const int row0 = u.pm * 256 + wr * 64 + fr, col0 = u.pn * 256 + wc * 32 + 8 * fq, ln_ = fq * 16 + fr;
#pragma unroll
        for (int ai = 0; ai < 2; ++ai)
#pragma unroll
            for (int mh = 0; mh < 2; ++mh) {
                f32x4 xa[2][2][2];
#pragma unroll
                for (int mm = 0; mm < 2; ++mm) { const float* xr = out + (size_t)(grow0 + row0 + ai * 128 + (2 * mh + mm) * 16) * DM;
#pragma unroll
                    for (int bj = 0; bj < 2; ++bj) { xa[mm][bj][0] = *(const f32x4*)(xr + col0 + bj * 128); xa[mm][bj][1] = *(const f32x4*)(xr + col0 + bj * 128 + 4); } }
#pragma unroll
                for (int mm = 0; mm < 2; ++mm) { const int m = 2 * mh + mm, grow = grow0 + row0 + ai * 128 + m * 16; float* orow = out + (size_t)grow * DM; float ss = 0.f;
#pragma unroll
                    for (int bj = 0; bj < 2; ++bj) { const int c = col0 + bj * 128;
                        const f32x4 a = xa[mm][bj][0] + acc[ai][bj][m][0], b = xa[mm][bj][1] + acc[ai][bj][m][1];
                        *(f32x4*)(orow + c) = a; *(f32x4*)(orow + c + 4) = b;
                        ss += a[0] * a[0] + a[1] * a[1] + a[2] * a[2] + a[3] * a[3] + b[0] * b[0] + b[1] * b[1] + b[2] * b[2] + b[3] * b[3]; }
                    ss += shfl_idx(ss, ln_ ^ 16); ss += shfl_idx(ss, ln_ ^ 32);
                    if (fq == 0) atomicAdd(rss + grow, ss); }
            }
    }
};

__device__ __forceinline__ void transpose_tile(const float* src, int N, int k0, int n0, bf16_t* dst, int K, int mode, const float* kscale, LAS float* tl, int tid) {
    for (int i = tid; i < 1024; i += 512) { const int kk = i >> 4, n4 = (i & 15) * 4; f32x4 v = *(const f32x4*)(src + (size_t)(k0 + kk) * N + n0 + n4); if (kscale) v *= kscale[k0 + kk];
        tl[kk * 65 + n4] = v[0]; tl[kk * 65 + n4 + 1] = v[1]; tl[kk * 65 + n4 + 2] = v[2]; tl[kk * 65 + n4 + 3] = v[3]; }
    __syncthreads();
    for (int i = tid; i < 2048; i += 512) { const int nn = i >> 5, kp = i & 31; const float a = tl[(2 * kp) * 65 + nn], b = tl[(2 * kp + 1) * 65 + nn]; const int n = n0 + nn;
        const int row = mode == 0 ? n : (256 * (n >> 7) + (n & 127) + (mode == 2 ? 128 : 0));
        *(unsigned*)(dst + (size_t)row * K + k0 + 2 * kp) = cvt_pk_bf16(a, b); }
    __syncthreads();
}
__device__ __forceinline__ void phase_weights(const Params& p, LAS unsigned char* l, int tid) {
    unsigned char* ws = p.ws; LAS float* tl = (LAS float*)l;
    for (int j = blockIdx.x; j < 4304; j += gridDim.x) {
        if (j < 1552) transpose_tile(p.w_in, PC, (j / 97) * 64, (j % 97) * 64, (bf16_t*)(ws + WS_WIN), 1024, 0, nullptr, tl, tid);
        else if (j < 1680) { const int t = j - 1552; transpose_tile(p.w_br_gla, 1024, (t / 16) * 64, (t % 16) * 64, (bf16_t*)(ws + WS_WB1), 512, 0, nullptr, tl, tid); }
        else if (j < 1936) { const int t = j - 1680; transpose_tile(p.w_br_ssm, 1024, (t / 16) * 64, (t % 16) * 64, (bf16_t*)(ws + WS_WB2), 1024, 0, p.ssm_norm_w, tl, tid); }
        else if (j < 2192) { const int t = j - 1936; transpose_tile(p.w_out, 1024, (t / 16) * 64, (t % 16) * 64, (bf16_t*)(ws + WS_WOUT), 1024, 0, nullptr, tl, tid); }
        else if (j < 2896) { const int t = j - 2192; transpose_tile(p.w_ffn_gate, DFF, (t / 44) * 64, (t % 44) * 64, (bf16_t*)(ws + WS_WGU), 1024, 1, p.norm_ffn_w, tl, tid); }
        else if (j < 3600) { const int t = j - 2896; transpose_tile(p.w_ffn_up, DFF, (t / 44) * 64, (t % 44) * 64, (bf16_t*)(ws + WS_WGU), 1024, 2, p.norm_ffn_w, tl, tid); }
        else { const int t = j - 3600; transpose_tile(p.w_ffn_down, 1024, (t / 16) * 64, (t % 16) * 64, (bf16_t*)(ws + WS_WD), DFF, 0, nullptr, tl, tid); }
    }
    const int gt = blockIdx.x * 512 + tid, GT = gridDim.x * 512;
    unsigned* zw = (unsigned*)(ws + WS_WIN + (size_t)PC * 1024 * 2);
    for (int i = gt; i < 192 * 1024 / 2; i += GT) zw[i] = 0u;
    float* rs = (float*)(ws + WS_RSS1);
    for (int i = gt; i < 3 * NTOK; i += GT) rs[i] = 0.f;
}
__device__ __forceinline__ void phase_u(const Params& p, int row0, int nrows, int tid) {
    const int wave = tid >> 6, lane = tid & 63; bf16_t* U = (bf16_t*)(p.ws + WS_U);
    const int RST = gridDim.x * 8;
    for (int rb = blockIdx.x * 8 + wave; rb < nrows; rb += 2 * RST) {
        f32x4 v[2][4]; float ss[2] = {0.f, 0.f};
#pragma unroll
        for (int q = 0; q < 2; ++q) { const int r = rb + q * RST; if (r < nrows) { const float* xr = xrow(p, row0 + r);
#pragma unroll
            for (int i = 0; i < 4; ++i) v[q][i] = ((const f32x4*)xr)[lane + 64 * i]; } else {
#pragma unroll
            for (int i = 0; i < 4; ++i) v[q][i] = (f32x4){0.f, 0.f, 0.f, 0.f}; } }
        f32x4 wv[4];
#pragma unroll
        for (int i = 0; i < 4; ++i) wv[i] = ((const f32x4*)p.norm_mix_w)[lane + 64 * i];
#pragma unroll
        for (int q = 0; q < 2; ++q) {
#pragma unroll
            for (int i = 0; i < 4; ++i) ss[q] += v[q][i][0] * v[q][i][0] + v[q][i][1] * v[q][i][1] + v[q][i][2] * v[q][i][2] + v[q][i][3] * v[q][i][3];
#pragma unroll
            for (int o = 1; o < 64; o <<= 1) ss[q] += shfl_idx(ss[q], lane ^ o);
            const float rstd = rsqrtf(ss[q] * (1.0f / 1024.0f) + EPS); const int r = rb + q * RST;
            if (r < nrows) {
#pragma unroll
                for (int i = 0; i < 4; ++i) { u32x2 o; o.x = cvt_pk_bf16(v[q][i][0] * rstd * wv[i][0], v[q][i][1] * rstd * wv[i][1]); o.y = cvt_pk_bf16(v[q][i][2] * rstd * wv[i][2], v[q][i][3] * rstd * wv[i][3]);
                    *(u32x2*)(U + (size_t)r * DM + 4 * (lane + 64 * i)) = o; } }
        }
    }
}

constexpr int G_QF = 0, G_KF = 9216, G_QB = 18432, G_KB = 27648, G_V = 36864, G_ATT = 54272, G_SFT = 63488, G_SBT = 81920, G_SSQ = 100352, G_RS = 144, G_RSV = 272,
              G_UP = 101376, G_BIAS = 109568, G_KR = 110080, G_QR = 119296, G_RFB = 128512, G_RSR = 80, G_OGR = 133632, G_STG3 = 110080, G_STG1 = 63488, G_GNW = 151040;
struct GlaPF { u32x4 k, q, rf; f32x4 up, bias, gnw; };
template <bool S3>
__device__ __forceinline__ void gla_pf_load(GlaPF& f, const Params& p, int item, int tid) {
    const int h = item & 3, c = (item >> 2) & 63, seq = item >> 8, r0 = seq * 4096 + c * 64;
    const bf16_t* proj = (const bf16_t*)(p.ws + WS_PROJ);
    { const int row = tid >> 3, ch = tid & 7; const bf16_t* pr = proj + (size_t)(r0 + row) * PC; f.k = *(const u32x4*)(pr + C_K + 64 * h + ch * 8); if (S3) f.q = *(const u32x4*)(pr + C_Q + 64 * h + ch * 8); }
    if (tid < 256) { const int row = tid >> 2, ch = tid & 3; f.rf = *(const u32x4*)(proj + (size_t)(r0 + row) * PC + C_RF + ch * 8); }
    { const int dr = tid >> 8, r = (tid >> 4) & 15, d4 = tid & 15; f.up = *(const f32x4*)((dr ? p.gla_up_b : p.gla_up_f) + r * 256 + 64 * h + 4 * d4); }
    if (tid < 32) f.bias = *(const f32x4*)(((tid >> 4) ? p.gla_bias_b : p.gla_bias_f) + 64 * h + 4 * (tid & 15));
    if (S3 && tid >= 64 && tid < 96) f.gnw = *(const f32x4*)(p.gla_norm_w + 4 * (tid - 64));
}
template <bool S3>
__device__ __forceinline__ void gla_pf_store(const GlaPF& f, LAS unsigned char* l, int tid) {
    { const int row = tid >> 3, ch = tid & 7; *(LAS u32x4*)(l + G_KR + row * G_RS + ch * 16) = f.k; if (S3) *(LAS u32x4*)(l + G_QR + row * G_RS + ch * 16) = f.q; }
    if (tid < 256) { const int row = tid >> 2, ch = tid & 3; *(LAS u32x4*)(l + G_RFB + row * G_RSR + ch * 16) = f.rf; }
    *(LAS f32x4*)(l + G_UP + tid * 16) = f.up;
    if (tid < 32) *(LAS f32x4*)(l + G_BIAS + tid * 16) = f.bias;
    if (S3 && tid >= 64 && tid < 96) *(LAS f32x4*)(l + G_GNW + (tid - 64) * 16) = f.gnw;
}
#define LBAR() do { asm volatile("s_waitcnt lgkmcnt(0)" ::: "memory"); __builtin_amdgcn_s_barrier(); asm volatile("" ::: "memory"); } while (0)
template <bool S3>
__device__ __forceinline__ void gla_prep(LAS unsigned char* l, int lane, int w, int h, float* gdec_out) {
    const int dir = w >> 2, dq = w & 3;
    float rv[16];
    { const LAS unsigned char* rp = l + G_RFB + lane * G_RSR + 32 * dir; unpack8(*(const LAS u32x4*)rp, rv); unpack8(*(const LAS u32x4*)(rp + 16), rv + 8); }
    const LAS float* UPL = (const LAS float*)(l + G_UP) + dir * 1024; const LAS float* BIASL = (const LAS float*)(l + G_BIAS) + dir * 64;
#pragma unroll
    for (int grp = 0; grp < 4; ++grp) {
        float lgv[4];
#pragma unroll
        for (int q = 0; q < 4; ++q) {
            const int d = 16 * dq + 4 * grp + q;
            float z = BIASL[d];
#pragma unroll
            for (int r = 0; r < 16; ++r) z += rv[r] * UPL[r * 64 + d];
            lgv[q] = -(fmaxf(-z, 0.f) + __logf(1.0f + __expf(-fabsf(z)))) * 0.0625f;
        }
        __builtin_amdgcn_sched_barrier(0);
        const u32x2 kraw = *(const LAS u32x2*)(l + G_KR + lane * G_RS + 32 * dq + 8 * grp);
        const float kv[4] = {bflo(kraw.x), bfhi(kraw.x), bflo(kraw.y), bfhi(kraw.y)};
        float qv[4] = {0.f, 0.f, 0.f, 0.f};
        if (S3) { const u32x2 qraw = *(const LAS u32x2*)(l + G_QR + lane * G_RS + 32 * dq + 8 * grp); qv[0] = bflo(qraw.x); qv[1] = bfhi(qraw.x); qv[2] = bflo(qraw.y); qv[3] = bfhi(qraw.y); }
        float qd[4], kd[4];
#pragma unroll
        for (int q = 0; q < 4; ++q) {
            const int d = 16 * dq + 4 * grp + q;
            const float lg = lgv[q];
            float tot;
            const float incl = wave_incl_scan_tot(lg, lane, tot);
            const float G = dir ? (tot - incl + lg) : incl;
            if (!S3) {
                const float kp = kv[q] * __expf(tot - G);
                *(LAS bf16_t*)(l + G_QF + (dir * 64 + d) * G_RS + lane * 2) = f2bf(kp);
                if (lane == 0) gdec_out[dir * 256 + h * 64 + d] = __expf(tot);
            } else {
                qd[q] = qv[q] * 0.125f * __expf(G); kd[q] = kv[q] * __expf(-G);
            }
        }
        if (S3) {
            u32x2 qo, ko; qo.x = cvt_pk_bf16(qd[0], qd[1]); qo.y = cvt_pk_bf16(qd[2], qd[3]); ko.x = cvt_pk_bf16(kd[0], kd[1]); ko.y = cvt_pk_bf16(kd[2], kd[3]);
            *(LAS u32x2*)(l + (dir ? G_QB : G_QF) + lane * G_RS + 32 * dq + 8 * grp) = qo;
            *(LAS u32x2*)(l + (dir ? G_KB : G_KF) + lane * G_RS + 32 * dq + 8 * grp) = ko;
        }
        __builtin_amdgcn_sched_barrier(0);
    }
}
__device__ __forceinline__ void gla_s1_item(const Params& p, int item, int next_item, GlaPF& pf, LAS unsigned char* l, unsigned lbase, int tid) {
    const int lane = tid & 63, w = __builtin_amdgcn_readfirstlane(tid >> 6);
    const int h = item & 3, c = (item >> 2) & 63, seq = item >> 8, r0 = seq * 4096 + c * 64;
    const bf16_t* proj = (const bf16_t*)(p.ws + WS_PROJ);
    float* gdec = (float*)(p.ws + WS_GDEC) + (size_t)((seq * 64 + c) * 2) * 256;
    gla_pf_store<false>(pf, l, tid);
    u32x4 vr[2];
#pragma unroll
    for (int k = 0; k < 2; ++k) { const int i = tid + 512 * k, row = i >> 4, ch = i & 15; vr[k] = *(const u32x4*)(proj + (size_t)(r0 + row) * PC + C_V + 128 * h + ch * 8); }
    LBAR();
    gla_prep<false>(l, lane, w, h, gdec);
#pragma unroll
    for (int k = 0; k < 2; ++k) { const int i = tid + 512 * k, row = i >> 4, ch = i & 15; *(LAS u32x4*)(l + G_V + row * G_RSV + ch * 16) = vr[k]; }
    if (next_item >= 0) gla_pf_load<false>(pf, p, next_item, tid);
    LBAR();
    const int dir = w >> 2, dvb0 = (w & 3) * 2, g = lane >> 4, ln = lane & 15;
    LAS unsigned char* stg = l + G_STG1 + w * 4608;
#pragma unroll
    for (int i = 0; i < 2; ++i) {
        bf16x8 A[2];
#pragma unroll
        for (int ks = 0; ks < 2; ++ks) A[ks] = frag_tr(lbase + G_V, G_RSV, 32 * ks, 16 * (dvb0 + i), lane);
#pragma unroll
        for (int n = 0; n < 4; ++n) { f32x4 acc = {0.f, 0.f, 0.f, 0.f};
#pragma unroll
            for (int ks = 0; ks < 2; ++ks) acc = MFMA16(A[ks], frag_row(l + G_QF + dir * 64 * G_RS, G_RS, 16 * n, 32 * ks, lane), acc);
#pragma unroll
            for (int r = 0; r < 4; ++r) *(LAS bf16_t*)(stg + (16 * i + 4 * g + r) * G_RS + (16 * n + ln) * 2) = f2bf(acc[r]); }
    }
    asm volatile("" ::: "memory");
    bf16_t* GS = (bf16_t*)(p.ws + WS_GS) + ((size_t)(((seq * 64 + c) * 2 + dir) * 4 + h)) * 8192 + (size_t)dvb0 * 16 * 64;
#pragma unroll
    for (int k = 0; k < 4; ++k) { const int i = lane + 64 * k, row = i >> 3, ch = i & 7; *(u32x4*)(GS + row * 64 + ch * 8) = *(const LAS u32x4*)(stg + row * G_RS + ch * 16); }
    LBAR();
}
__device__ __forceinline__ void gla_s3_item(const Params& p, int item, int next_item, GlaPF& pf, LAS unsigned char* l, unsigned lbase, int tid) {
    const int lane = tid & 63, w = __builtin_amdgcn_readfirstlane(tid >> 6);
    const int h = item & 3, c = (item >> 2) & 63, seq = item >> 8, r0 = seq * 4096 + c * 64;
    const bf16_t* proj = (const bf16_t*)(p.ws + WS_PROJ);
    gla_pf_store<true>(pf, l, tid);
    u32x4 vr[2], ogr[2], str[4];
    const bf16_t* GSb = (const bf16_t*)(p.ws + WS_GS);
#pragma unroll
    for (int k = 0; k < 2; ++k) { const int i = tid + 512 * k, row = i >> 4, ch = i & 15; const bf16_t* pr = proj + (size_t)(r0 + row) * PC;
        vr[k] = *(const u32x4*)(pr + C_V + 128 * h + ch * 8); ogr[k] = *(const u32x4*)(pr + C_OG + 128 * h + ch * 8); }
#pragma unroll
    for (int k = 0; k < 4; ++k) { const int i = tid + 512 * k, dir = i >> 10, row = (i >> 3) & 127, ch = i & 7;
        str[k] = *(const u32x4*)(GSb + ((size_t)(((seq * 64 + c) * 2 + dir) * 4 + h)) * 8192 + row * 64 + ch * 8); }
    const int g = lane >> 4, ln = lane & 15, tb = w >> 1, dvh = w & 1;
    LBAR();
    gla_prep<true>(l, lane, w, h, nullptr);
#pragma unroll
    for (int k = 0; k < 2; ++k) { const int i = tid + 512 * k, row = i >> 4, ch = i & 15; *(LAS u32x4*)(l + G_V + row * G_RSV + ch * 16) = vr[k]; *(LAS u32x4*)(l + G_OGR + row * G_RSV + ch * 16) = ogr[k]; }
#pragma unroll
    for (int k = 0; k < 4; ++k) { const int i = tid + 512 * k, dir = i >> 10, row = (i >> 3) & 127, ch = i & 7; *(LAS u32x4*)(l + (dir ? G_SBT : G_SFT) + row * G_RS + ch * 16) = str[k]; }
    if (next_item >= 0) gla_pf_load<true>(pf, p, next_item, tid);
    LBAR();
    {
        const int ti = w >> 1;
#pragma unroll
        for (int k = 0; k < 2; ++k) { const int si = 2 * (w & 1) + k; f32x4 af = {0.f, 0.f, 0.f, 0.f}, ab = {0.f, 0.f, 0.f, 0.f};
            if (ti >= si) {
#pragma unroll
                for (int ks = 0; ks < 2; ++ks) af = MFMA16(frag_row(l + G_QF, G_RS, 16 * ti, 32 * ks, lane), frag_row(l + G_KF, G_RS, 16 * si, 32 * ks, lane), af); }
            if (ti <= si) {
#pragma unroll
                for (int ks = 0; ks < 2; ++ks) ab = MFMA16(frag_row(l + G_QB, G_RS, 16 * ti, 32 * ks, lane), frag_row(l + G_KB, G_RS, 16 * si, 32 * ks, lane), ab); }
#pragma unroll
            for (int r = 0; r < 4; ++r) { const int t = 16 * ti + 4 * g + r, s = 16 * si + ln; *(LAS bf16_t*)(l + G_ATT + t * G_RS + s * 2) = f2bf(s <= t ? af[r] : ab[r]); }
        }
    }
    LBAR();
    f32x4 acc[4];
#pragma unroll
    for (int i = 0; i < 4; ++i) acc[i] = (f32x4){0.f, 0.f, 0.f, 0.f};
#pragma unroll
    for (int ks = 0; ks < 2; ++ks) {
        const bf16x8 a_att = frag_row(l + G_ATT, G_RS, 16 * tb, 32 * ks, lane), a_qf = frag_row(l + G_QF, G_RS, 16 * tb, 32 * ks, lane), a_qb = frag_row(l + G_QB, G_RS, 16 * tb, 32 * ks, lane);
        bf16x8 vb[4]; frag_tr4(vb, lbase + G_V, G_RSV, 32 * ks, 64 * dvh, 16, lane);
#pragma unroll
        for (int i = 0; i < 4; ++i) { const int dvb = dvh * 4 + i;
            acc[i] = MFMA16(a_att, vb[i], acc[i]);
            acc[i] = MFMA16(a_qf, frag_row(l + G_SFT, G_RS, 16 * dvb, 32 * ks, lane), acc[i]);
            acc[i] = MFMA16(a_qb, frag_row(l + G_SBT, G_RS, 16 * dvb, 32 * ks, lane), acc[i]); }
    }
#pragma unroll
    for (int r = 0; r < 4; ++r) { float s = 0.f;
#pragma unroll
        for (int i = 0; i < 4; ++i) s += acc[i][r] * acc[i][r];
        s += shfl_idx(s, lane ^ 1); s += shfl_idx(s, lane ^ 2); s += shfl_idx(s, lane ^ 4); s += shfl_idx(s, lane ^ 8);
        if (ln == 0) *(LAS float*)(l + G_SSQ + ((16 * tb + 4 * g + r) * 2 + dvh) * 4) = s; }
    LBAR();
    LAS unsigned char* stg = l + G_STG3 + w * 2304;
#pragma unroll
    for (int r = 0; r < 4; ++r) { const int t = 16 * tb + 4 * g + r; const LAS float* sp = (const LAS float*)(l + G_SSQ + t * 8);
        const float rstd = rsqrtf((sp[0] + sp[1]) * (1.0f / 128.0f) + EPS);
#pragma unroll
        for (int i = 0; i < 4; ++i) { const int dvl = 16 * i + ln; const float og = bf2f(*(const LAS bf16_t*)(l + G_OGR + t * G_RSV + (64 * dvh + dvl) * 2));
            *(LAS bf16_t*)(stg + (4 * g + r) * G_RS + dvl * 2) = f2bf(acc[i][r] * rstd * ((const LAS float*)(l + G_GNW))[64 * dvh + dvl] * siluf_(og)); } }
    asm volatile("" ::: "memory");
    bf16_t* OG = (bf16_t*)(p.ws + WS_OG) + (size_t)(r0 + 16 * tb) * 512 + 128 * h + 64 * dvh;
#pragma unroll
    for (int k = 0; k < 2; ++k) { const int i = lane + 64 * k, row = i >> 3, ch = i & 7; *(u32x4*)(OG + (size_t)row * 512 + ch * 8) = *(const LAS u32x4*)(stg + row * G_RS + ch * 16); }
    LBAR();
}

constexpr int S_XS = 0, S_BM = 67584, S_CM = 86016, S_MB = 104448, S_DT = 139264, S_AC = 143360, S_W8 = 147456, S_RSX = 528, S_RS = 144, S_RSM = 272;
template <bool S3>
__device__ __forceinline__ void ssd_prep(const Params& p, const bf16_t* proj, int seq, int c, int gi, LAS unsigned char* l, int tid, float* sdec_out) {
    const int lane = tid & 63, w = __builtin_amdgcn_readfirstlane(tid >> 6);
    const int tok0 = c * 128; constexpr int NV = S3 ? 48 : 40, NST = S3 ? 10 : 12, TS = S3 ? 13 : 11;
    const int dir = w >> 2, j = w & 3, hd = 4 * gi + j, r0 = seq * 4096 + tok0;
    const int dcol = (dir ? C_DTB : C_DTF) + hd;
    const float raw0 = bf2f(proj[(size_t)(r0 + lane) * PC + dcol]), raw1 = bf2f(proj[(size_t)(r0 + lane + 64) * PC + dcol]);
    const float dtb = (dir ? p.dt_bias_b : p.dt_bias_f)[hd], alog = (dir ? p.a_log_b : p.a_log_f)[hd];
    if (tid < NV * NST) {
        const int cv = tid % NV, t0 = (tid / NV) * TS;
        const int col = cv < 32 ? C_XBC + 256 * gi + 8 * cv : (cv < 40 ? C_BM + 64 * gi + 8 * (cv - 32) : C_CM + 64 * gi + 8 * (cv - 40));
        const int ch = col - C_XBC;
        u32x4 raw[TS + 4];
#pragma unroll
        for (int i = 0; i < TS + 4; ++i) { const int tt = tok0 + t0 + i - 2; raw[i] = (u32x4){0u, 0u, 0u, 0u};
            if (tt >= 0 && tt < 4096 && t0 + i - 2 < 130) raw[i] = *(const u32x4*)(proj + (size_t)(seq * 4096 + tt) * PC + col); }
        typedef float f32x2 __attribute__((ext_vector_type(2)));
        f32x2 wv[5][4], bv[4];
#pragma unroll
        for (int i = 0; i < 5; ++i) { const f32x4 a = *(const f32x4*)(p.conv_w + i * 1536 + ch), b = *(const f32x4*)(p.conv_w + i * 1536 + ch + 4);
            wv[i][0] = (f32x2){a[0], a[1]}; wv[i][1] = (f32x2){a[2], a[3]}; wv[i][2] = (f32x2){b[0], b[1]}; wv[i][3] = (f32x2){b[2], b[3]}; }
        { const f32x4 a = *(const f32x4*)(p.conv_b + ch), b = *(const f32x4*)(p.conv_b + ch + 4); bv[0] = (f32x2){a[0], a[1]}; bv[1] = (f32x2){a[2], a[3]}; bv[2] = (f32x2){b[0], b[1]}; bv[3] = (f32x2){b[2], b[3]}; }
        LAS unsigned char* dst0 = cv < 32 ? l + S_XS + cv * 16 : (cv < 40 ? l + S_BM + (cv - 32) * 16 : l + S_CM + (cv - 40) * 16); const int drs = cv < 32 ? S_RSX : S_RS;
        f32x2 xw[5][4];
#pragma unroll
        for (int i = 0; i < 4; ++i) { const u32x4 rr = raw[i]; xw[i][0] = (f32x2){bflo(rr.x), bfhi(rr.x)}; xw[i][1] = (f32x2){bflo(rr.y), bfhi(rr.y)}; xw[i][2] = (f32x2){bflo(rr.z), bfhi(rr.z)}; xw[i][3] = (f32x2){bflo(rr.w), bfhi(rr.w)}; }
#pragma unroll
        for (int o = 0; o < TS; ++o) { const int t = t0 + o;
            { const u32x4 rr = raw[o + 4]; xw[4][0] = (f32x2){bflo(rr.x), bfhi(rr.x)}; xw[4][1] = (f32x2){bflo(rr.y), bfhi(rr.y)}; xw[4][2] = (f32x2){bflo(rr.z), bfhi(rr.z)}; xw[4][3] = (f32x2){bflo(rr.w), bfhi(rr.w)}; }
            if (t < 128) { u32x4 pk;
#pragma unroll
                for (int k = 0; k < 4; ++k) { f32x2 a = bv[k];
#pragma unroll
                    for (int i = 0; i < 5; ++i) a = xw[i][k] * wv[i][k] + a;
                    const unsigned pw = cvt_pk_bf16(siluf_(a[0]), siluf_(a[1])); if (k == 0) pk.x = pw; else if (k == 1) pk.y = pw; else if (k == 2) pk.z = pw; else pk.w = pw; }
                *(LAS u32x4*)(dst0 + t * drs) = pk; }
#pragma unroll
            for (int i = 0; i < 4; ++i)
#pragma unroll
                for (int k = 0; k < 4; ++k) xw[i][k] = xw[i + 1][k];
        }
    }
    {
        const float A = -__expf(alog);
        const float dt0 = softplusf_(raw0 + dtb), dt1 = softplusf_(raw1 + dtb);
        const float la0 = dt0 * A, la1 = dt1 * A;
        float tot0, tot1; const float s0 = wave_incl_scan_tot(la0, lane, tot0), s1 = wave_incl_scan_tot(la1, lane, tot1); const float total = tot0 + tot1;
        float ac0, ac1;
        if (dir == 0) { ac0 = s0; ac1 = tot0 + s1; } else { ac0 = total - (s0 - la0); ac1 = total - (tot0 + s1 - la1); }
        LAS float* DT = (LAS float*)(l + S_DT) + (dir * 4 + j) * 128; LAS float* AC = (LAS float*)(l + S_AC) + (dir * 4 + j) * 128;
        DT[lane] = dt0; DT[lane + 64] = dt1; AC[lane] = ac0; AC[lane + 64] = ac1;
        if (!S3) { LAS float* W8 = (LAS float*)(l + S_W8) + (dir * 4 + j) * 128; W8[lane] = dt0 * __expf(total - ac0); W8[lane + 64] = dt1 * __expf(total - ac1);
            if (lane == 0) sdec_out[dir * 16 + hd] = __expf(total); }
    }
}
__device__ __forceinline__ void ssd_s1_item(const Params& p, int item, LAS unsigned char* l, unsigned lbase, int tid) {
    const int lane = tid & 63, w = __builtin_amdgcn_readfirstlane(tid >> 6);
    const int gi = item & 3, c = (item >> 2) & 31, seq = item >> 7;
    const bf16_t* proj = (const bf16_t*)(p.ws + WS_PROJ);
    float* sdec = (float*)(p.ws + WS_SDEC) + (size_t)((seq * 32 + c) * 2) * 16;
    ssd_prep<false>(p, proj, seq, c, gi, l, tid, sdec);
    __syncthreads();
    const int dir = w >> 2, j = w & 3, hd = 4 * gi + j, g = lane >> 4, ln = lane & 15;
    f32x4 acc[4][4];
#pragma unroll
    for (int a = 0; a < 4; ++a)
#pragma unroll
        for (int b = 0; b < 4; ++b) acc[a][b] = (f32x4){0.f, 0.f, 0.f, 0.f};
#pragma unroll
    for (int ks = 0; ks < 4; ++ks) {
        bf16x8 A[4], B[4], Braw[4];
        frag_tr4(A, lbase + S_XS, S_RSX, 32 * ks, 64 * j, 16, lane);
        frag_tr4(Braw, lbase + S_BM, S_RS, 32 * ks, 0, 16, lane);
        const LAS float* wp = (const LAS float*)(l + S_W8) + (dir * 4 + j) * 128 + 32 * ks + 8 * g;
        const f32x4 w0 = *(const LAS f32x4*)wp, w1 = *(const LAS f32x4*)(wp + 4);
#pragma unroll
        for (int ni = 0; ni < 4; ++ni) { const bf16x8 b = Braw[ni]; float o[8];
#pragma unroll
            for (int jj = 0; jj < 8; ++jj) o[jj] = bf2f((unsigned short)b[jj]) * (jj < 4 ? w0[jj & 3] : w1[jj & 3]);
            const u32x4 pk = pack8(o); B[ni] = __builtin_bit_cast(bf16x8, pk); }
#pragma unroll
        for (int pi = 0; pi < 4; ++pi)
#pragma unroll
            for (int ni = 0; ni < 4; ++ni) acc[pi][ni] = MFMA16(A[pi], B[ni], acc[pi][ni]);
    }
    __syncthreads();
    LAS unsigned char* stg = l + S_XS + w * 9216;
#pragma unroll
    for (int pi = 0; pi < 4; ++pi)
#pragma unroll
        for (int ni = 0; ni < 4; ++ni)
#pragma unroll
            for (int r = 0; r < 4; ++r) *(LAS bf16_t*)(stg + (16 * pi + 4 * g + r) * S_RS + (16 * ni + ln) * 2) = f2bf(acc[pi][ni][r]);
    asm volatile("" ::: "memory");
    bf16_t* SS = (bf16_t*)(p.ws + WS_SS) + ((size_t)(((seq * 32 + c) * 2 + dir) * 16 + hd)) * 4096;
#pragma unroll
    for (int k = 0; k < 8; ++k) { const int i = lane + 64 * k, row = i >> 3, ch = i & 7; *(u32x4*)(SS + row * 64 + ch * 8) = *(const LAS u32x4*)(stg + row * S_RS + ch * 16); }
    __syncthreads();
}
__device__ __forceinline__ void ssd_s3_item(const Params& p, int row0, int item, LAS unsigned char* l, unsigned lbase, int tid) {
    const int lane = tid & 63, w = __builtin_amdgcn_readfirstlane(tid >> 6);
    const int gi = item & 3, c = (item >> 2) & 31, seq = item >> 7, r0 = seq * 4096 + c * 128;
    const bf16_t* proj = (const bf16_t*)(p.ws + WS_PROJ);
    const bf16_t* SSb = (const bf16_t*)(p.ws + WS_SS);
    const int sdir = tid >> 8, si_ = tid & 255, srow0 = si_ >> 3, sch = si_ & 7;
    const bf16_t* sp0 = SSb + ((size_t)(((seq * 32 + c) * 2 + sdir) * 16 + 4 * gi)) * 4096 + srow0 * 64 + sch * 8;
    u32x4 sa = *(const u32x4*)sp0, sb = *(const u32x4*)(sp0 + 32 * 64);
    ssd_prep<true>(p, proj, seq, c, gi, l, tid, nullptr);
    __syncthreads();
    const int g = lane >> 4, ln = lane & 15;
    f32x4 cb[8];
#pragma unroll
    for (int si = 0; si < 8; ++si) { cb[si] = (f32x4){0.f, 0.f, 0.f, 0.f};
#pragma unroll
        for (int ks = 0; ks < 2; ++ks) cb[si] = MFMA16(frag_row(l + S_CM, S_RS, 16 * w, 32 * ks, lane), frag_row(l + S_BM, S_RS, 16 * si, 32 * ks, lane), cb[si]); }
    __syncthreads();
    bf16_t* Y = (bf16_t*)(p.ws + WS_Y);
    const int erow = lane >> 2, epc = lane & 3;
    float ssq = 0.f;
    for (int j = 0; j < 4; ++j) {
        const int hd = 4 * gi + j;
        *(LAS u32x4*)(l + S_BM + sdir * 9216 + srow0 * S_RS + sch * 16) = sa; *(LAS u32x4*)(l + S_BM + sdir * 9216 + (srow0 + 32) * S_RS + sch * 16) = sb;
        if (j < 3) { sa = *(const u32x4*)(sp0 + (size_t)(j + 1) * 4096); sb = *(const u32x4*)(sp0 + (size_t)(j + 1) * 4096 + 32 * 64); }
        const bf16_t* zp = proj + (size_t)(r0 + 16 * w + erow) * PC + C_Z + 64 * hd + 16 * epc;
        const u32x4 z0 = *(const u32x4*)zp, z1 = *(const u32x4*)(zp + 8);
        const LAS float* DTf = (const LAS float*)(l + S_DT) + j * 128; const LAS float* DTb = DTf + 512;
        const LAS float* ACf = (const LAS float*)(l + S_AC) + j * 128; const LAS float* ACb = ACf + 512;
        const float dsk = p.d_skip[hd];
#pragma unroll
        for (int si = 0; si < 8; ++si) { const int s = 16 * si + ln;
            if (si < w) { const float afs = ACf[s], dfs = DTf[s];
#pragma unroll
                for (int r = 0; r < 4; ++r) { const int lr = 16 * w + 4 * g + r; *(LAS bf16_t*)(l + S_MB + lr * S_RSM + s * 2) = f2bf(cb[si][r] * __expf(ACf[lr] - afs) * dfs); } }
            else if (si > w) { const float abs_ = ACb[s], dbs = DTb[s];
#pragma unroll
                for (int r = 0; r < 4; ++r) { const int lr = 16 * w + 4 * g + r; *(LAS bf16_t*)(l + S_MB + lr * S_RSM + s * 2) = f2bf(cb[si][r] * __expf(ACb[lr] - abs_) * dbs); } }
            else { const float afs = ACf[s], abs_ = ACb[s], dfs = DTf[s], dbs = DTb[s];
#pragma unroll
                for (int r = 0; r < 4; ++r) { const int lr = 16 * w + 4 * g + r;
                    const float wt = (s <= lr) ? __expf(ACf[lr] - afs) * dfs : __expf(ACb[lr] - abs_) * dbs;
                    const float v = cb[si][r] * wt + (s == lr ? dsk : 0.f);
                    *(LAS bf16_t*)(l + S_MB + lr * S_RSM + s * 2) = f2bf(v); } } }
        __syncthreads();
        f32x4 ay[4], af[4], ab[4];
#pragma unroll
        for (int pi = 0; pi < 4; ++pi) { ay[pi] = (f32x4){0.f, 0.f, 0.f, 0.f}; af[pi] = ay[pi]; ab[pi] = ay[pi]; }
#pragma unroll
        for (int ks = 0; ks < 4; ++ks) { const bf16x8 am = frag_row(l + S_MB, S_RSM, 16 * w, 32 * ks, lane); bf16x8 xb[4]; frag_tr4(xb, lbase + S_XS, S_RSX, 32 * ks, 64 * j, 16, lane);
#pragma unroll
            for (int pi = 0; pi < 4; ++pi) ay[pi] = MFMA16(am, xb[pi], ay[pi]); }
#pragma unroll
        for (int ks = 0; ks < 2; ++ks) { const bf16x8 ac = frag_row(l + S_CM, S_RS, 16 * w, 32 * ks, lane);
#pragma unroll
            for (int pi = 0; pi < 4; ++pi) { af[pi] = MFMA16(ac, frag_row(l + S_BM, S_RS, 16 * pi, 32 * ks, lane), af[pi]);
                ab[pi] = MFMA16(ac, frag_row(l + S_BM + 9216, S_RS, 16 * pi, 32 * ks, lane), ab[pi]); } }
#pragma unroll
        for (int r = 0; r < 4; ++r) { const int lr = 16 * w + 4 * g + r; const float ef = __expf(ACf[lr]), eb = __expf(ACb[lr]);
#pragma unroll
            for (int pi = 0; pi < 4; ++pi) *(LAS float*)(l + S_MB + lr * S_RSM + (16 * pi + ln) * 4) = ay[pi][r] + ef * af[pi][r] + eb * ab[pi][r]; }
        asm volatile("" ::: "memory");
        {   float zv[16], yv[16];
            unpack8(z0, zv); unpack8(z1, zv + 8);
            const LAS unsigned char* yp = l + S_MB + (16 * w + erow) * S_RSM + epc * 64;
#pragma unroll
            for (int q = 0; q < 4; ++q) { const f32x4 t4 = *(const LAS f32x4*)(yp + 16 * q); yv[4 * q] = t4[0]; yv[4 * q + 1] = t4[1]; yv[4 * q + 2] = t4[2]; yv[4 * q + 3] = t4[3]; }
#pragma unroll
            for (int q = 0; q < 16; ++q) { yv[q] *= siluf_(zv[q]); ssq += yv[q] * yv[q]; }
            bf16_t* yo = Y + (size_t)(r0 + 16 * w + erow) * 1024 + 64 * hd + 16 * epc;
            *(u32x4*)yo = pack8(yv); *(u32x4*)(yo + 8) = pack8(yv + 8); }
        __syncthreads();
    }
    float* rssy = (float*)(p.ws + WS_RSSY) + (size_t)row0;
    ssq += shfl_idx(ssq, lane ^ 1); ssq += shfl_idx(ssq, lane ^ 2);
    if (epc == 0) atomicAdd(rssy + r0 + 16 * w + erow, ssq);
}

template <bool GLA>
__device__ __forceinline__ void scan_job(bf16_t* base, const float* dec, int dir) {
    constexpr int NCH = GLA ? 64 : 32; constexpr size_t CST = GLA ? 65536 : 131072; constexpr int DST = GLA ? 512 : 32; constexpr int UN = 4;
    float run[8];
#pragma unroll
    for (int e = 0; e < 8; ++e) run[e] = 0.f;
    const long long cstep = dir ? -(long long)CST : (long long)CST; const int dstep = dir ? -DST : DST;
    bf16_t* bp = base + (dir ? (size_t)(NCH - 1) * CST : 0); const float* dp = dec + (dir ? (NCH - 1) * DST : 0);
    for (int c0 = 0; c0 < NCH; c0 += UN) {
        u32x4 loc[UN]; f32x4 d0[UN], d1[UN];
#pragma unroll
        for (int u = 0; u < UN; ++u) { loc[u] = *(const u32x4*)(bp + u * cstep);
            if (GLA) { d0[u] = *(const f32x4*)(dp + u * dstep); d1[u] = *(const f32x4*)(dp + u * dstep + 4); } else { const float dv = dp[u * dstep]; d0[u] = (f32x4){dv, dv, dv, dv}; d1[u] = d0[u]; } }
#pragma unroll
        for (int u = 0; u < UN; ++u) { float lv[8]; unpack8(loc[u], lv);
            *(u32x4*)(bp + u * cstep) = pack8(run);
#pragma unroll
            for (int e = 0; e < 8; ++e) run[e] = (e < 4 ? d0[u][e & 3] : d1[u][e & 3]) * run[e] + lv[e]; }
        bp += UN * cstep; dp += UN * dstep;
    }
}
__device__ __forceinline__ void phase_scan(const Params& p, int nseq, int tid) {
    const int NG = nseq * 8192, NS = nseq * 16384;
    const int gt = blockIdx.x * 512 + tid, GT = gridDim.x * 512;
    for (int job = gt; job < NG + NS; job += GT) {
        if (job < NG) { const int e8 = job & 1023, h = (job >> 10) & 3, dir = (job >> 12) & 1, seq = job >> 13;
            scan_job<true>((bf16_t*)(p.ws + WS_GS) + ((size_t)((seq * 64 * 2 + dir) * 4 + h)) * 8192 + e8 * 8, (const float*)(p.ws + WS_GDEC) + (size_t)((seq * 64 * 2 + dir) * 4 + h) * 64 + ((e8 * 8) & 63), dir);
        } else { const int j2 = job - NG, e8 = j2 & 511, hd = (j2 >> 9) & 15, dir = (j2 >> 13) & 1, seq = j2 >> 14;
            scan_job<false>((bf16_t*)(p.ws + WS_SS) + ((size_t)((seq * 32 * 2 + dir) * 16 + hd)) * 4096 + e8 * 8, (const float*)(p.ws + WS_SDEC) + (size_t)((seq * 32 * 2 + dir) * 16 + hd), dir); }
    }
}

constexpr int LDS_BYTES = 160 * 1024;
#if defined(__HIP_DEVICE_COMPILE__)
typedef const __attribute__((address_space(4))) Params* KP;
#define KPARAMS() ({ unsigned long long k_ = (unsigned long long)__builtin_amdgcn_kernarg_segment_ptr(); asm volatile("" : "+s"(k_)); *(KP)k_; })
#define KWS() ({ unsigned long long k_ = (unsigned long long)__builtin_amdgcn_kernarg_segment_ptr(); asm volatile("" : "+s"(k_)); (unsigned char*)*(const __attribute__((address_space(4))) unsigned long long*)(k_ + 26 * 8); })
#else
#define KPARAMS() (p_unused)
#define KWS() (p_unused.ws)
#endif
#define GBAR() do { XcdBarrier b_; b_.bar = (unsigned*)(KWS() + WS_BAR); b_.x = xb_xcc_id(); b_.st = (volatile LAS unsigned*)(l + LDS_BYTES - 16); xcd_barrier(b_); } while (0)
#define OTID() ({ int t_ = threadIdx.x; asm volatile("" : "+v"(t_)); t_; })

template <int hb>
__device__ __forceinline__ void half_pass(const Params& p_unused, LAS unsigned char* l, const unsigned lbase, cg::grid_group& grid, const int G, const int bx) {
        constexpr int ROW0 = PASS_ROW0[hb], NR = PASS_ROWS[hb], NSQ = PASS_SEQ[hb], NSSD = NSQ * 128, NIT = NSQ * 384;
        { const Params q = KPARAMS(); phase_u(q, ROW0, NR, OTID()); }
        if (hb == 0) grid.sync(); else GBAR();
        {
            const Params q = KPARAMS(); unsigned char* ws = q.ws; bf16_t* PROJ = (bf16_t*)(ws + WS_PROJ);
            pg8::Gemm g{(const bf16_t*)(ws + WS_U), (const bf16_t*)(ws + WS_WIN), NR, 6400, 1024}; pg8::StaticOrder S; S.init(NR, 6400, G, bx);
            EpiProj E{PROJ}; pg8::gemm_phase<EpiProj, pg8::StaticOrder, true, true>(l, g, S, E);
        }
        GBAR();
        {   GlaPF pf; const int itg0 = bx + ((NSSD - bx + G - 1) / G) * G;
            if (itg0 < NIT) { const Params p = KPARAMS(); gla_pf_load<false>(pf, p, itg0 - NSSD, OTID()); }
            for (int it = bx; it < NIT; it += G) { const Params p = KPARAMS(); const int tid = OTID(); if (it < NSSD) ssd_s1_item(p, it, l, lbase, tid); else gla_s1_item(p, it - NSSD, it + G < NIT ? it + G - NSSD : -1, pf, l, lbase, tid); }
        }
        GBAR();
        { const Params q = KPARAMS(); phase_scan(q, NSQ, OTID()); }
        GBAR();
        {   GlaPF pf; const int itg0 = bx + ((NSSD - bx + G - 1) / G) * G;
            if (itg0 < NIT) { const Params p = KPARAMS(); gla_pf_load<true>(pf, p, itg0 - NSSD, OTID()); }
            for (int it = bx; it < NIT; it += G) { const Params p = KPARAMS(); const int tid = OTID(); if (it < NSSD) ssd_s3_item(p, ROW0, it, l, lbase, tid); else gla_s3_item(p, it - NSSD, it + G < NIT ? it + G - NSSD : -1, pf, l, lbase, tid); }
        }
        GBAR();
        {
            const Params p = KPARAMS(); unsigned char* ws = p.ws; bf16_t* PROJ = (bf16_t*)(ws + WS_PROJ);
            pg8::StaticOrder S; S.init(NR, 1024, G, bx);
            pg8::Gemm g1{(const bf16_t*)(ws + WS_OG), (const bf16_t*)(ws + WS_WB1), NR, 1024, 512};
            EpiM1 E1{PROJ, (bf16_t*)(ws + WS_T)}; pg8::gemm_phase<EpiM1, pg8::StaticOrder, true, true>(l, g1, S, E1);
            pg8::Gemm g2{(const bf16_t*)(ws + WS_Y), (const bf16_t*)(ws + WS_WB2), NR, 1024, 1024};
            EpiM2 E2{PROJ, (const bf16_t*)(ws + WS_T), (bf16_t*)(ws + WS_MM), (const float*)(ws + WS_RSSY) + (size_t)ROW0}; pg8::gemm_phase<EpiM2, pg8::StaticOrder, true, true>(l, g2, S, E2);
        }
        GBAR();
        {
            const Params p = KPARAMS(); unsigned char* ws = p.ws; bf16_t* PROJ = (bf16_t*)(ws + WS_PROJ);
            pg8::StaticOrder S; S.init(NR, 1024, G, bx);
            pg8::Gemm g{(const bf16_t*)(ws + WS_MM), (const bf16_t*)(ws + WS_WOUT), NR, 1024, 1024};
            EpiOut E{p, ROW0, (bf16_t*)(ws + WS_X1B), (float*)(ws + WS_RSS1)}; pg8::gemm_phase<EpiOut, pg8::StaticOrder, true, true>(l, g, S, E);
        }
        GBAR();
        {
            const Params p = KPARAMS(); unsigned char* ws = p.ws; bf16_t* PROJ = (bf16_t*)(ws + WS_PROJ);
            pg8::StaticOrder S; S.init(NR, 5632, G, bx);
            pg8::Gemm g{(const bf16_t*)(ws + WS_X1B), (const bf16_t*)(ws + WS_WGU), NR, 5632, 1024};
            EpiSwi E{(const float*)(ws + WS_RSS1) + (size_t)ROW0, PROJ}; pg8::gemm_phase<EpiSwi, pg8::StaticOrder, true, true>(l, g, S, E);
        }
        GBAR();
        {
            const Params p = KPARAMS(); unsigned char* ws = p.ws; bf16_t* PROJ = (bf16_t*)(ws + WS_PROJ);
            pg8::StaticOrder S; S.init(NR, 1024, G, bx);
            pg8::Gemm g{(const bf16_t*)PROJ, (const bf16_t*)(ws + WS_WD), NR, 1024, DFF};
            EpiDown E{p.out, ROW0, (float*)(ws + WS_RSS2)}; pg8::gemm_phase<EpiDown, pg8::StaticOrder, true, true>(l, g, S, E);
        }
    __syncthreads();
}

__global__ void __launch_bounds__(512) mega(Params p_unused) {
    extern __shared__ __attribute__((aligned(16))) unsigned char lds_raw[];
    cg::grid_group grid = cg::this_grid();
    LAS unsigned char* l = (LAS unsigned char*)lds_raw;
    const unsigned lbase = (unsigned)(size_t)l;
    const int G = gridDim.x, bx = blockIdx.x;
    volatile LAS unsigned* xst = (volatile LAS unsigned*)(l + LDS_BYTES - 16);
    { const int t0_ = OTID(); if (t0_ < 4) xst[t0_] = 0u; }
    __syncthreads();
    (void)xcd_barrier_post((unsigned*)(KWS() + WS_BAR), xst);
    { const Params q = KPARAMS(); phase_weights(q, l, OTID()); }
    half_pass<0>(p_unused, l, lbase, grid, G, bx);
    half_pass<1>(p_unused, l, lbase, grid, G, bx);
    GBAR();
    {
        const Params p = KPARAMS(); unsigned char* ws = p.ws; const int tid = OTID();
        const float* rss2 = (const float*)(ws + WS_RSS2);
        const size_t GT = (size_t)G * 512;
        for (size_t i0 = (size_t)bx * 512 + tid; i0 < (size_t)NTOK * 256; i0 += 4 * GT) {
            f32x4 v[4]; float rs[4];
#pragma unroll
            for (int k = 0; k < 4; ++k) { const size_t i = i0 + k * GT; if (i < (size_t)NTOK * 256) { v[k] = ((const f32x4*)p.out)[i]; rs[k] = rss2[i >> 8]; } }
#pragma unroll
            for (int k = 0; k < 4; ++k) { const size_t i = i0 + k * GT; if (i < (size_t)NTOK * 256) { const float r = rsqrtf(rs[k] * (1.0f / 1024.0f) + EPS); const f32x4 w = ((const f32x4*)p.norm_final_w)[i & 255];
                f32x4 o = v[k]; o[0] *= r * w[0]; o[1] *= r * w[1]; o[2] *= r * w[2]; o[3] *= r * w[3]; ((f32x4*)p.out)[i] = o; } }
        }
    }
}

extern "C" void kernel_launch(void* const* d_in, const int* in_sizes, int n_in, void* d_out, int out_size, void* d_ws, size_t ws_size, hipStream_t stream) {
    static int grid_blocks = 0;
    if (!grid_blocks) {
        int dev = 0, cus = 0, per_cu = 0;
        (void)hipGetDevice(&dev);
        (void)hipDeviceGetAttribute(&cus, hipDeviceAttributeMultiprocessorCount, dev);
        (void)hipFuncSetAttribute((const void*)mega, hipFuncAttributeMaxDynamicSharedMemorySize, LDS_BYTES);
        (void)hipOccupancyMaxActiveBlocksPerMultiprocessor(&per_cu, (const void*)mega, 512, LDS_BYTES);
        if (per_cu < 1) per_cu = 1;
        grid_blocks = cus * per_cu;
        if (ws_size < WS_END) fprintf(stderr, "workspace too small: %zu < %zu\n", ws_size, (size_t)WS_END);
    }
    Params p{};
    const float** pp = (const float**)&p;
    for (int i = 0; i < 25; ++i) pp[i] = (const float*)d_in[i];
    p.out = (float*)d_out; p.ws = (unsigned char*)d_ws;
    (void)hipMemsetAsync((unsigned char*)d_ws + WS_BAR, 0, (size_t)XCD_BAR_WORDS_ * 4, stream);
    void* args[] = {&p};
    hipError_t e = hipLaunchCooperativeKernel((const void*)mega, dim3(grid_blocks), dim3(512), args, LDS_BYTES, stream);
    if (e != hipSuccess) fprintf(stderr, "cooperative launch failed: %s (grid %d)\n", hipGetErrorString(e), grid_blocks);
}
```

```cpp
#include <hip/hip_runtime.h>
#include <hip/hip_cooperative_groups.h>
#include <cstdio>
namespace cg = cooperative_groups;

namespace pg8 {
#define PG8_LAS __attribute__((address_space(3)))
typedef unsigned short bf16_t;
typedef short bf16x8 __attribute__((ext_vector_type(8)));
typedef float f32x4 __attribute__((ext_vector_type(4)));
typedef unsigned u32x4 __attribute__((ext_vector_type(4)));
constexpr int BM = 256, BK = 64, HALF = 128, HTB = HALF * BK * 2  , STAGE_BYTES = 8 * HTB, NXCD = 8, WGM = 8;

__host__ __device__ __forceinline__ int lds_byte(int r, int c) { const int st = (r >> 4) * 2 + (c >> 5), rr = r & 15, cc = c & 31, ob = rr * 64 + cc * 2; return st * 1024 + (ob ^ (((ob >> 9) & 1) << 5)); }
__host__ __device__ __forceinline__ void stage_rc(int b, int& R, int& C) { const int st = b / 1024, sb = b % 1024, swz = sb ^ (((sb >> 9) & 1) << 5); R = (st >> 1) * 16 + swz / 64; C = (st & 1) * 32 + (swz % 64) / 2; }
__host__ __device__ __forceinline__ int perm32(int rho) { const int n = rho >> 4, i = rho & 15; return 8 * (i >> 2) + 4 * n + (i & 3); }

struct Unit { int pm, pn; };
struct Gemm { const bf16_t* A; const bf16_t* Bt; int M, N, K; };

struct StaticOrder {
    int nM, nN, nwg, G, c;
    __host__ __device__ void init(int M, int N, int G_, int c_) { nM = M / BM; nN = N / BM; nwg = nM * nN; G = G_; c = c_; }
    __host__ __device__ bool next(int i, Unit& u) const {
        const long L = (long)i * G + c; if (L >= nwg) return false;
        int wgid = (int)L; { const int q = nwg / NXCD, r = nwg % NXCD, xcd = wgid % NXCD, off = wgid / NXCD; wgid = (xcd < r ? xcd * (q + 1) : r * (q + 1) + (xcd - r) * q) + off; }
        const int nig = WGM * nN, gid = wgid / nig, fm = gid * WGM, gsz = (nM - fm) < WGM ? (nM - fm) : WGM;
        u.pm = fm + ((wgid % nig) % gsz); u.pn = (wgid % nig) / gsz; return true;
    }
    __device__ __forceinline__ void a_ready(const Unit&) const {}
    __device__ __forceinline__ void done(const Unit&) const {}
};
typedef float f32x2_t_ __attribute__((ext_vector_type(2)));
typedef __bf16 bf16x2_t_ __attribute__((ext_vector_type(2)));
__device__ __forceinline__ unsigned cvt_pk_bf16(float lo, float hi) { const f32x2_t_ v = {lo, hi}; const bf16x2_t_ b = __builtin_convertvector(v, bf16x2_t_); return __builtin_bit_cast(unsigned, b); }
template <class Epi, class Sched, bool ALIGN_EPI = false, bool SP2 = false>
__device__ __forceinline__ void gemm_phase(PG8_LAS unsigned char* lds, const Gemm g, const Sched& S, const Epi& E) {
    int tid_ = threadIdx.x; asm volatile("" : "+v"(tid_)); const int tid = tid_, wid = __builtin_amdgcn_readfirstlane(tid >> 6), lane = tid & 63, wr = wid >> 2, wc = wid & 3, fr = lane & 15, fq = lane >> 4;
    const int K = g.K, nt = K / BK;
    unsigned voffA[2], voffB[2];
#pragma unroll
    for (int i = 0; i < 2; ++i) { int R, C; stage_rc(tid * 16 + i * 8192, R, C); const int Rb = Epi::PERM ? ((R & ~31) + perm32(R & 31)) : R;
        voffA[i] = (unsigned)(R * K + C) * 2u; voffB[i] = (unsigned)(Rb * K + C) * 2u; }
    const size_t kstep = (size_t)(BK * 2);
    const size_t hstep = (size_t)HALF * K * 2;
    const size_t tstep = 2 * hstep;
    const unsigned ldsw = (unsigned)wid * 1024u;
    const int aoff = lds_byte(wr * 64 + fr, fq * 8), boff = lds_byte(wc * 32 + fr, fq * 8);
#define PG8_SA(b, h) (((b) * 2 + (h)) * HTB)
#define PG8_SB(b, h) ((4 + (b) * 2 + (h)) * HTB)
#define PG8_STAGE(bufoff, gbase, voff) do { _Pragma("unroll") for (int _i = 0; _i < 2; ++_i) \
        __builtin_amdgcn_global_load_lds((const unsigned*)((const char*)(gbase) + (voff)[_i]), (PG8_LAS unsigned*)(lds + (bufoff) + ldsw + _i * 8192), 16, 0, 0); } while (0)
#define PG8_LDA(dst, b, h) do { _Pragma("unroll") for (int m = 0; m < 4; ++m) _Pragma("unroll") for (int k = 0; k < 2; ++k) dst[m][k] = *(const PG8_LAS bf16x8*)(lds + PG8_SA(b, h) + aoff + m * 2048 + k * 1024); } while (0)
#define PG8_LDB(dst, b, h) do { _Pragma("unroll") for (int n = 0; n < 2; ++n) _Pragma("unroll") for (int k = 0; k < 2; ++k) dst[n][k] = *(const PG8_LAS bf16x8*)(lds + PG8_SB(b, h) + boff + n * 2048 + k * 1024); } while (0)
#define PG8_MMA(ai, bj, At, Bt) do { __builtin_amdgcn_s_setprio(1); _Pragma("unroll") for (int m = 0; m < 4; ++m) _Pragma("unroll") for (int n = 0; n < 2; ++n) _Pragma("unroll") for (int k = 0; k < 2; ++k) \
        acc[ai][bj][m][n] = __builtin_amdgcn_mfma_f32_16x16x32_bf16(Bt[n][k], At[m][k], acc[ai][bj][m][n], 0, 0, 0); __builtin_amdgcn_s_setprio(0); } while (0)
#define PG8_WAIT_V(n) asm volatile("s_waitcnt vmcnt(" #n ")" ::: "memory")
#define PG8_WAIT_L(n) asm volatile("s_waitcnt lgkmcnt(" #n ")" ::: "memory")
#define PG8_BAR __builtin_amdgcn_s_barrier()
#define PG8_SCHED __builtin_amdgcn_sched_barrier(0)
    Unit cur, nxt; int ui = 0;
    if (!S.next(0, cur)) return;
    f32x4 acc[2][2][4][2];
#pragma unroll
    for (int a = 0; a < 2; ++a)
#pragma unroll
        for (int b = 0; b < 2; ++b)
#pragma unroll
            for (int m = 0; m < 4; ++m)
#pragma unroll
                for (int n = 0; n < 2; ++n) acc[a][b][m][n] = (f32x4){0.f, 0.f, 0.f, 0.f};
    bf16x8 At[4][2], B0[2][2], B1[2][2];
    const char* cA = (const char*)g.A + (size_t)cur.pm * tstep; const char* cB = (const char*)g.Bt + (size_t)cur.pn * tstep;
    S.a_ready(cur);
    if constexpr (SP2) {
        PG8_STAGE(PG8_SB(0, 0), cB, voffB); PG8_STAGE(PG8_SB(0, 1), cB + hstep, voffB); PG8_STAGE(PG8_SA(0, 0), cA, voffA); PG8_STAGE(PG8_SA(0, 1), cA + hstep, voffA);
        if (wr == 1) PG8_BAR;
        PG8_WAIT_V(2); PG8_BAR;
        PG8_STAGE(PG8_SB(1, 0), cB + kstep, voffB); PG8_STAGE(PG8_SA(1, 0), cA + kstep, voffA); PG8_STAGE(PG8_SB(1, 1), cB + hstep + kstep, voffB);
        PG8_WAIT_V(6); PG8_BAR;
    } else {
        PG8_STAGE(PG8_SB(0, 0), cB, voffB); PG8_STAGE(PG8_SA(0, 0), cA, voffA); PG8_STAGE(PG8_SB(0, 1), cB + hstep, voffB); PG8_STAGE(PG8_SA(0, 1), cA + hstep, voffA);
        if (wr == 1) PG8_BAR;
        PG8_WAIT_V(4); PG8_BAR;
        PG8_STAGE(PG8_SB(1, 0), cB + kstep, voffB); PG8_STAGE(PG8_SA(1, 0), cA + kstep, voffA); PG8_STAGE(PG8_SB(1, 1), cB + hstep + kstep, voffB);
        PG8_WAIT_V(6); PG8_BAR;
    }
    for (;;) {
        const bool has_next = S.next(ui + 1, nxt);
        const char* nA = has_next ? (const char*)g.A + (size_t)nxt.pm * tstep : cA; const char* nB = has_next ? (const char*)g.Bt + (size_t)nxt.pn * tstep : cB;
        for (int t = 0; t < nt; t += 2) {
            const bool last = (t == nt - 2);
            const char* a1 = cA + (size_t)(t + 1) * kstep;
            const char* a2 = last ? nA : cA + (size_t)(t + 2) * kstep; const char* b2 = last ? nB : cB + (size_t)(t + 2) * kstep;
            const char* a3 = a2 + kstep; const char* b3 = b2 + kstep;
            if (last && has_next) S.a_ready(nxt);
            if constexpr (SP2) {
            PG8_LDB(B0, 0, 0); PG8_LDB(B1, 0, 1); PG8_SCHED; PG8_LDA(At, 0, 0); PG8_STAGE(PG8_SA(1, 1), a1 + hstep, voffA);
            PG8_WAIT_V(8); PG8_WAIT_L(0); PG8_BAR; PG8_MMA(0, 0, At, B0); PG8_MMA(0, 1, At, B1); PG8_BAR; PG8_SCHED;
            PG8_LDA(At, 0, 1); PG8_STAGE(PG8_SB(0, 0), b2, voffB); PG8_STAGE(PG8_SB(0, 1), b2 + hstep, voffB); PG8_STAGE(PG8_SA(0, 0), a2, voffA);
            PG8_WAIT_V(8); PG8_WAIT_L(0); PG8_BAR; PG8_MMA(1, 0, At, B0); PG8_MMA(1, 1, At, B1); PG8_BAR; PG8_SCHED;
            PG8_LDB(B0, 1, 0); PG8_LDB(B1, 1, 1); PG8_SCHED; PG8_LDA(At, 1, 0); PG8_STAGE(PG8_SA(0, 1), a2 + hstep, voffA);
            PG8_WAIT_V(8); PG8_WAIT_L(0); PG8_BAR; PG8_MMA(0, 0, At, B0); PG8_MMA(0, 1, At, B1); PG8_BAR; PG8_SCHED;
            PG8_LDA(At, 1, 1); PG8_STAGE(PG8_SB(1, 0), b3, voffB); PG8_STAGE(PG8_SB(1, 1), b3 + hstep, voffB); PG8_STAGE(PG8_SA(1, 0), a3, voffA);
            PG8_WAIT_V(8); PG8_WAIT_L(0); PG8_BAR; PG8_MMA(1, 0, At, B0); PG8_MMA(1, 1, At, B1); PG8_BAR; PG8_SCHED;
            } else {
            PG8_LDB(B0, 0, 0); PG8_SCHED; PG8_LDA(At, 0, 0); PG8_STAGE(PG8_SA(1, 1), a1 + hstep, voffA);
            PG8_WAIT_L(8); PG8_BAR; PG8_WAIT_L(0); PG8_MMA(0, 0, At, B0); PG8_BAR; PG8_SCHED;
            PG8_LDB(B1, 0, 1); PG8_STAGE(PG8_SB(0, 0), b2, voffB);
            PG8_BAR; PG8_WAIT_L(0); PG8_MMA(0, 1, At, B1); PG8_BAR;
            PG8_LDA(At, 0, 1); PG8_STAGE(PG8_SA(0, 0), a2, voffA);
            PG8_BAR; PG8_WAIT_L(0); PG8_MMA(1, 0, At, B0); PG8_BAR; PG8_SCHED;
            PG8_STAGE(PG8_SB(0, 1), b2 + hstep, voffB);
            PG8_WAIT_V(6); PG8_BAR; PG8_MMA(1, 1, At, B1); PG8_BAR;
            PG8_LDB(B0, 1, 0); PG8_SCHED; PG8_LDA(At, 1, 0); PG8_STAGE(PG8_SA(0, 1), a2 + hstep, voffA);
            PG8_WAIT_L(8); PG8_BAR; PG8_WAIT_L(0); PG8_MMA(0, 0, At, B0); PG8_BAR; PG8_SCHED;
            PG8_LDB(B1, 1, 1); PG8_STAGE(PG8_SB(1, 0), b3, voffB);
            PG8_BAR; PG8_WAIT_L(0); PG8_MMA(0, 1, At, B1); PG8_BAR;
            PG8_LDA(At, 1, 1); PG8_STAGE(PG8_SA(1, 0), a3, voffA);
            PG8_BAR; PG8_WAIT_L(0); PG8_MMA(1, 0, At, B0); PG8_BAR; PG8_SCHED;
            PG8_STAGE(PG8_SB(1, 1), b3 + hstep, voffB);
            PG8_WAIT_V(6); PG8_BAR; PG8_MMA(1, 1, At, B1); PG8_BAR;
            }
        }
        if constexpr (ALIGN_EPI) { if (wr == 0) PG8_BAR; }
        if constexpr (!Epi::AFTER_DRAIN) { E(acc, cur, wr, wc, fr, fq); S.done(cur); }
        if (!has_next) break;
#pragma unroll
        for (int a = 0; a < 2; ++a)
#pragma unroll
            for (int b = 0; b < 2; ++b)
#pragma unroll
                for (int m = 0; m < 4; ++m)
#pragma unroll
                    for (int n = 0; n < 2; ++n) acc[a][b][m][n] = (f32x4){0.f, 0.f, 0.f, 0.f};
        cur = nxt; cA = nA; cB = nB; ++ui;
        if constexpr (ALIGN_EPI) { if (wr == 1) PG8_BAR; }
    }
    PG8_WAIT_V(0);
    if constexpr (!ALIGN_EPI) { if (wr == 0) PG8_BAR; }
    PG8_BAR;
    if constexpr (Epi::AFTER_DRAIN) { E.fused(acc, cur, wr, wc, fr, fq, lds, wid, lane); S.done(cur); }
#undef PG8_SA
#undef PG8_SB
#undef PG8_STAGE
#undef PG8_LDA
#undef PG8_LDB
#undef PG8_MMA
#undef PG8_WAIT_V
#undef PG8_WAIT_L
#undef PG8_BAR
#undef PG8_SCHED
}
}


#define LAS __attribute__((address_space(3)))
typedef unsigned short bf16_t;
typedef short bf16x8 __attribute__((ext_vector_type(8)));
typedef float f32x4 __attribute__((ext_vector_type(4)));
typedef unsigned u32x4 __attribute__((ext_vector_type(4)));
typedef unsigned u32x2 __attribute__((ext_vector_type(2)));
typedef unsigned short u16x4 __attribute__((ext_vector_type(4)));
using pg8::cvt_pk_bf16;

constexpr int DM = 1024, NTOK = 81920, MH = 49152  , NSEQH = 12, NPTOK = 16384, PC = 6208, DFF = 2816;
constexpr int PASS_ROW0[2] = {0, 49152}, PASS_ROWS[2] = {49152, 32768}, PASS_SEQ[2] = {12, 8};
constexpr int C_Q = 0, C_K = 256, C_V = 512, C_OG = 1024, C_RF = 1536, C_Z = 1568, C_XBC = 2592, C_BM = 3616, C_CM = 3872, C_DTF = 4128, C_DTB = 4144, C_G1 = 4160, C_G2 = 5184;
constexpr float EPS = 1e-6f;
constexpr int XCD_BAR_WORDS_ = 3456;

constexpr size_t WS_WIN = 0;
constexpr size_t WS_WB1 = WS_WIN + (size_t)6400 * 1024 * 2;
constexpr size_t WS_WB2 = WS_WB1 + (size_t)1024 * 512 * 2;
constexpr size_t WS_WOUT = WS_WB2 + (size_t)1024 * 1024 * 2;
constexpr size_t WS_WGU = WS_WOUT + (size_t)1024 * 1024 * 2;
constexpr size_t WS_WD = WS_WGU + (size_t)5632 * 1024 * 2;
constexpr size_t WS_RSS1 = WS_WD + (size_t)1024 * 2816 * 2;
constexpr size_t WS_RSS2 = WS_RSS1 + (size_t)NTOK * 4;
constexpr size_t WS_RSSY = WS_RSS2 + (size_t)NTOK * 4;
constexpr size_t WS_GDEC = WS_RSSY + (size_t)NTOK * 4;
constexpr size_t WS_SDEC = WS_GDEC + (size_t)NSEQH * 64 * 2 * 4 * 64 * 4;
constexpr size_t WS_PROJ = WS_SDEC + (size_t)NSEQH * 32 * 2 * 16 * 4;
constexpr size_t WS_U = WS_PROJ + (size_t)MH * PC * 2;
constexpr size_t WS_OG = WS_U;
constexpr size_t WS_Y = WS_U + (size_t)MH * 512 * 2;
constexpr size_t WS_ST = WS_U + (size_t)MH * 1536 * 2;
constexpr size_t WS_GS = WS_ST;
constexpr size_t WS_SS = WS_ST + (size_t)MH * 2048;
constexpr size_t WS_T = WS_ST;
constexpr size_t WS_MM = WS_ST + (size_t)MH * 2048;
constexpr size_t WS_X1B = WS_U;
constexpr size_t WS_BAR = WS_ST + (size_t)MH * 4096;
constexpr size_t WS_LG = WS_BAR + 16384;
constexpr size_t WS_END = WS_LG + (size_t)NSEQH * 256 * 8192 * 2;
static_assert(WS_PROJ % 256 == 0 && WS_U % 256 == 0 && WS_ST % 256 == 0 && WS_END < (size_t)1070 * 1000 * 1000, "ws map");

struct Params {
    const float* xp; const float* xs; const float* norm_mix_w; const float* w_in; const float* gla_up_f; const float* gla_bias_f; const float* gla_up_b; const float* gla_bias_b;
    const float* gla_norm_w; const float* conv_w; const float* conv_b; const float* dt_bias_f; const float* dt_bias_b; const float* a_log_f; const float* a_log_b; const float* d_skip;
    const float* ssm_norm_w; const float* w_br_gla; const float* w_br_ssm; const float* w_out; const float* norm_ffn_w; const float* w_ffn_gate; const float* w_ffn_up; const float* w_ffn_down;
    const float* norm_final_w; float* out; unsigned char* ws;
};

__device__ __forceinline__ float bf2f(unsigned short b) { return __uint_as_float(((unsigned)b) << 16); }
__device__ __forceinline__ float bflo(unsigned u) { return __uint_as_float(u << 16); }
__device__ __forceinline__ float bfhi(unsigned u) { return __uint_as_float(u & 0xffff0000u); }
__device__ __forceinline__ unsigned short f2bf(float f) { return (unsigned short)(cvt_pk_bf16(f, 0.f) & 0xffffu); }
__device__ __forceinline__ float sigmoidf_(float x) { return __builtin_amdgcn_rcpf(1.0f + __expf(-x)); }
__device__ __forceinline__ float siluf_(float x) { return x * __builtin_amdgcn_rcpf(1.0f + __expf(-x)); }
__device__ __forceinline__ float softplusf_(float x) { return fmaxf(x, 0.f) + log1pf(__expf(-fabsf(x))); }
__device__ __forceinline__ const float* xrow(const Params& p, int grow) { return grow < NPTOK ? p.xp + (size_t)grow * DM : p.xs + (size_t)(grow - NPTOK) * DM; }
__device__ __forceinline__ void unpack8(const u32x4 v, float* o) { o[0] = bflo(v.x); o[1] = bfhi(v.x); o[2] = bflo(v.y); o[3] = bfhi(v.y); o[4] = bflo(v.z); o[5] = bfhi(v.z); o[6] = bflo(v.w); o[7] = bfhi(v.w); }
__device__ __forceinline__ u32x4 pack8(const float* o) { u32x4 w; w.x = cvt_pk_bf16(o[0], o[1]); w.y = cvt_pk_bf16(o[2], o[3]); w.z = cvt_pk_bf16(o[4], o[5]); w.w = cvt_pk_bf16(o[6], o[7]); return w; }
__device__ __forceinline__ float shfl_idx(float x, int src_lane) { return __int_as_float(__builtin_amdgcn_ds_bpermute(src_lane << 2, __float_as_int(x))); }
__device__ __forceinline__ float bcast_lane63(float x) { return __int_as_float(__builtin_amdgcn_readlane(__float_as_int(x), 63)); }
template <int N> __device__ __forceinline__ float dpp_row_shr(float x) { return __int_as_float(__builtin_amdgcn_update_dpp(0, __float_as_int(x), 0x110 + N, 0xf, 0xf, true)); }
__device__ __forceinline__ float wave_incl_scan_tot(float x, int lane, float& tot) {
    x += dpp_row_shr<1>(x); x += dpp_row_shr<2>(x); x += dpp_row_shr<4>(x); x += dpp_row_shr<8>(x);
    const float t0 = __int_as_float(__builtin_amdgcn_readlane(__float_as_int(x), 15)), t1 = __int_as_float(__builtin_amdgcn_readlane(__float_as_int(x), 31));
    const float t2 = __int_as_float(__builtin_amdgcn_readlane(__float_as_int(x), 47)), t3 = __int_as_float(__builtin_amdgcn_readlane(__float_as_int(x), 63));
    const int row = lane >> 4;
    const float add = (row >= 1 ? t0 : 0.f) + (row >= 2 ? t1 : 0.f) + (row >= 3 ? t2 : 0.f);
    tot = (t0 + t1) + (t2 + t3);
    return x + add;
}
__device__ __forceinline__ bf16x8 frag_row(const LAS unsigned char* base, int RS, int row0, int k0, int lane) {
    return *(const LAS bf16x8*)(base + (row0 + (lane & 15)) * RS + (k0 + 8 * (lane >> 4)) * 2);
}
__device__ __forceinline__ bf16x8 frag_tr(unsigned base_addr, int RS, int k0, int c0, int lane) {
    const int g = lane >> 4, q = (lane & 15) >> 2, pp = lane & 3;
    const unsigned a0 = base_addr + (unsigned)((k0 + 8 * g + q) * RS + (c0 + 4 * pp) * 2), a1 = a0 + 4u * (unsigned)RS;
    u16x4 lo, hi;
    asm volatile("ds_read_b64_tr_b16 %0, %2\n\tds_read_b64_tr_b16 %1, %3\n\ts_waitcnt lgkmcnt(0)" : "=&v"(lo), "=&v"(hi) : "v"(a0), "v"(a1) : "memory");
    bf16x8 r; r[0] = (short)lo[0]; r[1] = (short)lo[1]; r[2] = (short)lo[2]; r[3] = (short)lo[3]; r[4] = (short)hi[0]; r[5] = (short)hi[1]; r[6] = (short)hi[2]; r[7] = (short)hi[3];
    return r;
}
#define MFMA16(a, b, c) __builtin_amdgcn_mfma_f32_16x16x32_bf16(a, b, c, 0, 0, 0)
__device__ __forceinline__ void frag_tr4(bf16x8 (&r)[4], unsigned base_addr, int RS, int k0, int c0, int cstep, int lane) {
    const int g = lane >> 4, q = (lane & 15) >> 2, pp = lane & 3;
    const unsigned a0 = base_addr + (unsigned)((k0 + 8 * g + q) * RS + (c0 + 4 * pp) * 2), a1 = a0 + 4u * (unsigned)RS; const unsigned cs = (unsigned)cstep * 2u;
    u16x4 lo[4], hi[4];
#pragma unroll
    for (int i = 0; i < 4; ++i) { asm volatile("ds_read_b64_tr_b16 %0, %1" : "=&v"(lo[i]) : "v"(a0 + cs * i) : "memory"); asm volatile("ds_read_b64_tr_b16 %0, %1" : "=&v"(hi[i]) : "v"(a1 + cs * i) : "memory"); }
    asm volatile("s_waitcnt lgkmcnt(0)" : "+v"(lo[0]), "+v"(lo[1]), "+v"(lo[2]), "+v"(lo[3]), "+v"(hi[0]), "+v"(hi[1]), "+v"(hi[2]), "+v"(hi[3]) :: "memory");
#pragma unroll
    for (int i = 0; i < 4; ++i) { r[i][0] = (short)lo[i][0]; r[i][1] = (short)lo[i][1]; r[i][2] = (short)lo[i][2]; r[i][3] = (short)lo[i][3]; r[i][4] = (short)hi[i][0]; r[i][5] = (short)hi[i][1]; r[i][6] = (short)hi[i][2]; r[i][7] = (short)hi[i][3]; }
}


#define XB_TMO      128
#define XB_XCNT(j)  (256  + 64 * (j))
#define XB_XSUB(j)  (1280 + 64 * (j))
#define XB_XGEN(j)  (2304 + 64 * (j))
#define XB_TOP      3328
#define XB_TOPGEN   3392
#define XCD_BAR_WORDS 3456
#define XB_SPIN_CAP (1u << 18)

__device__ __forceinline__ unsigned xb_tid() { unsigned t_ = threadIdx.x; asm volatile("" : "+v"(t_)); return t_; }
__device__ __forceinline__ unsigned xb_ld(unsigned* p)              { return __hip_atomic_load(p, __ATOMIC_RELAXED, __HIP_MEMORY_SCOPE_AGENT); }
__device__ __forceinline__ unsigned xb_add(unsigned* p, unsigned v) { return __hip_atomic_fetch_add(p, v, __ATOMIC_RELAXED, __HIP_MEMORY_SCOPE_AGENT); }
__device__ __forceinline__ unsigned xb_xcc_id() { return (unsigned)__builtin_amdgcn_s_getreg((3 << 11) | 20) & 0xFu; }
#define XB_SPIN(cond, bar) do { unsigned _sp = 0; while (cond) { __builtin_amdgcn_s_sleep(1); \
    if ((++_sp & 255u) == 0u) { if (xb_ld(&(bar)[XB_TMO])) break; if (_sp > XB_SPIN_CAP) { atomicAdd(&(bar)[XB_TMO], 1u); break; } } } } while (0)

struct XcdBarrier {
    unsigned* bar; unsigned x;
    volatile LAS unsigned* st;
};

__device__ __forceinline__ XcdBarrier xcd_barrier_post(unsigned* bar, volatile LAS unsigned* st) {
    XcdBarrier b; b.bar = bar; b.x = xb_xcc_id(); b.st = st;
    if (xb_tid() == 0) (void)xb_add(&bar[XB_XCNT(b.x)], 1u);
    return b;
}
__device__ __forceinline__ void xcd_barrier_complete(unsigned* bar, unsigned x, unsigned& nloc, unsigned& nx) {
    const unsigned G = gridDim.x * gridDim.y * gridDim.z;
    unsigned sum, cnt, mine, sp = 0u;
    for (;;) {
        sum = 0u; cnt = 0u; mine = 0u;
#pragma unroll
        for (unsigned j = 0; j < 16; ++j) { const unsigned c = xb_ld(&bar[XB_XCNT(j)]); sum += c; cnt += (c > 0u) ? 1u : 0u; mine = (j == x) ? c : mine; }
        if (sum == G) break;
        __builtin_amdgcn_s_sleep(1);
        if ((++sp & 255u) == 0u) { if (xb_ld(&bar[XB_TMO])) break; if (sp > XB_SPIN_CAP) { atomicAdd(&bar[XB_TMO], 1u); break; } }
    }
    nloc = mine > 0u ? mine : 1u; nx = cnt > 0u ? cnt : 1u;
}

__device__ __forceinline__ void xcd_barrier(const XcdBarrier& b) {
    asm volatile("s_waitcnt vmcnt(0)" ::: "memory");
    __syncthreads();
    if (xb_tid() == 0) {
        unsigned* bar = b.bar;
        __builtin_amdgcn_s_waitcnt(0);
        unsigned nloc = b.st[0], nx = b.st[1];
        if (nloc == 0u) { xcd_barrier_complete(bar, b.x, nloc, nx); b.st[0] = nloc; b.st[1] = nx; }
        const unsigned old = xb_add(&bar[XB_XSUB(b.x)], 1u);
        const unsigned gen = old / nloc;
        if (old + 1u == (gen + 1u) * nloc) {
            __builtin_amdgcn_fence(__ATOMIC_RELEASE, "agent");
            asm volatile("s_waitcnt vmcnt(0)" ::: "memory");
            const unsigned og = xb_add(&bar[XB_TOP], 1u);
            const unsigned tg = og / nx;
            if (og + 1u == (tg + 1u) * nx) xb_add(&bar[XB_TOPGEN], 1u);
            else XB_SPIN(xb_ld(&bar[XB_TOPGEN]) == tg, bar);
            __builtin_amdgcn_fence(__ATOMIC_ACQUIRE, "agent");
            xb_add(&bar[XB_XGEN(b.x)], 1u);
            asm volatile("s_waitcnt vmcnt(0)" ::: "memory");
        } else {
            XB_SPIN(xb_ld(&bar[XB_XGEN(b.x)]) == gen, bar);
            __builtin_amdgcn_fence(__ATOMIC_ACQUIRE, "agent");
            asm volatile("s_waitcnt vmcnt(0)" ::: "memory");
        }
    }
    __syncthreads();
}

struct EpiProj {
    static constexpr bool PERM = true, AFTER_DRAIN = false;
    bf16_t* O;
    __device__ __forceinline__ void operator()(const f32x4 (&acc)[2][2][4][2], const pg8::Unit& u, int wr, int wc, int fr, int fq) const {
        const int row0 = u.pm * 256 + wr * 64 + fr, col0 = u.pn * 256 + wc * 32 + 8 * fq;
#pragma unroll
        for (int ai = 0; ai < 2; ++ai)
#pragma unroll
            for (int m = 0; m < 4; ++m) { bf16_t* rowp = O + (size_t)(row0 + ai * 128 + m * 16) * PC;
#pragma unroll
                for (int bj = 0; bj < 2; ++bj) { const int c = col0 + bj * 128; const f32x4 v0 = acc[ai][bj][m][0], v1 = acc[ai][bj][m][1];
                    u32x4 w; w.x = cvt_pk_bf16(v0[0], v0[1]); w.y = cvt_pk_bf16(v0[2], v0[3]); w.z = cvt_pk_bf16(v1[0], v1[1]); w.w = cvt_pk_bf16(v1[2], v1[3]);
                    if (c < PC) *(u32x4*)(rowp + c) = w; } }
    }
};
struct EpiM1 {
    static constexpr bool PERM = true, AFTER_DRAIN = false;
    const bf16_t* proj; bf16_t* T;
    __device__ __forceinline__ void operator()(const f32x4 (&acc)[2][2][4][2], const pg8::Unit& u, int wr, int wc, int fr, int fq) const {
        const int row0 = u.pm * 256 + wr * 64 + fr, col0 = u.pn * 256 + wc * 32 + 8 * fq;
#pragma unroll
        for (int ai = 0; ai < 2; ++ai) {
            u32x4 gq[4][2];
#pragma unroll
            for (int m = 0; m < 4; ++m)
#pragma unroll
                for (int bj = 0; bj < 2; ++bj) gq[m][bj] = *(const u32x4*)(proj + (size_t)(row0 + ai * 128 + m * 16) * PC + C_G1 + col0 + bj * 128);
#pragma unroll
            for (int m = 0; m < 4; ++m) { const int row = row0 + ai * 128 + m * 16;
#pragma unroll
                for (int bj = 0; bj < 2; ++bj) { const int c = col0 + bj * 128; float gv[8], o[8];
                    unpack8(gq[m][bj], gv);
#pragma unroll
                    for (int j = 0; j < 8; ++j) o[j] = sigmoidf_(gv[j]) * acc[ai][bj][m][j >> 2][j & 3];
                    *(u32x4*)(T + (size_t)row * DM + c) = pack8(o); } }
        }
    }
};
struct EpiM2 {
    static constexpr bool PERM = true, AFTER_DRAIN = false;
    const bf16_t* proj; const bf16_t* T; bf16_t* MMo; const float* rssy;
    __device__ __forceinline__ void operator()(const f32x4 (&acc)[2][2][4][2], const pg8::Unit& u, int wr, int wc, int fr, int fq) const {
        const int row0 = u.pm * 256 + wr * 64 + fr, col0 = u.pn * 256 + wc * 32 + 8 * fq;
#pragma unroll
        for (int ai = 0; ai < 2; ++ai)
#pragma unroll
            for (int mh = 0; mh < 2; ++mh) {
                u32x4 gq[2][2], tq[2][2]; float rsv[2];
#pragma unroll
                for (int mm = 0; mm < 2; ++mm) { const int row = row0 + ai * 128 + (2 * mh + mm) * 16; rsv[mm] = rssy[row];
#pragma unroll
                    for (int bj = 0; bj < 2; ++bj) { const int c = col0 + bj * 128; gq[mm][bj] = *(const u32x4*)(proj + (size_t)row * PC + C_G2 + c); tq[mm][bj] = *(const u32x4*)(T + (size_t)row * DM + c); } }
#pragma unroll
                for (int mm = 0; mm < 2; ++mm) { const int m = 2 * mh + mm, row = row0 + ai * 128 + m * 16; const float rs = rsqrtf(rsv[mm] * (1.0f / 1024.0f) + EPS);
#pragma unroll
                    for (int bj = 0; bj < 2; ++bj) { const int c = col0 + bj * 128; float gv[8], tv[8], o[8];
                        unpack8(gq[mm][bj], gv); unpack8(tq[mm][bj], tv);
#pragma unroll
                        for (int j = 0; j < 8; ++j) o[j] = tv[j] + sigmoidf_(gv[j]) * rs * acc[ai][bj][m][j >> 2][j & 3];
                        *(u32x4*)(MMo + (size_t)row * DM + c) = pack8(o); } }
            }
    }
};
struct EpiOut {
    static constexpr bool PERM = true, AFTER_DRAIN = false;
    Params p; int grow0; bf16_t* X1B; float* rss;
    __device__ __forceinline__ void operator()(const f32x4 (&acc)[2][2][4][2], const pg8::Unit& u, int wr, int wc, int fr, int fq) const {
        const int row0 = u.pm * 256 + wr * 64 + fr, col0 = u.pn * 256 + wc * 32 + 8 * fq, ln_ = fq * 16 + fr;
#pragma unroll
        for (int ai = 0; ai < 2; ++ai)
#pragma unroll
            for (int mh = 0; mh < 2; ++mh) {
                f32x4 xa[2][2][2];
#pragma unroll
                for (int mm = 0; mm < 2; ++mm) { const float* xr = xrow(p, grow0 + row0 + ai * 128 + (2 * mh + mm) * 16);
#pragma unroll
                    for (int bj = 0; bj < 2; ++bj) { xa[mm][bj][0] = *(const f32x4*)(xr + col0 + bj * 128); xa[mm][bj][1] = *(const f32x4*)(xr + col0 + bj * 128 + 4); } }
#pragma unroll
                for (int mm = 0; mm < 2; ++mm) { const int m = 2 * mh + mm, row = row0 + ai * 128 + m * 16, grow = grow0 + row; float* orow = p.out + (size_t)grow * DM; float ss = 0.f;
#pragma unroll
                    for (int bj = 0; bj < 2; ++bj) { const int c = col0 + bj * 128;
                        const f32x4 a = xa[mm][bj][0] + acc[ai][bj][m][0], b = xa[mm][bj][1] + acc[ai][bj][m][1];
                        *(f32x4*)(orow + c) = a; *(f32x4*)(orow + c + 4) = b;
                        ss += a[0] * a[0] + a[1] * a[1] + a[2] * a[2] + a[3] * a[3] + b[0] * b[0] + b[1] * b[1] + b[2] * b[2] + b[3] * b[3];
                        u32x4 w; w.x = cvt_pk_bf16(a[0], a[1]); w.y = cvt_pk_bf16(a[2], a[3]); w.z = cvt_pk_bf16(b[0], b[1]); w.w = cvt_pk_bf16(b[2], b[3]);
                        *(u32x4*)(X1B + (size_t)row * DM + c) = w; }
                    ss += shfl_idx(ss, ln_ ^ 16); ss += shfl_idx(ss, ln_ ^ 32);
                    if (fq == 0) atomicAdd(rss + grow, ss); }
            }
    }
};
struct EpiSwi {
    static constexpr bool PERM = true, AFTER_DRAIN = false;
    const float* rss; bf16_t* H;
    __device__ __forceinline__ void operator()(const f32x4 (&acc)[2][2][4][2], const pg8::Unit& u, int wr, int wc, int fr, int fq) const {
        const int row0 = u.pm * 256 + wr * 64 + fr, hc = u.pn * 128 + wc * 32 + 8 * fq;
        float rsv[2][4];
#pragma unroll
        for (int ai = 0; ai < 2; ++ai)
#pragma unroll
            for (int m = 0; m < 4; ++m) rsv[ai][m] = rss[row0 + ai * 128 + m * 16];
#pragma unroll
        for (int ai = 0; ai < 2; ++ai)
#pragma unroll
            for (int m = 0; m < 4; ++m) { const int row = row0 + ai * 128 + m * 16; const float rs = rsqrtf(rsv[ai][m] * (1.0f / 1024.0f) + EPS); float o[8];
#pragma unroll
                for (int j = 0; j < 8; ++j) { const float gt = rs * acc[ai][0][m][j >> 2][j & 3], up = rs * acc[ai][1][m][j >> 2][j & 3]; o[j] = siluf_(gt) * up; }
                *(u32x4*)(H + (size_t)row * DFF + hc) = pack8(o); }
    }
};
struct EpiDown {
    static constexpr bool PERM = true, AFTER_DRAIN = false;
    float* out; int grow0; float* rss;
    __device__ __forceinline__ void operator()(const f32x4 (&acc)[2][2][4][2], const pg8::Unit& u, int wr, int wc, int fr, int fq) const {
        const int row0 = u.pm * 256 + wr * 64 + fr, col0 = u.pn * 256 + wc * 32 + 8 * fq, ln_ = fq * 16 + fr;
#pragma unroll
        for (int ai = 0; ai < 2; ++ai)
#pragma unroll
            for (int mh = 0; mh < 2; ++mh) {
                f32x4 xa[2][2][2];
#pragma unroll
                for (int mm = 0; mm < 2; ++mm) { const float* xr = out + (size_t)(grow0 + row0 + ai * 128 + (2 * mh + mm) * 16) * DM;
#pragma unroll
                    for (int bj = 0; bj < 2; ++bj) { xa[mm][bj][0] = *(const f32x4*)(xr + col0 + bj * 128); xa[mm][bj][1] = *(const f32x4*)(xr + col0 + bj * 128 + 4); } }
#pragma unroll
                for (int mm = 0; mm < 2; ++mm) { const int m = 2 * mh + mm, grow = grow0 + row0 + ai * 128 + m * 16; float* orow = out + (size_t)grow * DM; float ss = 0.f;
#pragma unroll
                    for (int bj = 0; bj < 2; ++bj) { const int c = col0 + bj * 128;
                        const f32x4 a = xa[mm][bj][0] + acc[ai][bj][m][0], b = xa[mm][bj][1] + acc[ai][bj][m][1];
                        *(f32x4*)(orow + c) = a; *(f32x4*)(orow + c + 4) = b;
                        ss += a[0] * a[0] + a[1] * a[1] + a[2] * a[2] + a[3] * a[3] + b[0] * b[0] + b[1] * b[1] + b[2] * b[2] + b[3] * b[3]; }
                    ss += shfl_idx(ss, ln_ ^ 16); ss += shfl_idx(ss, ln_ ^ 32);
                    if (fq == 0) atomicAdd(rss + grow, ss); }
            }
    }
};

__device__ __forceinline__ void transpose_tile(const float* src, int N, int k0, int n0, bf16_t* dst, int K, int mode, const float* kscale, LAS float* tl, int tid) {
    for (int i = tid; i < 1024; i += 512) { const int kk = i >> 4, n4 = (i & 15) * 4; f32x4 v = *(const f32x4*)(src + (size_t)(k0 + kk) * N + n0 + n4); if (kscale) v *= kscale[k0 + kk];
        tl[kk * 65 + n4] = v[0]; tl[kk * 65 + n4 + 1] = v[1]; tl[kk * 65 + n4 + 2] = v[2]; tl[kk * 65 + n4 + 3] = v[3]; }
    __syncthreads();
    for (int i = tid; i < 2048; i += 512) { const int nn = i >> 5, kp = i & 31; const float a = tl[(2 * kp) * 65 + nn], b = tl[(2 * kp + 1) * 65 + nn]; const int n = n0 + nn;
        const int row = mode == 0 ? n : (256 * (n >> 7) + (n & 127) + (mode == 2 ? 128 : 0));
        *(unsigned*)(dst + (size_t)row * K + k0 + 2 * kp) = cvt_pk_bf16(a, b); }
    __syncthreads();
}
__device__ __forceinline__ void phase_weights(const Params& p, LAS unsigned char* l, int tid) {
    unsigned char* ws = p.ws; LAS float* tl = (LAS float*)l;
    for (int j = blockIdx.x; j < 4304; j += gridDim.x) {
        if (j < 1552) transpose_tile(p.w_in, PC, (j / 97) * 64, (j % 97) * 64, (bf16_t*)(ws + WS_WIN), 1024, 0, nullptr, tl, tid);
        else if (j < 1680) { const int t = j - 1552; transpose_tile(p.w_br_gla, 1024, (t / 16) * 64, (t % 16) * 64, (bf16_t*)(ws + WS_WB1), 512, 0, nullptr, tl, tid); }
        else if (j < 1936) { const int t = j - 1680; transpose_tile(p.w_br_ssm, 1024, (t / 16) * 64, (t % 16) * 64, (bf16_t*)(ws + WS_WB2), 1024, 0, p.ssm_norm_w, tl, tid); }
        else if (j < 2192) { const int t = j - 1936; transpose_tile(p.w_out, 1024, (t / 16) * 64, (t % 16) * 64, (bf16_t*)(ws + WS_WOUT), 1024, 0, nullptr, tl, tid); }
        else if (j < 2896) { const int t = j - 2192; transpose_tile(p.w_ffn_gate, DFF, (t / 44) * 64, (t % 44) * 64, (bf16_t*)(ws + WS_WGU), 1024, 1, p.norm_ffn_w, tl, tid); }
        else if (j < 3600) { const int t = j - 2896; transpose_tile(p.w_ffn_up, DFF, (t / 44) * 64, (t % 44) * 64, (bf16_t*)(ws + WS_WGU), 1024, 2, p.norm_ffn_w, tl, tid); }
        else { const int t = j - 3600; transpose_tile(p.w_ffn_down, 1024, (t / 16) * 64, (t % 16) * 64, (bf16_t*)(ws + WS_WD), DFF, 0, nullptr, tl, tid); }
    }
    const int gt = blockIdx.x * 512 + tid, GT = gridDim.x * 512;
    unsigned* zw = (unsigned*)(ws + WS_WIN + (size_t)PC * 1024 * 2);
    for (int i = gt; i < 192 * 1024 / 2; i += GT) zw[i] = 0u;
    float* rs = (float*)(ws + WS_RSS1);
    for (int i = gt; i < 3 * NTOK; i += GT) rs[i] = 0.f;
}
__device__ __forceinline__ void phase_u(const Params& p, int row0, int nrows, int tid) {
    const int wave = tid >> 6, lane = tid & 63; bf16_t* U = (bf16_t*)(p.ws + WS_U);
    const int RST = gridDim.x * 8;
    for (int rb = blockIdx.x * 8 + wave; rb < nrows; rb += 2 * RST) {
        f32x4 v[2][4]; float ss[2] = {0.f, 0.f};
#pragma unroll
        for (int q = 0; q < 2; ++q) { const int r = rb + q * RST; if (r < nrows) { const float* xr = xrow(p, row0 + r);
#pragma unroll
            for (int i = 0; i < 4; ++i) v[q][i] = ((const f32x4*)xr)[lane + 64 * i]; } else {
#pragma unroll
            for (int i = 0; i < 4; ++i) v[q][i] = (f32x4){0.f, 0.f, 0.f, 0.f}; } }
        f32x4 wv[4];
#pragma unroll
        for (int i = 0; i < 4; ++i) wv[i] = ((const f32x4*)p.norm_mix_w)[lane + 64 * i];
#pragma unroll
        for (int q = 0; q < 2; ++q) {
#pragma unroll
            for (int i = 0; i < 4; ++i) ss[q] += v[q][i][0] * v[q][i][0] + v[q][i][1] * v[q][i][1] + v[q][i][2] * v[q][i][2] + v[q][i][3] * v[q][i][3];
#pragma unroll
            for (int o = 1; o < 64; o <<= 1) ss[q] += shfl_idx(ss[q], lane ^ o);
            const float rstd = rsqrtf(ss[q] * (1.0f / 1024.0f) + EPS); const int r = rb + q * RST;
            if (r < nrows) {
#pragma unroll
                for (int i = 0; i < 4; ++i) { u32x2 o; o.x = cvt_pk_bf16(v[q][i][0] * rstd * wv[i][0], v[q][i][1] * rstd * wv[i][1]); o.y = cvt_pk_bf16(v[q][i][2] * rstd * wv[i][2], v[q][i][3] * rstd * wv[i][3]);
                    *(u32x2*)(U + (size_t)r * DM + 4 * (lane + 64 * i)) = o; } }
        }
    }
}

constexpr int G_QF = 0, G_KF = 9216, G_QB = 18432, G_KB = 27648, G_V = 36864, G_ATT = 54272, G_SFT = 63488, G_SBT = 81920, G_SSQ = 100352, G_RS = 144, G_RSV = 272,
              G_UP = 101376, G_BIAS = 109568, G_KR = 110080, G_QR = 119296, G_RFB = 128512, G_RSR = 80, G_OGR = 133632, G_STG3 = 110080, G_STG1 = 63488, G_GNW = 151040;
struct GlaPF { u32x4 k, q, rf; f32x4 up, bias, gnw; unsigned short lg[16]; };
template <bool S3>
__device__ __forceinline__ void gla_pf_load(GlaPF& f, const Params& p, int item, int tid) {
    const int h = item & 3, c = (item >> 2) & 63, seq = item >> 8, r0 = seq * 4096 + c * 64;
    const bf16_t* proj = (const bf16_t*)(p.ws + WS_PROJ);
    { const int row = tid >> 3, ch = tid & 7; const bf16_t* pr = proj + (size_t)(r0 + row) * PC; f.k = *(const u32x4*)(pr + C_K + 64 * h + ch * 8); if (S3) f.q = *(const u32x4*)(pr + C_Q + 64 * h + ch * 8); }
    if (!S3) {
        if (tid < 256) { const int row = tid >> 2, ch = tid & 3; f.rf = *(const u32x4*)(proj + (size_t)(r0 + row) * PC + C_RF + ch * 8); }
        { const int dr = tid >> 8, r = (tid >> 4) & 15, d4 = tid & 15; f.up = *(const f32x4*)((dr ? p.gla_up_b : p.gla_up_f) + r * 256 + 64 * h + 4 * d4); }
        if (tid < 32) f.bias = *(const f32x4*)(((tid >> 4) ? p.gla_bias_b : p.gla_bias_f) + 64 * h + 4 * (tid & 15));
    } else {
        if (tid >= 64 && tid < 96) f.gnw = *(const f32x4*)(p.gla_norm_w + 4 * (tid - 64));
        const unsigned short* lgp = (const unsigned short*)(p.ws + WS_LG) + (size_t)item * 8192 + (size_t)((tid >> 8) * 64 + ((tid >> 6) & 3) * 16) * 64 + (tid & 63);
#pragma unroll
        for (int dd = 0; dd < 16; ++dd) f.lg[dd] = lgp[dd * 64];
    }
}
template <bool S3>
__device__ __forceinline__ void gla_pf_store(const GlaPF& f, LAS unsigned char* l, int tid) {
    { const int row = tid >> 3, ch = tid & 7; *(LAS u32x4*)(l + G_KR + row * G_RS + ch * 16) = f.k; if (S3) *(LAS u32x4*)(l + G_QR + row * G_RS + ch * 16) = f.q; }
    if (!S3) {
        if (tid < 256) { const int row = tid >> 2, ch = tid & 3; *(LAS u32x4*)(l + G_RFB + row * G_RSR + ch * 16) = f.rf; }
        *(LAS f32x4*)(l + G_UP + tid * 16) = f.up;
        if (tid < 32) *(LAS f32x4*)(l + G_BIAS + tid * 16) = f.bias;
    } else if (tid >= 64 && tid < 96) *(LAS f32x4*)(l + G_GNW + (tid - 64) * 16) = f.gnw;
}
#define LBAR() do { asm volatile("s_waitcnt lgkmcnt(0)" ::: "memory"); __builtin_amdgcn_s_barrier(); asm volatile("" ::: "memory"); } while (0)
template <bool S3>
__device__ __forceinline__ void gla_prep(LAS unsigned char* l, int lane, int w, int h, float* gdec_out, const GlaPF& pf, unsigned short* lgbuf) {
    const int dir = w >> 2, dq = w & 3;
    float rv[16];
    if (!S3) { const LAS unsigned char* rp = l + G_RFB + lane * G_RSR + 32 * dir; unpack8(*(const LAS u32x4*)rp, rv); unpack8(*(const LAS u32x4*)(rp + 16), rv + 8); }
    const LAS float* UPL = (const LAS float*)(l + G_UP) + dir * 1024; const LAS float* BIASL = (const LAS float*)(l + G_BIAS) + dir * 64;
#pragma unroll
    for (int grp = 0; grp < 4; ++grp) {
        float lgv[4];
        if (!S3) {
            f32x4 z4 = *(const LAS f32x4*)(BIASL + 16 * dq + 4 * grp);
#pragma unroll
            for (int r = 0; r < 16; ++r) z4 += rv[r] * *(const LAS f32x4*)(UPL + r * 64 + 16 * dq + 4 * grp);
#pragma unroll
            for (int q = 0; q < 4; ++q) { lgv[q] = -(fmaxf(-z4[q], 0.f) + __logf(1.0f + __expf(-fabsf(z4[q])))) * 0.0625f;
                lgbuf[(size_t)(dir * 64 + 16 * dq + 4 * grp + q) * 64 + lane] = __builtin_bit_cast(unsigned short, (_Float16)lgv[q]); }
        } else {
#pragma unroll
            for (int q = 0; q < 4; ++q) lgv[q] = (float)__builtin_bit_cast(_Float16, pf.lg[4 * grp + q]);
        }
        __builtin_amdgcn_sched_barrier(0);
        const u32x2 kraw = *(const LAS u32x2*)(l + G_KR + lane * G_RS + 32 * dq + 8 * grp);
        const float kv[4] = {bflo(kraw.x), bfhi(kraw.x), bflo(kraw.y), bfhi(kraw.y)};
        float qv[4] = {0.f, 0.f, 0.f, 0.f};
        if (S3) { const u32x2 qraw = *(const LAS u32x2*)(l + G_QR + lane * G_RS + 32 * dq + 8 * grp); qv[0] = bflo(qraw.x); qv[1] = bfhi(qraw.x); qv[2] = bflo(qraw.y); qv[3] = bfhi(qraw.y); }
        float qd[4], kd[4];
#pragma unroll
        for (int q = 0; q < 4; ++q) {
            const int d = 16 * dq + 4 * grp + q;
            const float lg = lgv[q];
            float tot;
            const float incl = wave_incl_scan_tot(lg, lane, tot);
            const float G = dir ? (tot - incl + lg) : incl;
            if (!S3) {
                const float kp = kv[q] * __expf(tot - G);
                *(LAS bf16_t*)(l + G_QF + (dir * 64 + d) * G_RS + lane * 2) = f2bf(kp);
                if (lane == 0) gdec_out[dir * 256 + h * 64 + d] = __expf(tot);
            } else {
                qd[q] = qv[q] * 0.125f * __expf(G); kd[q] = kv[q] * __expf(-G);
            }
        }
        if (S3) {
            u32x2 qo, ko; qo.x = cvt_pk_bf16(qd[0], qd[1]); qo.y = cvt_pk_bf16(qd[2], qd[3]); ko.x = cvt_pk_bf16(kd[0], kd[1]); ko.y = cvt_pk_bf16(kd[2], kd[3]);
            *(LAS u32x2*)(l + (dir ? G_QB : G_QF) + lane * G_RS + 32 * dq + 8 * grp) = qo;
            *(LAS u32x2*)(l + (dir ? G_KB : G_KF) + lane * G_RS + 32 * dq + 8 * grp) = ko;
        }
        __builtin_amdgcn_sched_barrier(0);
    }
}
__device__ __forceinline__ void gla_s1_item(const Params& p, int item, int next_item, GlaPF& pf, LAS unsigned char* l, unsigned lbase, int tid) {
    const int lane = tid & 63, w = __builtin_amdgcn_readfirstlane(tid >> 6);
    const int h = item & 3, c = (item >> 2) & 63, seq = item >> 8, r0 = seq * 4096 + c * 64;
    const bf16_t* proj = (const bf16_t*)(p.ws + WS_PROJ);
    float* gdec = (float*)(p.ws + WS_GDEC) + (size_t)((seq * 64 + c) * 2) * 256;
    gla_pf_store<false>(pf, l, tid);
    u32x4 vr[2];
#pragma unroll
    for (int k = 0; k < 2; ++k) { const int i = tid + 512 * k, row = i >> 4, ch = i & 15; vr[k] = *(const u32x4*)(proj + (size_t)(r0 + row) * PC + C_V + 128 * h + ch * 8); }
    LBAR();
    gla_prep<false>(l, lane, w, h, gdec, pf, (unsigned short*)(p.ws + WS_LG) + (size_t)item * 8192);
#pragma unroll
    for (int k = 0; k < 2; ++k) { const int i = tid + 512 * k, row = i >> 4, ch = i & 15; *(LAS u32x4*)(l + G_V + row * G_RSV + ch * 16) = vr[k]; }
    if (next_item >= 0) gla_pf_load<false>(pf, p, next_item, tid);
    LBAR();
    const int dir = w >> 2, dvb0 = (w & 3) * 2, g = lane >> 4, ln = lane & 15;
    LAS unsigned char* stg = l + G_STG1 + w * 4608;
#pragma unroll
    for (int i = 0; i < 2; ++i) {
        bf16x8 A[2];
#pragma unroll
        for (int ks = 0; ks < 2; ++ks) A[ks] = frag_tr(lbase + G_V, G_RSV, 32 * ks, 16 * (dvb0 + i), lane);
#pragma unroll
        for (int n = 0; n < 4; ++n) { f32x4 acc = {0.f, 0.f, 0.f, 0.f};
#pragma unroll
            for (int ks = 0; ks < 2; ++ks) acc = MFMA16(A[ks], frag_row(l + G_QF + dir * 64 * G_RS, G_RS, 16 * n, 32 * ks, lane), acc);
#pragma unroll
            for (int r = 0; r < 4; ++r) *(LAS bf16_t*)(stg + (16 * i + 4 * g + r) * G_RS + (16 * n + ln) * 2) = f2bf(acc[r]); }
    }
    asm volatile("" ::: "memory");
    bf16_t* GS = (bf16_t*)(p.ws + WS_GS) + ((size_t)(((seq * 64 + c) * 2 + dir) * 4 + h)) * 8192 + (size_t)dvb0 * 16 * 64;
#pragma unroll
    for (int k = 0; k < 4; ++k) { const int i = lane + 64 * k, row = i >> 3, ch = i & 7; *(u32x4*)(GS + row * 64 + ch * 8) = *(const LAS u32x4*)(stg + row * G_RS + ch * 16); }
    LBAR();
}
__device__ __forceinline__ void gla_s3_item(const Params& p, int item, int next_item, GlaPF& pf, LAS unsigned char* l, unsigned lbase, int tid) {
    const int lane = tid & 63, w = __builtin_amdgcn_readfirstlane(tid >> 6);
    const int h = item & 3, c = (item >> 2) & 63, seq = item >> 8, r0 = seq * 4096 + c * 64;
    const bf16_t* proj = (const bf16_t*)(p.ws + WS_PROJ);
    gla_pf_store<true>(pf, l, tid);
    u32x4 vr[2], ogr[2], str[4];
    const bf16_t* GSb = (const bf16_t*)(p.ws + WS_GS);
#pragma unroll
    for (int k = 0; k < 2; ++k) { const int i = tid + 512 * k, row = i >> 4, ch = i & 15; const bf16_t* pr = proj + (size_t)(r0 + row) * PC;
        vr[k] = *(const u32x4*)(pr + C_V + 128 * h + ch * 8); ogr[k] = *(const u32x4*)(pr + C_OG + 128 * h + ch * 8); }
#pragma unroll
    for (int k = 0; k < 4; ++k) { const int i = tid + 512 * k, dir = i >> 10, row = (i >> 3) & 127, ch = i & 7;
        str[k] = *(const u32x4*)(GSb + ((size_t)(((seq * 64 + c) * 2 + dir) * 4 + h)) * 8192 + row * 64 + ch * 8); }
    const int g = lane >> 4, ln = lane & 15, tb = w >> 1, dvh = w & 1;
    LBAR();
    gla_prep<true>(l, lane, w, h, nullptr, pf, nullptr);
#pragma unroll
    for (int k = 0; k < 2; ++k) { const int i = tid + 512 * k, row = i >> 4, ch = i & 15; *(LAS u32x4*)(l + G_V + row * G_RSV + ch * 16) = vr[k]; *(LAS u32x4*)(l + G_OGR + row * G_RSV + ch * 16) = ogr[k]; }
#pragma unroll
    for (int k = 0; k < 4; ++k) { const int i = tid + 512 * k, dir = i >> 10, row = (i >> 3) & 127, ch = i & 7; *(LAS u32x4*)(l + (dir ? G_SBT : G_SFT) + row * G_RS + ch * 16) = str[k]; }
    if (next_item >= 0) gla_pf_load<true>(pf, p, next_item, tid);
    LBAR();
    {
        const int ti = w >> 1;
#pragma unroll
        for (int k = 0; k < 2; ++k) { const int si = 2 * (w & 1) + k; f32x4 af = {0.f, 0.f, 0.f, 0.f}, ab = {0.f, 0.f, 0.f, 0.f};
            if (ti >= si) {
#pragma unroll
                for (int ks = 0; ks < 2; ++ks) af = MFMA16(frag_row(l + G_QF, G_RS, 16 * ti, 32 * ks, lane), frag_row(l + G_KF, G_RS, 16 * si, 32 * ks, lane), af); }
            if (ti <= si) {
#pragma unroll
                for (int ks = 0; ks < 2; ++ks) ab = MFMA16(frag_row(l + G_QB, G_RS, 16 * ti, 32 * ks, lane), frag_row(l + G_KB, G_RS, 16 * si, 32 * ks, lane), ab); }
#pragma unroll
            for (int r = 0; r < 4; ++r) { const int t = 16 * ti + 4 * g + r, s = 16 * si + ln; *(LAS bf16_t*)(l + G_ATT + t * G_RS + s * 2) = f2bf(s <= t ? af[r] : ab[r]); }
        }
    }
    LBAR();
    f32x4 acc[4];
#pragma unroll
    for (int i = 0; i < 4; ++i) acc[i] = (f32x4){0.f, 0.f, 0.f, 0.f};
#pragma unroll
    for (int ks = 0; ks < 2; ++ks) {
        const bf16x8 a_att = frag_row(l + G_ATT, G_RS, 16 * tb, 32 * ks, lane), a_qf = frag_row(l + G_QF, G_RS, 16 * tb, 32 * ks, lane), a_qb = frag_row(l + G_QB, G_RS, 16 * tb, 32 * ks, lane);
        bf16x8 vb[4]; frag_tr4(vb, lbase + G_V, G_RSV, 32 * ks, 64 * dvh, 16, lane);
#pragma unroll
        for (int i = 0; i < 4; ++i) { const int dvb = dvh * 4 + i;
            acc[i] = MFMA16(a_att, vb[i], acc[i]);
            acc[i] = MFMA16(a_qf, frag_row(l + G_SFT, G_RS, 16 * dvb, 32 * ks, lane), acc[i]);
            acc[i] = MFMA16(a_qb, frag_row(l + G_SBT, G_RS, 16 * dvb, 32 * ks, lane), acc[i]); }
    }
#pragma unroll
    for (int r = 0; r < 4; ++r) { float s = 0.f;
#pragma unroll
        for (int i = 0; i < 4; ++i) s += acc[i][r] * acc[i][r];
        s += shfl_idx(s, lane ^ 1); s += shfl_idx(s, lane ^ 2); s += shfl_idx(s, lane ^ 4); s += shfl_idx(s, lane ^ 8);
        if (ln == 0) *(LAS float*)(l + G_SSQ + ((16 * tb + 4 * g + r) * 2 + dvh) * 4) = s; }
    LBAR();
    LAS unsigned char* stg = l + G_STG3 + w * 2304;
#pragma unroll
    for (int r = 0; r < 4; ++r) { const int t = 16 * tb + 4 * g + r; const LAS float* sp = (const LAS float*)(l + G_SSQ + t * 8);
        const float rstd = rsqrtf((sp[0] + sp[1]) * (1.0f / 128.0f) + EPS);
#pragma unroll
        for (int i = 0; i < 4; ++i) { const int dvl = 16 * i + ln; const float og = bf2f(*(const LAS bf16_t*)(l + G_OGR + t * G_RSV + (64 * dvh + dvl) * 2));
            *(LAS bf16_t*)(stg + (4 * g + r) * G_RS + dvl * 2) = f2bf(acc[i][r] * rstd * ((const LAS float*)(l + G_GNW))[64 * dvh + dvl] * siluf_(og)); } }
    asm volatile("" ::: "memory");
    bf16_t* OG = (bf16_t*)(p.ws + WS_OG) + (size_t)(r0 + 16 * tb) * 512 + 128 * h + 64 * dvh;
#pragma unroll
    for (int k = 0; k < 2; ++k) { const int i = lane + 64 * k, row = i >> 3, ch = i & 7; *(u32x4*)(OG + (size_t)row * 512 + ch * 8) = *(const LAS u32x4*)(stg + row * G_RS + ch * 16); }
    LBAR();
}

constexpr int S_XS = 0, S_BM = 67584, S_CM = 86016, S_MB = 104448, S_DT = 139264, S_AC = 143360, S_W8 = 147456, S_RSX = 528, S_RS = 144, S_RSM = 272;
template <bool S3>
__device__ __forceinline__ void ssd_prep(const Params& p, const bf16_t* proj, int seq, int c, int gi, LAS unsigned char* l, int tid, float* sdec_out) {
    const int lane = tid & 63, w = __builtin_amdgcn_readfirstlane(tid >> 6);
    const int tok0 = c * 128; constexpr int NV = S3 ? 48 : 40, NST = S3 ? 10 : 12, TS = S3 ? 13 : 11;
    const int dir = w >> 2, j = w & 3, hd = 4 * gi + j, r0 = seq * 4096 + tok0;
    const int dcol = (dir ? C_DTB : C_DTF) + hd;
    const float raw0 = bf2f(proj[(size_t)(r0 + lane) * PC + dcol]), raw1 = bf2f(proj[(size_t)(r0 + lane + 64) * PC + dcol]);
    const float dtb = (dir ? p.dt_bias_b : p.dt_bias_f)[hd], alog = (dir ? p.a_log_b : p.a_log_f)[hd];
    if (tid < NV * NST) {
        const int cv = tid % NV, t0 = (tid / NV) * TS;
        const int col = cv < 32 ? C_XBC + 256 * gi + 8 * cv : (cv < 40 ? C_BM + 64 * gi + 8 * (cv - 32) : C_CM + 64 * gi + 8 * (cv - 40));
        const int ch = col - C_XBC;
        u32x4 raw[TS + 4];
#pragma unroll
        for (int i = 0; i < TS + 4; ++i) { const int tt = tok0 + t0 + i - 2; raw[i] = (u32x4){0u, 0u, 0u, 0u};
            if (tt >= 0 && tt < 4096 && t0 + i - 2 < 130) raw[i] = *(const u32x4*)(proj + (size_t)(seq * 4096 + tt) * PC + col); }
        typedef float f32x2 __attribute__((ext_vector_type(2)));
        f32x2 wv[5][4], bv[4];
#pragma unroll
        for (int i = 0; i < 5; ++i) { const f32x4 a = *(const f32x4*)(p.conv_w + i * 1536 + ch), b = *(const f32x4*)(p.conv_w + i * 1536 + ch + 4);
            wv[i][0] = (f32x2){a[0], a[1]}; wv[i][1] = (f32x2){a[2], a[3]}; wv[i][2] = (f32x2){b[0], b[1]}; wv[i][3] = (f32x2){b[2], b[3]}; }
        { const f32x4 a = *(const f32x4*)(p.conv_b + ch), b = *(const f32x4*)(p.conv_b + ch + 4); bv[0] = (f32x2){a[0], a[1]}; bv[1] = (f32x2){a[2], a[3]}; bv[2] = (f32x2){b[0], b[1]}; bv[3] = (f32x2){b[2], b[3]}; }
        LAS unsigned char* dst0 = cv < 32 ? l + S_XS + cv * 16 : (cv < 40 ? l + S_BM + (cv - 32) * 16 : l + S_CM + (cv - 40) * 16); const int drs = cv < 32 ? S_RSX : S_RS;
        f32x2 xw[5][4];
#pragma unroll
        for (int i = 0; i < 4; ++i) { const u32x4 rr = raw[i]; xw[i][0] = (f32x2){bflo(rr.x), bfhi(rr.x)}; xw[i][1] = (f32x2){bflo(rr.y), bfhi(rr.y)}; xw[i][2] = (f32x2){bflo(rr.z), bfhi(rr.z)}; xw[i][3] = (f32x2){bflo(rr.w), bfhi(rr.w)}; }
#pragma unroll
        for (int o = 0; o < TS; ++o) { const int t = t0 + o;
            { const u32x4 rr = raw[o + 4]; xw[4][0] = (f32x2){bflo(rr.x), bfhi(rr.x)}; xw[4][1] = (f32x2){bflo(rr.y), bfhi(rr.y)}; xw[4][2] = (f32x2){bflo(rr.z), bfhi(rr.z)}; xw[4][3] = (f32x2){bflo(rr.w), bfhi(rr.w)}; }
            if (t < 128) { u32x4 pk;
#pragma unroll
                for (int k = 0; k < 4; ++k) { f32x2 a = bv[k];
#pragma unroll
                    for (int i = 0; i < 5; ++i) a = xw[i][k] * wv[i][k] + a;
                    const unsigned pw = cvt_pk_bf16(siluf_(a[0]), siluf_(a[1])); if (k == 0) pk.x = pw; else if (k == 1) pk.y = pw; else if (k == 2) pk.z = pw; else pk.w = pw; }
                *(LAS u32x4*)(dst0 + t * drs) = pk; }
#pragma unroll
            for (int i = 0; i < 4; ++i)
#pragma unroll
                for (int k = 0; k < 4; ++k) xw[i][k] = xw[i + 1][k];
        }
    }
    {
        const float A = -__expf(alog);
        const float dt0 = softplusf_(raw0 + dtb), dt1 = softplusf_(raw1 + dtb);
        const float la0 = dt0 * A, la1 = dt1 * A;
        float tot0, tot1; const float s0 = wave_incl_scan_tot(la0, lane, tot0), s1 = wave_incl_scan_tot(la1, lane, tot1); const float total = tot0 + tot1;
        float ac0, ac1;
        if (dir == 0) { ac0 = s0; ac1 = tot0 + s1; } else { ac0 = total - (s0 - la0); ac1 = total - (tot0 + s1 - la1); }
        LAS float* DT = (LAS float*)(l + S_DT) + (dir * 4 + j) * 128; LAS float* AC = (LAS float*)(l + S_AC) + (dir * 4 + j) * 128;
        DT[lane] = dt0; DT[lane + 64] = dt1; AC[lane] = ac0; AC[lane + 64] = ac1;
        if (!S3) { LAS float* W8 = (LAS float*)(l + S_W8) + (dir * 4 + j) * 128; W8[lane] = dt0 * __expf(total - ac0); W8[lane + 64] = dt1 * __expf(total - ac1);
            if (lane == 0) sdec_out[dir * 16 + hd] = __expf(total); }
    }
}
__device__ __forceinline__ void ssd_s1_item(const Params& p, int item, LAS unsigned char* l, unsigned lbase, int tid) {
    const int lane = tid & 63, w = __builtin_amdgcn_readfirstlane(tid >> 6);
    const int gi = item & 3, c = (item >> 2) & 31, seq = item >> 7;
    const bf16_t* proj = (const bf16_t*)(p.ws + WS_PROJ);
    float* sdec = (float*)(p.ws + WS_SDEC) + (size_t)((seq * 32 + c) * 2) * 16;
    ssd_prep<false>(p, proj, seq, c, gi, l, tid, sdec);
    __syncthreads();
    const int dir = w >> 2, j = w & 3, hd = 4 * gi + j, g = lane >> 4, ln = lane & 15;
    f32x4 acc[4][4];
#pragma unroll
    for (int a = 0; a < 4; ++a)
#pragma unroll
        for (int b = 0; b < 4; ++b) acc[a][b] = (f32x4){0.f, 0.f, 0.f, 0.f};
#pragma unroll
    for (int ks = 0; ks < 4; ++ks) {
        bf16x8 A[4], B[4], Braw[4];
        frag_tr4(A, lbase + S_XS, S_RSX, 32 * ks, 64 * j, 16, lane);
        frag_tr4(Braw, lbase + S_BM, S_RS, 32 * ks, 0, 16, lane);
        const LAS float* wp = (const LAS float*)(l + S_W8) + (dir * 4 + j) * 128 + 32 * ks + 8 * g;
        const f32x4 w0 = *(const LAS f32x4*)wp, w1 = *(const LAS f32x4*)(wp + 4);
#pragma unroll
        for (int ni = 0; ni < 4; ++ni) { const bf16x8 b = Braw[ni]; float o[8];
#pragma unroll
            for (int jj = 0; jj < 8; ++jj) o[jj] = bf2f((unsigned short)b[jj]) * (jj < 4 ? w0[jj & 3] : w1[jj & 3]);
            const u32x4 pk = pack8(o); B[ni] = __builtin_bit_cast(bf16x8, pk); }
#pragma unroll
        for (int pi = 0; pi < 4; ++pi)
#pragma unroll
            for (int ni = 0; ni < 4; ++ni) acc[pi][ni] = MFMA16(A[pi], B[ni], acc[pi][ni]);
    }
    __syncthreads();
    LAS unsigned char* stg = l + S_XS + w * 9216;
#pragma unroll
    for (int pi = 0; pi < 4; ++pi)
#pragma unroll
        for (int ni = 0; ni < 4; ++ni)
#pragma unroll
            for (int r = 0; r < 4; ++r) *(LAS bf16_t*)(stg + (16 * pi + 4 * g + r) * S_RS + (16 * ni + ln) * 2) = f2bf(acc[pi][ni][r]);
    asm volatile("" ::: "memory");
    bf16_t* SS = (bf16_t*)(p.ws + WS_SS) + ((size_t)(((seq * 32 + c) * 2 + dir) * 16 + hd)) * 4096;
#pragma unroll
    for (int k = 0; k < 8; ++k) { const int i = lane + 64 * k, row = i >> 3, ch = i & 7; *(u32x4*)(SS + row * 64 + ch * 8) = *(const LAS u32x4*)(stg + row * S_RS + ch * 16); }
    __syncthreads();
}
__device__ __forceinline__ void ssd_s3_item(const Params& p, int row0, int item, LAS unsigned char* l, unsigned lbase, int tid) {
    const int lane = tid & 63, w = __builtin_amdgcn_readfirstlane(tid >> 6);
    const int gi = item & 3, c = (item >> 2) & 31, seq = item >> 7, r0 = seq * 4096 + c * 128;
    const bf16_t* proj = (const bf16_t*)(p.ws + WS_PROJ);
    const bf16_t* SSb = (const bf16_t*)(p.ws + WS_SS);
    const int sdir = tid >> 8, si_ = tid & 255, srow0 = si_ >> 3, sch = si_ & 7;
    const bf16_t* sp0 = SSb + ((size_t)(((seq * 32 + c) * 2 + sdir) * 16 + 4 * gi)) * 4096 + srow0 * 64 + sch * 8;
    u32x4 sa = *(const u32x4*)sp0, sb = *(const u32x4*)(sp0 + 32 * 64);
    ssd_prep<true>(p, proj, seq, c, gi, l, tid, nullptr);
    __syncthreads();
    const int g = lane >> 4, ln = lane & 15;
    f32x4 cb[8];
#pragma unroll
    for (int si = 0; si < 8; ++si) { cb[si] = (f32x4){0.f, 0.f, 0.f, 0.f};
#pragma unroll
        for (int ks = 0; ks < 2; ++ks) cb[si] = MFMA16(frag_row(l + S_CM, S_RS, 16 * w, 32 * ks, lane), frag_row(l + S_BM, S_RS, 16 * si, 32 * ks, lane), cb[si]); }
    __syncthreads();
    bf16_t* Y = (bf16_t*)(p.ws + WS_Y);
    const int erow = lane >> 2, epc = lane & 3;
    float ssq = 0.f;
    for (int j = 0; j < 4; ++j) {
        const int hd = 4 * gi + j;
        *(LAS u32x4*)(l + S_BM + sdir * 9216 + srow0 * S_RS + sch * 16) = sa; *(LAS u32x4*)(l + S_BM + sdir * 9216 + (srow0 + 32) * S_RS + sch * 16) = sb;
        if (j < 3) { sa = *(const u32x4*)(sp0 + (size_t)(j + 1) * 4096); sb = *(const u32x4*)(sp0 + (size_t)(j + 1) * 4096 + 32 * 64); }
        const bf16_t* zp = proj + (size_t)(r0 + 16 * w + erow) * PC + C_Z + 64 * hd + 16 * epc;
        const u32x4 z0 = *(const u32x4*)zp, z1 = *(const u32x4*)(zp + 8);
        const LAS float* DTf = (const LAS float*)(l + S_DT) + j * 128; const LAS float* DTb = DTf + 512;
        const LAS float* ACf = (const LAS float*)(l + S_AC) + j * 128; const LAS float* ACb = ACf + 512;
        const float dsk = p.d_skip[hd];
#pragma unroll
        for (int si = 0; si < 8; ++si) { const int s = 16 * si + ln;
            if (si < w) { const float afs = ACf[s], dfs = DTf[s];
#pragma unroll
                for (int r = 0; r < 4; ++r) { const int lr = 16 * w + 4 * g + r; *(LAS bf16_t*)(l + S_MB + lr * S_RSM + s * 2) = f2bf(cb[si][r] * __expf(ACf[lr] - afs) * dfs); } }
            else if (si > w) { const float abs_ = ACb[s], dbs = DTb[s];
#pragma unroll
                for (int r = 0; r < 4; ++r) { const int lr = 16 * w + 4 * g + r; *(LAS bf16_t*)(l + S_MB + lr * S_RSM + s * 2) = f2bf(cb[si][r] * __expf(ACb[lr] - abs_) * dbs); } }
            else { const float afs = ACf[s], abs_ = ACb[s], dfs = DTf[s], dbs = DTb[s];
#pragma unroll
                for (int r = 0; r < 4; ++r) { const int lr = 16 * w + 4 * g + r;
                    const float wt = (s <= lr) ? __expf(ACf[lr] - afs) * dfs : __expf(ACb[lr] - abs_) * dbs;
                    const float v = cb[si][r] * wt + (s == lr ? dsk : 0.f);
                    *(LAS bf16_t*)(l + S_MB + lr * S_RSM + s * 2) = f2bf(v); } } }
        __syncthreads();
        f32x4 ay[4], af[4], ab[4];
#pragma unroll
        for (int pi = 0; pi < 4; ++pi) { ay[pi] = (f32x4){0.f, 0.f, 0.f, 0.f}; af[pi] = ay[pi]; ab[pi] = ay[pi]; }
#pragma unroll
        for (int ks = 0; ks < 4; ++ks) { const bf16x8 am = frag_row(l + S_MB, S_RSM, 16 * w, 32 * ks, lane); bf16x8 xb[4]; frag_tr4(xb, lbase + S_XS, S_RSX, 32 * ks, 64 * j, 16, lane);
#pragma unroll
            for (int pi = 0; pi < 4; ++pi) ay[pi] = MFMA16(am, xb[pi], ay[pi]); }
#pragma unroll
        for (int ks = 0; ks < 2; ++ks) { const bf16x8 ac = frag_row(l + S_CM, S_RS, 16 * w, 32 * ks, lane);
#pragma unroll
            for (int pi = 0; pi < 4; ++pi) { af[pi] = MFMA16(ac, frag_row(l + S_BM, S_RS, 16 * pi, 32 * ks, lane), af[pi]);
                ab[pi] = MFMA16(ac, frag_row(l + S_BM + 9216, S_RS, 16 * pi, 32 * ks, lane), ab[pi]); } }
#pragma unroll
        for (int r = 0; r < 4; ++r) { const int lr = 16 * w + 4 * g + r; const float ef = __expf(ACf[lr]), eb = __expf(ACb[lr]);
#pragma unroll
            for (int pi = 0; pi < 4; ++pi) *(LAS float*)(l + S_MB + lr * S_RSM + (16 * pi + ln) * 4) = ay[pi][r] + ef * af[pi][r] + eb * ab[pi][r]; }
        asm volatile("" ::: "memory");
        {   float zv[16], yv[16];
            unpack8(z0, zv); unpack8(z1, zv + 8);
            const LAS unsigned char* yp = l + S_MB + (16 * w + erow) * S_RSM + epc * 64;
#pragma unroll
            for (int q = 0; q < 4; ++q) { const f32x4 t4 = *(const LAS f32x4*)(yp + 16 * q); yv[4 * q] = t4[0]; yv[4 * q + 1] = t4[1]; yv[4 * q + 2] = t4[2]; yv[4 * q + 3] = t4[3]; }
#pragma unroll
            for (int q = 0; q < 16; ++q) { yv[q] *= siluf_(zv[q]); ssq += yv[q] * yv[q]; }
            bf16_t* yo = Y + (size_t)(r0 + 16 * w + erow) * 1024 + 64 * hd + 16 * epc;
            *(u32x4*)yo = pack8(yv); *(u32x4*)(yo + 8) = pack8(yv + 8); }
        __syncthreads();
    }
    float* rssy = (float*)(p.ws + WS_RSSY) + (size_t)row0;
    ssq += shfl_idx(ssq, lane ^ 1); ssq += shfl_idx(ssq, lane ^ 2);
    if (epc == 0) atomicAdd(rssy + r0 + 16 * w + erow, ssq);
}

template <bool GLA>
__device__ __forceinline__ void scan_job(bf16_t* base, const float* dec, int dir) {
    constexpr int NCH = GLA ? 64 : 32; constexpr size_t CST = GLA ? 65536 : 131072; constexpr int DST = GLA ? 512 : 32; constexpr int UN = 4;
    float run[8];
#pragma unroll
    for (int e = 0; e < 8; ++e) run[e] = 0.f;
    const long long cstep = dir ? -(long long)CST : (long long)CST; const int dstep = dir ? -DST : DST;
    bf16_t* bp = base + (dir ? (size_t)(NCH - 1) * CST : 0); const float* dp = dec + (dir ? (NCH - 1) * DST : 0);
    for (int c0 = 0; c0 < NCH; c0 += UN) {
        u32x4 loc[UN]; f32x4 d0[UN], d1[UN];
#pragma unroll
        for (int u = 0; u < UN; ++u) { loc[u] = *(const u32x4*)(bp + u * cstep);
            if (GLA) { d0[u] = *(const f32x4*)(dp + u * dstep); d1[u] = *(const f32x4*)(dp + u * dstep + 4); } else { const float dv = dp[u * dstep]; d0[u] = (f32x4){dv, dv, dv, dv}; d1[u] = d0[u]; } }
#pragma unroll
        for (int u = 0; u < UN; ++u) { float lv[8]; unpack8(loc[u], lv);
            *(u32x4*)(bp + u * cstep) = pack8(run);
#pragma unroll
            for (int e = 0; e < 8; ++e) run[e] = (e < 4 ? d0[u][e & 3] : d1[u][e & 3]) * run[e] + lv[e]; }
        bp += UN * cstep; dp += UN * dstep;
    }
}
__device__ __forceinline__ void phase_scan(const Params& p, int nseq, int tid) {
    const int NG = nseq * 8192, NS = nseq * 16384;
    const int gt = blockIdx.x * 512 + tid, GT = gridDim.x * 512;
    for (int job = gt; job < NG + NS; job += GT) {
        if (job < NG) { const int e8 = job & 1023, h = (job >> 10) & 3, dir = (job >> 12) & 1, seq = job >> 13;
            scan_job<true>((bf16_t*)(p.ws + WS_GS) + ((size_t)((seq * 64 * 2 + dir) * 4 + h)) * 8192 + e8 * 8, (const float*)(p.ws + WS_GDEC) + (size_t)((seq * 64 * 2 + dir) * 4 + h) * 64 + ((e8 * 8) & 63), dir);
        } else { const int j2 = job - NG, e8 = j2 & 511, hd = (j2 >> 9) & 15, dir = (j2 >> 13) & 1, seq = j2 >> 14;
            scan_job<false>((bf16_t*)(p.ws + WS_SS) + ((size_t)((seq * 32 * 2 + dir) * 16 + hd)) * 4096 + e8 * 8, (const float*)(p.ws + WS_SDEC) + (size_t)((seq * 32 * 2 + dir) * 16 + hd), dir); }
    }
}

constexpr int LDS_BYTES = 160 * 1024;
#if defined(__HIP_DEVICE_COMPILE__)
typedef const __attribute__((address_space(4))) Params* KP;
#define KPARAMS() ({ unsigned long long k_ = (unsigned long long)__builtin_amdgcn_kernarg_segment_ptr(); asm volatile("" : "+s"(k_)); *(KP)k_; })
#define KWS() ({ unsigned long long k_ = (unsigned long long)__builtin_amdgcn_kernarg_segment_ptr(); asm volatile("" : "+s"(k_)); (unsigned char*)*(const __attribute__((address_space(4))) unsigned long long*)(k_ + 26 * 8); })
#else
#define KPARAMS() (p_unused)
#define KWS() (p_unused.ws)
#endif
#define GBAR() do { XcdBarrier b_; b_.bar = (unsigned*)(KWS() + WS_BAR); b_.x = xb_xcc_id(); b_.st = (volatile LAS unsigned*)(l + LDS_BYTES - 16); xcd_barrier(b_); } while (0)
#define OTID() ({ int t_ = threadIdx.x; asm volatile("" : "+v"(t_)); t_; })

template <int hb>
__device__ __forceinline__ void half_pass(const Params& p_unused, LAS unsigned char* l, const unsigned lbase, cg::grid_group& grid, const int G, const int bx) {
        constexpr int ROW0 = PASS_ROW0[hb], NR = PASS_ROWS[hb], NSQ = PASS_SEQ[hb], NSSD = NSQ * 128, NIT = NSQ * 384;
        { const Params q = KPARAMS(); phase_u(q, ROW0, NR, OTID()); }
        if (hb == 0) grid.sync(); else GBAR();
        {
            const Params q = KPARAMS(); unsigned char* ws = q.ws; bf16_t* PROJ = (bf16_t*)(ws + WS_PROJ);
            pg8::Gemm g{(const bf16_t*)(ws + WS_U), (const bf16_t*)(ws + WS_WIN), NR, 6400, 1024}; pg8::StaticOrder S; S.init(NR, 6400, G, bx);
            EpiProj E{PROJ}; pg8::gemm_phase<EpiProj, pg8::StaticOrder, true, true>(l, g, S, E);
        }
        GBAR();
        {   GlaPF pf; const int itg0 = bx + ((NSSD - bx + G - 1) / G) * G;
            if (itg0 < NIT) { const Params p = KPARAMS(); gla_pf_load<false>(pf, p, itg0 - NSSD, OTID()); }
            for (int it = bx; it < NIT; it += G) { const Params p = KPARAMS(); const int tid = OTID(); if (it < NSSD) ssd_s1_item(p, it, l, lbase, tid); else gla_s1_item(p, it - NSSD, it + G < NIT ? it + G - NSSD : -1, pf, l, lbase, tid); }
        }
        GBAR();
        { const Params q = KPARAMS(); phase_scan(q, NSQ, OTID()); }
        GBAR();
        {   GlaPF pf; const int itg0 = bx + ((NSSD - bx + G - 1) / G) * G;
            if (itg0 < NIT) { const Params p = KPARAMS(); gla_pf_load<true>(pf, p, itg0 - NSSD, OTID()); }
            for (int it = bx; it < NIT; it += G) { const Params p = KPARAMS(); const int tid = OTID(); if (it < NSSD) ssd_s3_item(p, ROW0, it, l, lbase, tid); else gla_s3_item(p, it - NSSD, it + G < NIT ? it + G - NSSD : -1, pf, l, lbase, tid); }
        }
        GBAR();
        {
            const Params p = KPARAMS(); unsigned char* ws = p.ws; bf16_t* PROJ = (bf16_t*)(ws + WS_PROJ);
            pg8::StaticOrder S; S.init(NR, 1024, G, bx);
            pg8::Gemm g1{(const bf16_t*)(ws + WS_OG), (const bf16_t*)(ws + WS_WB1), NR, 1024, 512};
            EpiM1 E1{PROJ, (bf16_t*)(ws + WS_T)}; pg8::gemm_phase<EpiM1, pg8::StaticOrder, true, true>(l, g1, S, E1);
            pg8::Gemm g2{(const bf16_t*)(ws + WS_Y), (const bf16_t*)(ws + WS_WB2), NR, 1024, 1024};
            EpiM2 E2{PROJ, (const bf16_t*)(ws + WS_T), (bf16_t*)(ws + WS_MM), (const float*)(ws + WS_RSSY) + (size_t)ROW0}; pg8::gemm_phase<EpiM2, pg8::StaticOrder, true, true>(l, g2, S, E2);
        }
        GBAR();
        {
            const Params p = KPARAMS(); unsigned char* ws = p.ws; bf16_t* PROJ = (bf16_t*)(ws + WS_PROJ);
            pg8::StaticOrder S; S.init(NR, 1024, G, bx);
            pg8::Gemm g{(const bf16_t*)(ws + WS_MM), (const bf16_t*)(ws + WS_WOUT), NR, 1024, 1024};
            EpiOut E{p, ROW0, (bf16_t*)(ws + WS_X1B), (float*)(ws + WS_RSS1)}; pg8::gemm_phase<EpiOut, pg8::StaticOrder, true, true>(l, g, S, E);
        }
        GBAR();
        {
            const Params p = KPARAMS(); unsigned char* ws = p.ws; bf16_t* PROJ = (bf16_t*)(ws + WS_PROJ);
            pg8::StaticOrder S; S.init(NR, 5632, G, bx);
            pg8::Gemm g{(const bf16_t*)(ws + WS_X1B), (const bf16_t*)(ws + WS_WGU), NR, 5632, 1024};
            EpiSwi E{(const float*)(ws + WS_RSS1) + (size_t)ROW0, PROJ}; pg8::gemm_phase<EpiSwi, pg8::StaticOrder, true, true>(l, g, S, E);
        }
        GBAR();
        {
            const Params p = KPARAMS(); unsigned char* ws = p.ws; bf16_t* PROJ = (bf16_t*)(ws + WS_PROJ);
            pg8::StaticOrder S; S.init(NR, 1024, G, bx);
            pg8::Gemm g{(const bf16_t*)PROJ, (const bf16_t*)(ws + WS_WD), NR, 1024, DFF};
            EpiDown E{p.out, ROW0, (float*)(ws + WS_RSS2)}; pg8::gemm_phase<EpiDown, pg8::StaticOrder, true, true>(l, g, S, E);
        }
    __syncthreads();
}

__global__ void __launch_bounds__(512) mega(Params p_unused) {
    extern __shared__ __attribute__((aligned(16))) unsigned char lds_raw[];
    cg::grid_group grid = cg::this_grid();
    LAS unsigned char* l = (LAS unsigned char*)lds_raw;
    const unsigned lbase = (unsigned)(size_t)l;
    const int G = gridDim.x, bx = blockIdx.x;
    volatile LAS unsigned* xst = (volatile LAS unsigned*)(l + LDS_BYTES - 16);
    { const int t0_ = OTID(); if (t0_ < 4) xst[t0_] = 0u; }
    __syncthreads();
    (void)xcd_barrier_post((unsigned*)(KWS() + WS_BAR), xst);
    { const Params q = KPARAMS(); phase_weights(q, l, OTID()); }
    half_pass<0>(p_unused, l, lbase, grid, G, bx);
    half_pass<1>(p_unused, l, lbase, grid, G, bx);
    GBAR();
    {
        const Params p = KPARAMS(); unsigned char* ws = p.ws; const int tid = OTID();
        const float* rss2 = (const float*)(ws + WS_RSS2);
        const size_t GT = (size_t)G * 512;
        for (size_t i0 = (size_t)bx * 512 + tid; i0 < (size_t)NTOK * 256; i0 += 4 * GT) {
            f32x4 v[4]; float rs[4];
#pragma unroll
            for (int k = 0; k < 4; ++k) { const size_t i = i0 + k * GT; if (i < (size_t)NTOK * 256) { v[k] = ((const f32x4*)p.out)[i]; rs[k] = rss2[i >> 8]; } }
#pragma unroll
            for (int k = 0; k < 4; ++k) { const size_t i = i0 + k * GT; if (i < (size_t)NTOK * 256) { const float r = rsqrtf(rs[k] * (1.0f / 1024.0f) + EPS); const f32x4 w = ((const f32x4*)p.norm_final_w)[i & 255];
                f32x4 o = v[k]; o[0] *= r * w[0]; o[1] *= r * w[1]; o[2] *= r * w[2]; o[3] *= r * w[3]; ((f32x4*)p.out)[i] = o; } }
        }
    }
}

extern "C" void kernel_launch(void* const* d_in, const int* in_sizes, int n_in, void* d_out, int out_size, void* d_ws, size_t ws_size, hipStream_t stream) {
    static int grid_blocks = 0;
    if (!grid_blocks) {
        int dev = 0, cus = 0, per_cu = 0;
        (void)hipGetDevice(&dev);
        (void)hipDeviceGetAttribute(&cus, hipDeviceAttributeMultiprocessorCount, dev);
        (void)hipFuncSetAttribute((const void*)mega, hipFuncAttributeMaxDynamicSharedMemorySize, LDS_BYTES);
        (void)hipOccupancyMaxActiveBlocksPerMultiprocessor(&per_cu, (const void*)mega, 512, LDS_BYTES);
        if (per_cu < 1) per_cu = 1;
        grid_blocks = cus * per_cu;
        if (ws_size < WS_END) fprintf(stderr, "workspace too small: %zu < %zu\n", ws_size, (size_t)WS_END);
    }
    Params p{};
    const float** pp = (const float**)&p;
    for (int i = 0; i < 25; ++i) pp[i] = (const float*)d_in[i];
    p.out = (float*)d_out; p.ws = (unsigned char*)d_ws;
    (void)hipMemsetAsync((unsigned char*)d_ws + WS_BAR, 0, (size_t)XCD_BAR_WORDS_ * 4, stream);
    void* args[] = {&p};
    hipError_t e = hipLaunchCooperativeKernel((const void*)mega, dim3(grid_blocks), dim3(512), args, LDS_BYTES, stream);
    if (e != hipSuccess) fprintf(stderr, "cooperative launch failed: %s (grid %d)\n", hipGetErrorString(e), grid_blocks);
}
```

```cpp
#include <hip/hip_runtime.h>
#include <hip/hip_cooperative_groups.h>
#include <cstdio>
namespace cg = cooperative_groups;

namespace pg8 {
#define PG8_LAS __attribute__((address_space(3)))
typedef unsigned short bf16_t;
typedef short bf16x8 __attribute__((ext_vector_type(8)));
typedef float f32x4 __attribute__((ext_vector_type(4)));
typedef unsigned u32x4 __attribute__((ext_vector_type(4)));
constexpr int BM = 256, BK = 64, HALF = 128, HTB = HALF * BK * 2  , STAGE_BYTES = 8 * HTB, NXCD = 8, WGM = 8;

__host__ __device__ __forceinline__ int lds_byte(int r, int c) { const int st = (r >> 4) * 2 + (c >> 5), rr = r & 15, cc = c & 31, ob = rr * 64 + cc * 2; return st * 1024 + (ob ^ (((ob >> 9) & 1) << 5)); }
__host__ __device__ __forceinline__ void stage_rc(int b, int& R, int& C) { const int st = b / 1024, sb = b % 1024, swz = sb ^ (((sb >> 9) & 1) << 5); R = (st >> 1) * 16 + swz / 64; C = (st & 1) * 32 + (swz % 64) / 2; }
__host__ __device__ __forceinline__ int perm32(int rho) { const int n = rho >> 4, i = rho & 15; return 8 * (i >> 2) + 4 * n + (i & 3); }

struct Unit { int pm, pn; };
struct Gemm { const bf16_t* A; const bf16_t* Bt; int M, N, K; };

struct StaticOrder {
    int nM, nN, nwg, G, c;
    __host__ __device__ void init(int M, int N, int G_, int c_) { nM = M / BM; nN = N / BM; nwg = nM * nN; G = G_; c = c_; }
    __host__ __device__ bool next(int i, Unit& u) const {
        const long L = (long)i * G + c; if (L >= nwg) return false;
        int wgid = (int)L; { const int q = nwg / NXCD, r = nwg % NXCD, xcd = wgid % NXCD, off = wgid / NXCD; wgid = (xcd < r ? xcd * (q + 1) : r * (q + 1) + (xcd - r) * q) + off; }
        const int nig = WGM * nN, gid = wgid / nig, fm = gid * WGM, gsz = (nM - fm) < WGM ? (nM - fm) : WGM;
        u.pm = fm + ((wgid % nig) % gsz); u.pn = (wgid % nig) / gsz; return true;
    }
    __device__ __forceinline__ void a_ready(const Unit&) const {}
    __device__ __forceinline__ void done(const Unit&) const {}
};
typedef float f32x2_t_ __attribute__((ext_vector_type(2)));
typedef __bf16 bf16x2_t_ __attribute__((ext_vector_type(2)));
__device__ __forceinline__ unsigned cvt_pk_bf16(float lo, float hi) { const f32x2_t_ v = {lo, hi}; const bf16x2_t_ b = __builtin_convertvector(v, bf16x2_t_); return __builtin_bit_cast(unsigned, b); }
template <class Epi, class Sched, bool ALIGN_EPI = false, bool SP2 = false>
__device__ __forceinline__ void gemm_phase(PG8_LAS unsigned char* lds, const Gemm g, const Sched& S, const Epi& E) {
    int tid_ = threadIdx.x; asm volatile("" : "+v"(tid_)); const int tid = tid_, wid = __builtin_amdgcn_readfirstlane(tid >> 6), lane = tid & 63, wr = wid >> 2, wc = wid & 3, fr = lane & 15, fq = lane >> 4;
    const int K = g.K, nt = K / BK;
    unsigned voffA[2], voffB[2];
#pragma unroll
    for (int i = 0; i < 2; ++i) { int R, C; stage_rc(tid * 16 + i * 8192, R, C); const int Rb = Epi::PERM ? ((R & ~31) + perm32(R & 31)) : R;
        voffA[i] = (unsigned)(R * K + C) * 2u; voffB[i] = (unsigned)(Rb * K + C) * 2u; }
    const size_t kstep = (size_t)(BK * 2);
    const size_t hstep = (size_t)HALF * K * 2;
    const size_t tstep = 2 * hstep;
    const unsigned ldsw = (unsigned)wid * 1024u;
    const int aoff = lds_byte(wr * 64 + fr, fq * 8), boff = lds_byte(wc * 32 + fr, fq * 8);
#define PG8_SA(b, h) (((b) * 2 + (h)) * HTB)
#define PG8_SB(b, h) ((4 + (b) * 2 + (h)) * HTB)
#define PG8_STAGE(bufoff, gbase, voff) do { _Pragma("unroll") for (int _i = 0; _i < 2; ++_i) \
        __builtin_amdgcn_global_load_lds((const unsigned*)((const char*)(gbase) + (voff)[_i]), (PG8_LAS unsigned*)(lds + (bufoff) + ldsw + _i * 8192), 16, 0, 0); } while (0)
#define PG8_LDA(dst, b, h) do { _Pragma("unroll") for (int m = 0; m < 4; ++m) _Pragma("unroll") for (int k = 0; k < 2; ++k) dst[m][k] = *(const PG8_LAS bf16x8*)(lds + PG8_SA(b, h) + aoff + m * 2048 + k * 1024); } while (0)
#define PG8_LDB(dst, b, h) do { _Pragma("unroll") for (int n = 0; n < 2; ++n) _Pragma("unroll") for (int k = 0; k < 2; ++k) dst[n][k] = *(const PG8_LAS bf16x8*)(lds + PG8_SB(b, h) + boff + n * 2048 + k * 1024); } while (0)
#define PG8_MMA(ai, bj, At, Bt) do { __builtin_amdgcn_s_setprio(1); _Pragma("unroll") for (int m = 0; m < 4; ++m) _Pragma("unroll") for (int n = 0; n < 2; ++n) _Pragma("unroll") for (int k = 0; k < 2; ++k) \
        acc[ai][bj][m][n] = __builtin_amdgcn_mfma_f32_16x16x32_bf16(Bt[n][k], At[m][k], acc[ai][bj][m][n], 0, 0, 0); __builtin_amdgcn_s_setprio(0); } while (0)
#define PG8_WAIT_V(n) asm volatile("s_waitcnt vmcnt(" #n ")" ::: "memory")
#define PG8_WAIT_L(n) asm volatile("s_waitcnt lgkmcnt(" #n ")" ::: "memory")
#define PG8_BAR __builtin_amdgcn_s_barrier()
#define PG8_SCHED __builtin_amdgcn_sched_barrier(0)
    Unit cur, nxt; int ui = 0;
    if (!S.next(0, cur)) return;
    f32x4 acc[2][2][4][2];
#pragma unroll
    for (int a = 0; a < 2; ++a)
#pragma unroll
        for (int b = 0; b < 2; ++b)
#pragma unroll
            for (int m = 0; m < 4; ++m)
#pragma unroll
                for (int n = 0; n < 2; ++n) acc[a][b][m][n] = (f32x4){0.f, 0.f, 0.f, 0.f};
    bf16x8 At[4][2], B0[2][2], B1[2][2];
    const char* cA = (const char*)g.A + (size_t)cur.pm * tstep; const char* cB = (const char*)g.Bt + (size_t)cur.pn * tstep;
    S.a_ready(cur);
    if constexpr (SP2) {
        PG8_STAGE(PG8_SB(0, 0), cB, voffB); PG8_STAGE(PG8_SB(0, 1), cB + hstep, voffB); PG8_STAGE(PG8_SA(0, 0), cA, voffA); PG8_STAGE(PG8_SA(0, 1), cA + hstep, voffA);
        if (wr == 1) PG8_BAR;
        PG8_WAIT_V(2); PG8_BAR;
        PG8_STAGE(PG8_SB(1, 0), cB + kstep, voffB); PG8_STAGE(PG8_SA(1, 0), cA + kstep, voffA); PG8_STAGE(PG8_SB(1, 1), cB + hstep + kstep, voffB);
        PG8_WAIT_V(6); PG8_BAR;
    } else {
        PG8_STAGE(PG8_SB(0, 0), cB, voffB); PG8_STAGE(PG8_SA(0, 0), cA, voffA); PG8_STAGE(PG8_SB(0, 1), cB + hstep, voffB); PG8_STAGE(PG8_SA(0, 1), cA + hstep, voffA);
        if (wr == 1) PG8_BAR;
        PG8_WAIT_V(4); PG8_BAR;
        PG8_STAGE(PG8_SB(1, 0), cB + kstep, voffB); PG8_STAGE(PG8_SA(1, 0), cA + kstep, voffA); PG8_STAGE(PG8_SB(1, 1), cB + hstep + kstep, voffB);
        PG8_WAIT_V(6); PG8_BAR;
    }
    for (;;) {
        const bool has_next = S.next(ui + 1, nxt);
        const char* nA = has_next ? (const char*)g.A + (size_t)nxt.pm * tstep : cA; const char* nB = has_next ? (const char*)g.Bt + (size_t)nxt.pn * tstep : cB;
        for (int t = 0; t < nt; t += 2) {
            const bool last = (t == nt - 2);
            const char* a1 = cA + (size_t)(t + 1) * kstep;
            const char* a2 = last ? nA : cA + (size_t)(t + 2) * kstep; const char* b2 = last ? nB : cB + (size_t)(t + 2) * kstep;
            const char* a3 = a2 + kstep; const char* b3 = b2 + kstep;
            if (last && has_next) S.a_ready(nxt);
            if constexpr (SP2) {
            PG8_LDB(B0, 0, 0); PG8_LDB(B1, 0, 1); PG8_SCHED; PG8_LDA(At, 0, 0); PG8_STAGE(PG8_SA(1, 1), a1 + hstep, voffA);
            PG8_WAIT_V(8); PG8_WAIT_L(0); PG8_BAR; PG8_MMA(0, 0, At, B0); PG8_MMA(0, 1, At, B1); PG8_BAR; PG8_SCHED;
            PG8_LDA(At, 0, 1); PG8_STAGE(PG8_SB(0, 0), b2, voffB); PG8_STAGE(PG8_SB(0, 1), b2 + hstep, voffB); PG8_STAGE(PG8_SA(0, 0), a2, voffA);
            PG8_WAIT_V(8); PG8_WAIT_L(0); PG8_BAR; PG8_MMA(1, 0, At, B0); PG8_MMA(1, 1, At, B1); PG8_BAR; PG8_SCHED;
            PG8_LDB(B0, 1, 0); PG8_LDB(B1, 1, 1); PG8_SCHED; PG8_LDA(At, 1, 0); PG8_STAGE(PG8_SA(0, 1), a2 + hstep, voffA);
            PG8_WAIT_V(8); PG8_WAIT_L(0); PG8_BAR; PG8_MMA(0, 0, At, B0); PG8_MMA(0, 1, At, B1); PG8_BAR; PG8_SCHED;
            PG8_LDA(At, 1, 1); PG8_STAGE(PG8_SB(1, 0), b3, voffB); PG8_STAGE(PG8_SB(1, 1), b3 + hstep, voffB); PG8_STAGE(PG8_SA(1, 0), a3, voffA);
            PG8_WAIT_V(8); PG8_WAIT_L(0); PG8_BAR; PG8_MMA(1, 0, At, B0); PG8_MMA(1, 1, At, B1); PG8_BAR; PG8_SCHED;
            } else {
            PG8_LDB(B0, 0, 0); PG8_SCHED; PG8_LDA(At, 0, 0); PG8_STAGE(PG8_SA(1, 1), a1 + hstep, voffA);
            PG8_WAIT_L(8); PG8_BAR; PG8_WAIT_L(0); PG8_MMA(0, 0, At, B0); PG8_BAR; PG8_SCHED;
            PG8_LDB(B1, 0, 1); PG8_STAGE(PG8_SB(0, 0), b2, voffB);
            PG8_BAR; PG8_WAIT_L(0); PG8_MMA(0, 1, At, B1); PG8_BAR;
            PG8_LDA(At, 0, 1); PG8_STAGE(PG8_SA(0, 0), a2, voffA);
            PG8_BAR; PG8_WAIT_L(0); PG8_MMA(1, 0, At, B0); PG8_BAR; PG8_SCHED;
            PG8_STAGE(PG8_SB(0, 1), b2 + hstep, voffB);
            PG8_WAIT_V(6); PG8_BAR; PG8_MMA(1, 1, At, B1); PG8_BAR;
            PG8_LDB(B0, 1, 0); PG8_SCHED; PG8_LDA(At, 1, 0); PG8_STAGE(PG8_SA(0, 1), a2 + hstep, voffA);
            PG8_WAIT_L(8); PG8_BAR; PG8_WAIT_L(0); PG8_MMA(0, 0, At, B0); PG8_BAR; PG8_SCHED;
            PG8_LDB(B1, 1, 1); PG8_STAGE(PG8_SB(1, 0), b3, voffB);
            PG8_BAR; PG8_WAIT_L(0); PG8_MMA(0, 1, At, B1); PG8_BAR;
            PG8_LDA(At, 1, 1); PG8_STAGE(PG8_SA(1, 0), a3, voffA);
            PG8_BAR; PG8_WAIT_L(0); PG8_MMA(1, 0, At, B0); PG8_BAR; PG8_SCHED;
            PG8_STAGE(PG8_SB(1, 1), b3 + hstep, voffB);
            PG8_WAIT_V(6); PG8_BAR; PG8_MMA(1, 1, At, B1); PG8_BAR;
            }
        }
        if constexpr (ALIGN_EPI) { if (wr == 0) PG8_BAR; }
        if constexpr (!Epi::AFTER_DRAIN) { E(acc, cur, wr, wc, fr, fq); S.done(cur); }
        if (!has_next) break;
#pragma unroll
        for (int a = 0; a < 2; ++a)
#pragma unroll
            for (int b = 0; b < 2; ++b)
#pragma unroll
                for (int m = 0; m < 4; ++m)
#pragma unroll
                    for (int n = 0; n < 2; ++n) acc[a][b][m][n] = (f32x4){0.f, 0.f, 0.f, 0.f};
        cur = nxt; cA = nA; cB = nB; ++ui;
        if constexpr (ALIGN_EPI) { if (wr == 1) PG8_BAR; }
    }
    PG8_WAIT_V(0);
    if constexpr (!ALIGN_EPI) { if (wr == 0) PG8_BAR; }
    PG8_BAR;
    if constexpr (Epi::AFTER_DRAIN) { E.fused(acc, cur, wr, wc, fr, fq, lds, wid, lane); S.done(cur); }
#undef PG8_SA
#undef PG8_SB
#undef PG8_STAGE
#undef PG8_LDA
#undef PG8_LDB
#undef PG8_MMA
#undef PG8_WAIT_V
#undef PG8_WAIT_L
#undef PG8_BAR
#undef PG8_SCHED
}
}


#define LAS __attribute__((address_space(3)))
typedef unsigned short bf16_t;
typedef short bf16x8 __attribute__((ext_vector_type(8)));
typedef float f32x4 __attribute__((ext_vector_type(4)));
typedef unsigned u32x4 __attribute__((ext_vector_type(4)));
typedef unsigned u32x2 __attribute__((ext_vector_type(2)));
typedef unsigned short u16x4 __attribute__((ext_vector_type(4)));
using pg8::cvt_pk_bf16;

constexpr int DM = 1024, NTOK = 81920, MH = 49152  , NSEQH = 12, NPTOK = 16384, PC = 6208, DFF = 2816;
constexpr int PASS_ROW0[2] = {0, 49152}, PASS_ROWS[2] = {49152, 32768}, PASS_SEQ[2] = {12, 8};
constexpr int C_Q = 0, C_K = 256, C_V = 512, C_OG = 1024, C_RF = 1536, C_Z = 1568, C_XBC = 2592, C_BM = 3616, C_CM = 3872, C_DTF = 4128, C_DTB = 4144, C_G1 = 4160, C_G2 = 5184;
constexpr float EPS = 1e-6f;
constexpr int XCD_BAR_WORDS_ = 3456;

constexpr size_t WS_WIN = 0;
constexpr size_t WS_WB1 = WS_WIN + (size_t)6400 * 1024 * 2;
constexpr size_t WS_WB2 = WS_WB1 + (size_t)1024 * 512 * 2;
constexpr size_t WS_WOUT = WS_WB2 + (size_t)1024 * 1024 * 2;
constexpr size_t WS_WGU = WS_WOUT + (size_t)1024 * 1024 * 2;
constexpr size_t WS_WD = WS_WGU + (size_t)5632 * 1024 * 2;
constexpr size_t WS_RSS1 = WS_WD + (size_t)1024 * 2816 * 2;
constexpr size_t WS_RSS2 = WS_RSS1 + (size_t)NTOK * 4;
constexpr size_t WS_RSSY = WS_RSS2 + (size_t)NTOK * 4;
constexpr size_t WS_GDEC = WS_RSSY + (size_t)NTOK * 4;
constexpr size_t WS_SDEC = WS_GDEC + (size_t)NSEQH * 64 * 2 * 4 * 64 * 4;
constexpr size_t WS_PROJ = WS_SDEC + (size_t)NSEQH * 32 * 2 * 16 * 4;
constexpr size_t WS_U = WS_PROJ + (size_t)MH * PC * 2;
constexpr size_t WS_OG = WS_U;
constexpr size_t WS_Y = WS_U + (size_t)MH * 512 * 2;
constexpr size_t WS_ST = WS_U + (size_t)MH * 1536 * 2;
constexpr size_t WS_GS = WS_ST;
constexpr size_t WS_SS = WS_ST + (size_t)MH * 2048;
constexpr size_t WS_T = WS_ST;
constexpr size_t WS_MM = WS_ST + (size_t)MH * 2048;
constexpr size_t WS_X1B = WS_U;
constexpr size_t WS_BAR = WS_ST + (size_t)MH * 4096;
constexpr size_t WS_LG = WS_BAR + 16384;
constexpr size_t WS_END = WS_LG + (size_t)NSEQH * 256 * 8192 * 2;
static_assert(WS_PROJ % 256 == 0 && WS_U % 256 == 0 && WS_ST % 256 == 0 && WS_END < (size_t)1070 * 1000 * 1000, "ws map");

struct Params {
    const float* xp; const float* xs; const float* norm_mix_w; const float* w_in; const float* gla_up_f; const float* gla_bias_f; const float* gla_up_b; const float* gla_bias_b;
    const float* gla_norm_w; const float* conv_w; const float* conv_b; const float* dt_bias_f; const float* dt_bias_b; const float* a_log_f; const float* a_log_b; const float* d_skip;
    const float* ssm_norm_w; const float* w_br_gla; const float* w_br_ssm; const float* w_out; const float* norm_ffn_w; const float* w_ffn_gate; const float* w_ffn_up; const float* w_ffn_down;
    const float* norm_final_w; float* out; unsigned char* ws;
};

__device__ __forceinline__ float bf2f(unsigned short b) { return __uint_as_float(((unsigned)b) << 16); }
__device__ __forceinline__ float bflo(unsigned u) { return __uint_as_float(u << 16); }
__device__ __forceinline__ float bfhi(unsigned u) { return __uint_as_float(u & 0xffff0000u); }
__device__ __forceinline__ unsigned short f2bf(float f) { return (unsigned short)(cvt_pk_bf16(f, 0.f) & 0xffffu); }
__device__ __forceinline__ float sigmoidf_(float x) { return __builtin_amdgcn_rcpf(1.0f + __expf(-x)); }
__device__ __forceinline__ float siluf_(float x) { return x * __builtin_amdgcn_rcpf(1.0f + __expf(-x)); }
__device__ __forceinline__ float softplusf_(float x) { return fmaxf(x, 0.f) + log1pf(__expf(-fabsf(x))); }
__device__ __forceinline__ const float* xrow(const Params& p, int grow) { return grow < NPTOK ? p.xp + (size_t)grow * DM : p.xs + (size_t)(grow - NPTOK) * DM; }
__device__ __forceinline__ void unpack8(const u32x4 v, float* o) { o[0] = bflo(v.x); o[1] = bfhi(v.x); o[2] = bflo(v.y); o[3] = bfhi(v.y); o[4] = bflo(v.z); o[5] = bfhi(v.z); o[6] = bflo(v.w); o[7] = bfhi(v.w); }
__device__ __forceinline__ u32x4 pack8(const float* o) { u32x4 w; w.x = cvt_pk_bf16(o[0], o[1]); w.y = cvt_pk_bf16(o[2], o[3]); w.z = cvt_pk_bf16(o[4], o[5]); w.w = cvt_pk_bf16(o[6], o[7]); return w; }
__device__ __forceinline__ float shfl_idx(float x, int src_lane) { return __int_as_float(__builtin_amdgcn_ds_bpermute(src_lane << 2, __float_as_int(x))); }
__device__ __forceinline__ float bcast_lane63(float x) { return __int_as_float(__builtin_amdgcn_readlane(__float_as_int(x), 63)); }
template <int N> __device__ __forceinline__ float dpp_row_shr(float x) { return __int_as_float(__builtin_amdgcn_update_dpp(0, __float_as_int(x), 0x110 + N, 0xf, 0xf, true)); }
__device__ __forceinline__ float wave_incl_scan_tot(float x, int lane, float& tot) {
    x += dpp_row_shr<1>(x); x += dpp_row_shr<2>(x); x += dpp_row_shr<4>(x); x += dpp_row_shr<8>(x);
    const float t0 = __int_as_float(__builtin_amdgcn_readlane(__float_as_int(x), 15)), t1 = __int_as_float(__builtin_amdgcn_readlane(__float_as_int(x), 31));
    const float t2 = __int_as_float(__builtin_amdgcn_readlane(__float_as_int(x), 47)), t3 = __int_as_float(__builtin_amdgcn_readlane(__float_as_int(x), 63));
    const int row = lane >> 4;
    const float add = (row >= 1 ? t0 : 0.f) + (row >= 2 ? t1 : 0.f) + (row >= 3 ? t2 : 0.f);
    tot = (t0 + t1) + (t2 + t3);
    return x + add;
}
__device__ __forceinline__ bf16x8 frag_row(const LAS unsigned char* base, int RS, int row0, int k0, int lane) {
    return *(const LAS bf16x8*)(base + (row0 + (lane & 15)) * RS + (k0 + 8 * (lane >> 4)) * 2);
}
__device__ __forceinline__ bf16x8 frag_tr(unsigned base_addr, int RS, int k0, int c0, int lane) {
    const int g = lane >> 4, q = (lane & 15) >> 2, pp = lane & 3;
    const unsigned a0 = base_addr + (unsigned)((k0 + 8 * g + q) * RS + (c0 + 4 * pp) * 2), a1 = a0 + 4u * (unsigned)RS;
    u16x4 lo, hi;
    asm volatile("ds_read_b64_tr_b16 %0, %2\n\tds_read_b64_tr_b16 %1, %3\n\ts_waitcnt lgkmcnt(0)" : "=&v"(lo), "=&v"(hi) : "v"(a0), "v"(a1) : "memory");
    bf16x8 r; r[0] = (short)lo[0]; r[1] = (short)lo[1]; r[2] = (short)lo[2]; r[3] = (short)lo[3]; r[4] = (short)hi[0]; r[5] = (short)hi[1]; r[6] = (short)hi[2]; r[7] = (short)hi[3];
    return r;
}
#define MFMA16(a, b, c) __builtin_amdgcn_mfma_f32_16x16x32_bf16(a, b, c, 0, 0, 0)
__device__ __forceinline__ void frag_tr4(bf16x8 (&r)[4], unsigned base_addr, int RS, int k0, int c0, int cstep, int lane) {
    const int g = lane >> 4, q = (lane & 15) >> 2, pp = lane & 3;
    const unsigned a0 = base_addr + (unsigned)((k0 + 8 * g + q) * RS + (c0 + 4 * pp) * 2), a1 = a0 + 4u * (unsigned)RS; const unsigned cs = (unsigned)cstep * 2u;
    u16x4 lo[4], hi[4];
#pragma unroll
    for (int i = 0; i < 4; ++i) { asm volatile("ds_read_b64_tr_b16 %0, %1" : "=&v"(lo[i]) : "v"(a0 + cs * i) : "memory"); asm volatile("ds_read_b64_tr_b16 %0, %1" : "=&v"(hi[i]) : "v"(a1 + cs * i) : "memory"); }
    asm volatile("s_waitcnt lgkmcnt(0)" : "+v"(lo[0]), "+v"(lo[1]), "+v"(lo[2]), "+v"(lo[3]), "+v"(hi[0]), "+v"(hi[1]), "+v"(hi[2]), "+v"(hi[3]) :: "memory");
#pragma unroll
    for (int i = 0; i < 4; ++i) { r[i][0] = (short)lo[i][0]; r[i][1] = (short)lo[i][1]; r[i][2] = (short)lo[i][2]; r[i][3] = (short)lo[i][3]; r[i][4] = (short)hi[i][0]; r[i][5] = (short)hi[i][1]; r[i][6] = (short)hi[i][2]; r[i][7] = (short)hi[i][3]; }
}


#define XB_TMO      128
#define XB_XCNT(j)  (256  + 64 * (j))
#define XB_XSUB(j)  (1280 + 64 * (j))
#define XB_XGEN(j)  (2304 + 64 * (j))
#define XB_TOP      3328
#define XB_TOPGEN   3392
#define XCD_BAR_WORDS 3456
#define XB_SPIN_CAP (1u << 18)

__device__ __forceinline__ unsigned xb_tid() { unsigned t_ = threadIdx.x; asm volatile("" : "+v"(t_)); return t_; }
__device__ __forceinline__ unsigned xb_ld(unsigned* p)              { return __hip_atomic_load(p, __ATOMIC_RELAXED, __HIP_MEMORY_SCOPE_AGENT); }
__device__ __forceinline__ unsigned xb_add(unsigned* p, unsigned v) { return __hip_atomic_fetch_add(p, v, __ATOMIC_RELAXED, __HIP_MEMORY_SCOPE_AGENT); }
__device__ __forceinline__ unsigned xb_xcc_id() { return (unsigned)__builtin_amdgcn_s_getreg((3 << 11) | 20) & 0xFu; }
#define XB_SPIN(cond, bar) do { unsigned _sp = 0; while (cond) { __builtin_amdgcn_s_sleep(1); \
    if ((++_sp & 255u) == 0u) { if (xb_ld(&(bar)[XB_TMO])) break; if (_sp > XB_SPIN_CAP) { atomicAdd(&(bar)[XB_TMO], 1u); break; } } } } while (0)

struct XcdBarrier {
    unsigned* bar; unsigned x;
    volatile LAS unsigned* st;
};

__device__ __forceinline__ XcdBarrier xcd_barrier_post(unsigned* bar, volatile LAS unsigned* st) {
    XcdBarrier b; b.bar = bar; b.x = xb_xcc_id(); b.st = st;
    if (xb_tid() == 0) (void)xb_add(&bar[XB_XCNT(b.x)], 1u);
    return b;
}
__device__ __forceinline__ void xcd_barrier_complete(unsigned* bar, unsigned x, unsigned& nloc, unsigned& nx) {
    const unsigned G = gridDim.x * gridDim.y * gridDim.z;
    unsigned sum, cnt, mine, sp = 0u;
    for (;;) {
        sum = 0u; cnt = 0u; mine = 0u;
#pragma unroll
        for (unsigned j = 0; j < 16; ++j) { const unsigned c = xb_ld(&bar[XB_XCNT(j)]); sum += c; cnt += (c > 0u) ? 1u : 0u; mine = (j == x) ? c : mine; }
        if (sum == G) break;
        __builtin_amdgcn_s_sleep(1);
        if ((++sp & 255u) == 0u) { if (xb_ld(&bar[XB_TMO])) break; if (sp > XB_SPIN_CAP) { atomicAdd(&bar[XB_TMO], 1u); break; } }
    }
    nloc = mine > 0u ? mine : 1u; nx = cnt > 0u ? cnt : 1u;
}

__device__ __forceinline__ void xcd_barrier(const XcdBarrier& b) {
    asm volatile("s_waitcnt vmcnt(0)" ::: "memory");
    __syncthreads();
    if (xb_tid() == 0) {
        unsigned* bar = b.bar;
        __builtin_amdgcn_s_waitcnt(0);
        unsigned nloc = b.st[0], nx = b.st[1];
        if (nloc == 0u) { xcd_barrier_complete(bar, b.x, nloc, nx); b.st[0] = nloc; b.st[1] = nx; }
        const unsigned old = xb_add(&bar[XB_XSUB(b.x)], 1u);
        const unsigned gen = old / nloc;
        if (old + 1u == (gen + 1u) * nloc) {
            __builtin_amdgcn_fence(__ATOMIC_RELEASE, "agent");
            asm volatile("s_waitcnt vmcnt(0)" ::: "memory");
            const unsigned og = xb_add(&bar[XB_TOP], 1u);
            const unsigned tg = og / nx;
            if (og + 1u == (tg + 1u) * nx) xb_add(&bar[XB_TOPGEN], 1u);
            else XB_SPIN(xb_ld(&bar[XB_TOPGEN]) == tg, bar);
            __builtin_amdgcn_fence(__ATOMIC_ACQUIRE, "agent");
            xb_add(&bar[XB_XGEN(b.x)], 1u);
            asm volatile("s_waitcnt vmcnt(0)" ::: "memory");
        } else {
            XB_SPIN(xb_ld(&bar[XB_XGEN(b.x)]) == gen, bar);
            __builtin_amdgcn_fence(__ATOMIC_ACQUIRE, "agent");
            asm volatile("s_waitcnt vmcnt(0)" ::: "memory");
        }
    }
    __syncthreads();
}

struct EpiProj {
    static constexpr bool PERM = true, AFTER_DRAIN = false;
    bf16_t* O;
    __device__ __forceinline__ void operator()(const f32x4 (&acc)[2][2][4][2], const pg8::Unit& u, int wr, int wc, int fr, int fq) const {
        const int row0 = u.pm * 256 + wr * 64 + fr, col0 = u.pn * 256 + wc * 32 + 8 * fq;
#pragma unroll
        for (int ai = 0; ai < 2; ++ai)
#pragma unroll
            for (int m = 0; m < 4; ++m) { bf16_t* rowp = O + (size_t)(row0 + ai * 128 + m * 16) * PC;
#pragma unroll
                for (int bj = 0; bj < 2; ++bj) { const int c = col0 + bj * 128; const f32x4 v0 = acc[ai][bj][m][0], v1 = acc[ai][bj][m][1];
                    u32x4 w; w.x = cvt_pk_bf16(v0[0], v0[1]); w.y = cvt_pk_bf16(v0[2], v0[3]); w.z = cvt_pk_bf16(v1[0], v1[1]); w.w = cvt_pk_bf16(v1[2], v1[3]);
                    if (c < PC) *(u32x4*)(rowp + c) = w; } }
    }
};
struct EpiM1 {
    static constexpr bool PERM = true, AFTER_DRAIN = false;
    const bf16_t* proj; bf16_t* T;
    __device__ __forceinline__ void operator()(const f32x4 (&acc)[2][2][4][2], const pg8::Unit& u, int wr, int wc, int fr, int fq) const {
        const int row0 = u.pm * 256 + wr * 64 + fr, col0 = u.pn * 256 + wc * 32 + 8 * fq;
#pragma unroll
        for (int ai = 0; ai < 2; ++ai) {
            u32x4 gq[4][2];
#pragma unroll
            for (int m = 0; m < 4; ++m)
#pragma unroll
                for (int bj = 0; bj < 2; ++bj) gq[m][bj] = *(const u32x4*)(proj + (size_t)(row0 + ai * 128 + m * 16) * PC + C_G1 + col0 + bj * 128);
#pragma unroll
            for (int m = 0; m < 4; ++m) { const int row = row0 + ai * 128 + m * 16;
#pragma unroll
                for (int bj = 0; bj < 2; ++bj) { const int c = col0 + bj * 128; float gv[8], o[8];
                    unpack8(gq[m][bj], gv);
#pragma unroll
                    for (int j = 0; j < 8; ++j) o[j] = sigmoidf_(gv[j]) * acc[ai][bj][m][j >> 2][j & 3];
                    *(u32x4*)(T + (size_t)row * DM + c) = pack8(o); } }
        }
    }
};
struct EpiM2 {
    static constexpr bool PERM = true, AFTER_DRAIN = false;
    const bf16_t* proj; const bf16_t* T; bf16_t* MMo; const float* rssy;
    __device__ __forceinline__ void operator()(const f32x4 (&acc)[2][2][4][2], const pg8::Unit& u, int wr, int wc, int fr, int fq) const {
        const int row0 = u.pm * 256 + wr * 64 + fr, col0 = u.pn * 256 + wc * 32 + 8 * fq;
#pragma unroll
        for (int ai = 0; ai < 2; ++ai)
#pragma unroll
            for (int mh = 0; mh < 2; ++mh) {
                u32x4 gq[2][2], tq[2][2]; float rsv[2];
#pragma unroll
                for (int mm = 0; mm < 2; ++mm) { const int row = row0 + ai * 128 + (2 * mh + mm) * 16; rsv[mm] = rssy[row];
#pragma unroll
                    for (int bj = 0; bj < 2; ++bj) { const int c = col0 + bj * 128; gq[mm][bj] = *(const u32x4*)(proj + (size_t)row * PC + C_G2 + c); tq[mm][bj] = *(const u32x4*)(T + (size_t)row * DM + c); } }
#pragma unroll
                for (int mm = 0; mm < 2; ++mm) { const int m = 2 * mh + mm, row = row0 + ai * 128 + m * 16; const float rs = rsqrtf(rsv[mm] * (1.0f / 1024.0f) + EPS);
#pragma unroll
                    for (int bj = 0; bj < 2; ++bj) { const int c = col0 + bj * 128; float gv[8], tv[8], o[8];
                        unpack8(gq[mm][bj], gv); unpack8(tq[mm][bj], tv);
#pragma unroll
                        for (int j = 0; j < 8; ++j) o[j] = tv[j] + sigmoidf_(gv[j]) * rs * acc[ai][bj][m][j >> 2][j & 3];
                        *(u32x4*)(MMo + (size_t)row * DM + c) = pack8(o); } }
            }
    }
};
struct EpiOut {
    static constexpr bool PERM = true, AFTER_DRAIN = false;
    Params p; int grow0; bf16_t* X1B; float* rss;
    __device__ __forceinline__ void operator()(const f32x4 (&acc)[2][2][4][2], const pg8::Unit& u, int wr, int wc, int fr, int fq) const {
        const int row0 = u.pm * 256 + wr * 64 + fr, col0 = u.pn * 256 + wc * 32 + 8 * fq, ln_ = fq * 16 + fr;
#pragma unroll
        for (int ai = 0; ai < 2; ++ai)
#pragma unroll
            for (int mh = 0; mh < 2; ++mh) {
                f32x4 xa[2][2][2];
#pragma unroll
                for (int mm = 0; mm < 2; ++mm) { const float* xr = xrow(p, grow0 + row0 + ai * 128 + (2 * mh + mm) * 16);
#pragma unroll
                    for (int bj = 0; bj < 2; ++bj) { xa[mm][bj][0] = *(const f32x4*)(xr + col0 + bj * 128); xa[mm][bj][1] = *(const f32x4*)(xr + col0 + bj * 128 + 4); } }
#pragma unroll
                for (int mm = 0; mm < 2; ++mm) { const int m = 2 * mh + mm, row = row0 + ai * 128 + m * 16, grow = grow0 + row; float* orow = p.out + (size_t)grow * DM; float ss = 0.f;
#pragma unroll
                    for (int bj = 0; bj < 2; ++bj) { const int c = col0 + bj * 128;
                        const f32x4 a = xa[mm][bj][0] + acc[ai][bj][m][0], b = xa[mm][bj][1] + acc[ai][bj][m][1];
                        *(f32x4*)(orow + c) = a; *(f32x4*)(orow + c + 4) = b;
                        ss += a[0] * a[0] + a[1] * a[1] + a[2] * a[2] + a[3] * a[3] + b[0] * b[0] + b[1] * b[1] + b[2] * b[2] + b[3] * b[3];
                        u32x4 w; w.x = cvt_pk_bf16(a[0], a[1]); w.y = cvt_pk_bf16(a[2], a[3]); w.z = cvt_pk_bf16(b[0], b[1]); w.w = cvt_pk_bf16(b[2], b[3]);
                        *(u32x4*)(X1B + (size_t)row * DM + c) = w; }
                    ss += shfl_idx(ss, ln_ ^ 16); ss += shfl_idx(ss, ln_ ^ 32);
                    if (fq == 0) atomicAdd(rss + grow, ss); }
            }
    }
};
struct EpiSwi {
    static constexpr bool PERM = true, AFTER_DRAIN = false;
    const float* rss; bf16_t* H;
    __device__ __forceinline__ void operator()(const f32x4 (&acc)[2][2][4][2], const pg8::Unit& u, int wr, int wc, int fr, int fq) const {
        const int row0 = u.pm * 256 + wr * 64 + fr, hc = u.pn * 128 + wc * 32 + 8 * fq;
        float rsv[2][4];
#pragma unroll
        for (int ai = 0; ai < 2; ++ai)
#pragma unroll
            for (int m = 0; m < 4; ++m) rsv[ai][m] = rss[row0 + ai * 128 + m * 16];
#pragma unroll
        for (int ai = 0; ai < 2; ++ai)
#pragma unroll
            for (int m = 0; m < 4; ++m) { const int row = row0 + ai * 128 + m * 16; const float rs = rsqrtf(rsv[ai][m] * (1.0f / 1024.0f) + EPS); float o[8];
#pragma unroll
                for (int j = 0; j < 8; ++j) { const float gt = rs * acc[ai][0][m][j >> 2][j & 3], up = rs * acc[ai][1][m][j >> 2][j & 3]; o[j] = siluf_(gt) * up; }
                *(u32x4*)(H + (size_t)row * DFF + hc) = pack8(o); }
    }
};
struct EpiDown {
    static constexpr bool PERM = true, AFTER_DRAIN = false;
    float* out; int grow0; float* rss;
    __device__ __forceinline__ void operator()(const f32x4 (&acc)[2][2][4][2], const pg8::Unit& u, int wr, int wc, int fr, int fq) const {
        const int row0 = u.pm * 256 + wr * 64 + fr, col0 = u.pn * 256 + wc * 32 + 8 * fq, ln_ = fq * 16 + fr;
#pragma unroll
        for (int ai = 0; ai < 2; ++ai)
#pragma unroll
            for (int mh = 0; mh < 2; ++mh) {
                f32x4 xa[2][2][2];
#pragma unroll
                for (int mm = 0; mm < 2; ++mm) { const float* xr = out + (size_t)(grow0 + row0 + ai * 128 + (2 * mh + mm) * 16) * DM;
#pragma unroll
                    for (int bj = 0; bj < 2; ++bj) { xa[mm][bj][0] = *(const f32x4*)(xr + col0 + bj * 128); xa[mm][bj][1] = *(const f32x4*)(xr + col0 + bj * 128 + 4); } }
#pragma unroll
                for (int mm = 0; mm < 2; ++mm) { const int m = 2 * mh + mm, grow = grow0 + row0 + ai * 128 + m * 16; float* orow = out + (size_t)grow * DM; float ss = 0.f;
#pragma unroll
                    for (int bj = 0; bj < 2; ++bj) { const int c = col0 + bj * 128;
                        const f32x4 a = xa[mm][bj][0] + acc[ai][bj][m][0], b = xa[mm][bj][1] + acc[ai][bj][m][1];
                        *(f32x4*)(orow + c) = a; *(f32x4*)(orow + c + 4) = b;
                        ss += a[0] * a[0] + a[1] * a[1] + a[2] * a[2] + a[3] * a[3] + b[0] * b[0] + b[1] * b[1] + b[2] * b[2] + b[3] * b[3]; }
                    ss += shfl_idx(ss, ln_ ^ 16); ss += shfl_idx(ss, ln_ ^ 32);
                    if (fq == 0) atomicAdd(rss + grow, ss); }
            }
    }
};

__device__ __forceinline__ void transpose_tile(const float* src, int N, int k0, int n0, bf16_t* dst, int K, int mode, const float* kscale, LAS float* tl, int tid) {
    for (int i = tid; i < 1024; i += 512) { const int kk = i >> 4, n4 = (i & 15) * 4; f32x4 v = *(const f32x4*)(src + (size_t)(k0 + kk) * N + n0 + n4); if (kscale) v *= kscale[k0 + kk];
        tl[kk * 65 + n4] = v[0]; tl[kk * 65 + n4 + 1] = v[1]; tl[kk * 65 + n4 + 2] = v[2]; tl[kk * 65 + n4 + 3] = v[3]; }
    __syncthreads();
    for (int i = tid; i < 2048; i += 512) { const int nn = i >> 5, kp = i & 31; const float a = tl[(2 * kp) * 65 + nn], b = tl[(2 * kp + 1) * 65 + nn]; const int n = n0 + nn;
        const int row = mode == 0 ? n : (256 * (n >> 7) + (n & 127) + (mode == 2 ? 128 : 0));
        *(unsigned*)(dst + (size_t)row * K + k0 + 2 * kp) = cvt_pk_bf16(a, b); }
    __syncthreads();
}
__device__ __forceinline__ void phase_weights(const Params& p, LAS unsigned char* l, int tid) {
    unsigned char* ws = p.ws; LAS float* tl = (LAS float*)l;
    for (int j = blockIdx.x; j < 4304; j += gridDim.x) {
        if (j < 1552) transpose_tile(p.w_in, PC, (j / 97) * 64, (j % 97) * 64, (bf16_t*)(ws + WS_WIN), 1024, 0, nullptr, tl, tid);
        else if (j < 1680) { const int t = j - 1552; transpose_tile(p.w_br_gla, 1024, (t / 16) * 64, (t % 16) * 64, (bf16_t*)(ws + WS_WB1), 512, 0, nullptr, tl, tid); }
        else if (j < 1936) { const int t = j - 1680; transpose_tile(p.w_br_ssm, 1024, (t / 16) * 64, (t % 16) * 64, (bf16_t*)(ws + WS_WB2), 1024, 0, p.ssm_norm_w, tl, tid); }
        else if (j < 2192) { const int t = j - 1936; transpose_tile(p.w_out, 1024, (t / 16) * 64, (t % 16) * 64, (bf16_t*)(ws + WS_WOUT), 1024, 0, nullptr, tl, tid); }
        else if (j < 2896) { const int t = j - 2192; transpose_tile(p.w_ffn_gate, DFF, (t / 44) * 64, (t % 44) * 64, (bf16_t*)(ws + WS_WGU), 1024, 1, p.norm_ffn_w, tl, tid); }
        else if (j < 3600) { const int t = j - 2896; transpose_tile(p.w_ffn_up, DFF, (t / 44) * 64, (t % 44) * 64, (bf16_t*)(ws + WS_WGU), 1024, 2, p.norm_ffn_w, tl, tid); }
        else { const int t = j - 3600; transpose_tile(p.w_ffn_down, 1024, (t / 16) * 64, (t % 16) * 64, (bf16_t*)(ws + WS_WD), DFF, 0, nullptr, tl, tid); }
    }
    const int gt = blockIdx.x * 512 + tid, GT = gridDim.x * 512;
    unsigned* zw = (unsigned*)(ws + WS_WIN + (size_t)PC * 1024 * 2);
    for (int i = gt; i < 192 * 1024 / 2; i += GT) zw[i] = 0u;
    float* rs = (float*)(ws + WS_RSS1);
    for (int i = gt; i < 3 * NTOK; i += GT) rs[i] = 0.f;
}
__device__ __forceinline__ void phase_u(const Params& p, int row0, int nrows, int tid) {
    const int wave = tid >> 6, lane = tid & 63; bf16_t* U = (bf16_t*)(p.ws + WS_U);
    const int RST = gridDim.x * 8;
    for (int rb = blockIdx.x * 8 + wave; rb < nrows; rb += 2 * RST) {
        f32x4 v[2][4]; float ss[2] = {0.f, 0.f};
#pragma unroll
        for (int q = 0; q < 2; ++q) { const int r = rb + q * RST; if (r < nrows) { const float* xr = xrow(p, row0 + r);
#pragma unroll
            for (int i = 0; i < 4; ++i) v[q][i] = ((const f32x4*)xr)[lane + 64 * i]; } else {
#pragma unroll
            for (int i = 0; i < 4; ++i) v[q][i] = (f32x4){0.f, 0.f, 0.f, 0.f}; } }
        f32x4 wv[4];
#pragma unroll
        for (int i = 0; i < 4; ++i) wv[i] = ((const f32x4*)p.norm_mix_w)[lane + 64 * i];
#pragma unroll
        for (int q = 0; q < 2; ++q) {
#pragma unroll
            for (int i = 0; i < 4; ++i) ss[q] += v[q][i][0] * v[q][i][0] + v[q][i][1] * v[q][i][1] + v[q][i][2] * v[q][i][2] + v[q][i][3] * v[q][i][3];
#pragma unroll
            for (int o = 1; o < 64; o <<= 1) ss[q] += shfl_idx(ss[q], lane ^ o);
            const float rstd = rsqrtf(ss[q] * (1.0f / 1024.0f) + EPS); const int r = rb + q * RST;
            if (r < nrows) {
#pragma unroll
                for (int i = 0; i < 4; ++i) { u32x2 o; o.x = cvt_pk_bf16(v[q][i][0] * rstd * wv[i][0], v[q][i][1] * rstd * wv[i][1]); o.y = cvt_pk_bf16(v[q][i][2] * rstd * wv[i][2], v[q][i][3] * rstd * wv[i][3]);
                    *(u32x2*)(U + (size_t)r * DM + 4 * (lane + 64 * i)) = o; } }
        }
    }
}

constexpr int G_QF = 0, G_KF = 9216, G_QB = 18432, G_KB = 27648, G_V = 36864, G_ATT = 54272, G_SFT = 63488, G_SBT = 81920, G_SSQ = 100352, G_RS = 144, G_RSV = 272,
              G_UP = 101376, G_BIAS = 109568, G_KR = 110080, G_QR = 119296, G_RFB = 128512, G_RSR = 80, G_OGR = 133632, G_STG3 = 110080, G_STG1 = 63488, G_GNW = 151040;
struct GlaPF { u32x4 k, q, rf; f32x4 up, bias, gnw; unsigned short lg[16]; };
template <bool S3>
__device__ __forceinline__ void gla_pf_load(GlaPF& f, const Params& p, int item, int tid) {
    const int h = item & 3, c = (item >> 2) & 63, seq = item >> 8, r0 = seq * 4096 + c * 64;
    const bf16_t* proj = (const bf16_t*)(p.ws + WS_PROJ);
    { const int row = tid >> 3, ch = tid & 7; const bf16_t* pr = proj + (size_t)(r0 + row) * PC; f.k = *(const u32x4*)(pr + C_K + 64 * h + ch * 8); if (S3) f.q = *(const u32x4*)(pr + C_Q + 64 * h + ch * 8); }
    if (!S3) {
        if (tid < 256) { const int row = tid >> 2, ch = tid & 3; f.rf = *(const u32x4*)(proj + (size_t)(r0 + row) * PC + C_RF + ch * 8); }
        { const int dr = tid >> 8, r = (tid >> 4) & 15, d4 = tid & 15; f.up = *(const f32x4*)((dr ? p.gla_up_b : p.gla_up_f) + r * 256 + 64 * h + 4 * d4); }
        if (tid < 32) f.bias = *(const f32x4*)(((tid >> 4) ? p.gla_bias_b : p.gla_bias_f) + 64 * h + 4 * (tid & 15));
    } else {
        if (tid >= 64 && tid < 96) f.gnw = *(const f32x4*)(p.gla_norm_w + 4 * (tid - 64));
        const unsigned short* lgp = (const unsigned short*)(p.ws + WS_LG) + (size_t)item * 8192 + (size_t)((tid >> 8) * 64 + ((tid >> 6) & 3) * 16) * 64 + (tid & 63);
#pragma unroll
        for (int dd = 0; dd < 16; ++dd) f.lg[dd] = lgp[dd * 64];
    }
}
template <bool S3>
__device__ __forceinline__ void gla_pf_store(const GlaPF& f, LAS unsigned char* l, int tid) {
    { const int row = tid >> 3, ch = tid & 7; *(LAS u32x4*)(l + G_KR + row * G_RS + ch * 16) = f.k; if (S3) *(LAS u32x4*)(l + G_QR + row * G_RS + ch * 16) = f.q; }
    if (!S3) {
        if (tid < 256) { const int row = tid >> 2, ch = tid & 3; *(LAS u32x4*)(l + G_RFB + row * G_RSR + ch * 16) = f.rf; }
        *(LAS f32x4*)(l + G_UP + tid * 16) = f.up;
        if (tid < 32) *(LAS f32x4*)(l + G_BIAS + tid * 16) = f.bias;
    } else if (tid >= 64 && tid < 96) *(LAS f32x4*)(l + G_GNW + (tid - 64) * 16) = f.gnw;
}
#define LBAR() do { asm volatile("s_waitcnt lgkmcnt(0)" ::: "memory"); __builtin_amdgcn_s_barrier(); asm volatile("" ::: "memory"); } while (0)
template <bool S3>
__device__ __forceinline__ void gla_prep(LAS unsigned char* l, int lane, int w, int h, float* gdec_out, const GlaPF& pf, unsigned short* lgbuf) {
    const int dir = w >> 2, dq = w & 3;
    float rv[16];
    if (!S3) { const LAS unsigned char* rp = l + G_RFB + lane * G_RSR + 32 * dir; unpack8(*(const LAS u32x4*)rp, rv); unpack8(*(const LAS u32x4*)(rp + 16), rv + 8); }
    const LAS float* UPL = (const LAS float*)(l + G_UP) + dir * 1024; const LAS float* BIASL = (const LAS float*)(l + G_BIAS) + dir * 64;
#pragma unroll
    for (int grp = 0; grp < 4; ++grp) {
        float lgv[4];
        if (!S3) {
            f32x4 z4 = *(const LAS f32x4*)(BIASL + 16 * dq + 4 * grp);
#pragma unroll
            for (int r = 0; r < 16; ++r) z4 += rv[r] * *(const LAS f32x4*)(UPL + r * 64 + 16 * dq + 4 * grp);
#pragma unroll
            for (int q = 0; q < 4; ++q) { lgv[q] = -(fmaxf(-z4[q], 0.f) + __logf(1.0f + __expf(-fabsf(z4[q])))) * 0.0625f;
                lgbuf[(size_t)(dir * 64 + 16 * dq + 4 * grp + q) * 64 + lane] = __builtin_bit_cast(unsigned short, (_Float16)lgv[q]); }
        } else {
#pragma unroll
            for (int q = 0; q < 4; ++q) lgv[q] = (float)__builtin_bit_cast(_Float16, pf.lg[4 * grp + q]);
        }
        __builtin_amdgcn_sched_barrier(0);
        const u32x2 kraw = *(const LAS u32x2*)(l + G_KR + lane * G_RS + 32 * dq + 8 * grp);
        const float kv[4] = {bflo(kraw.x), bfhi(kraw.x), bflo(kraw.y), bfhi(kraw.y)};
        float qv[4] = {0.f, 0.f, 0.f, 0.f};
        if (S3) { const u32x2 qraw = *(const LAS u32x2*)(l + G_QR + lane * G_RS + 32 * dq + 8 * grp); qv[0] = bflo(qraw.x); qv[1] = bfhi(qraw.x); qv[2] = bflo(qraw.y); qv[3] = bfhi(qraw.y); }
        float qd[4], kd[4];
#pragma unroll
        for (int q = 0; q < 4; ++q) {
            const int d = 16 * dq + 4 * grp + q;
            const float lg = lgv[q];
            float tot;
            const float incl = wave_incl_scan_tot(lg, lane, tot);
            const float G = dir ? (tot - incl + lg) : incl;
            if (!S3) {
                const float kp = kv[q] * __expf(tot - G);
                *(LAS bf16_t*)(l + G_QF + (dir * 64 + d) * G_RS + lane * 2) = f2bf(kp);
                if (lane == 0) gdec_out[dir * 256 + h * 64 + d] = __expf(tot);
            } else {
                qd[q] = qv[q] * 0.125f * __expf(G); kd[q] = kv[q] * __expf(-G);
            }
        }
        if (S3) {
            u32x2 qo, ko; qo.x = cvt_pk_bf16(qd[0], qd[1]); qo.y = cvt_pk_bf16(qd[2], qd[3]); ko.x = cvt_pk_bf16(kd[0], kd[1]); ko.y = cvt_pk_bf16(kd[2], kd[3]);
            *(LAS u32x2*)(l + (dir ? G_QB : G_QF) + lane * G_RS + 32 * dq + 8 * grp) = qo;
            *(LAS u32x2*)(l + (dir ? G_KB : G_KF) + lane * G_RS + 32 * dq + 8 * grp) = ko;
        }
        __builtin_amdgcn_sched_barrier(0);
    }
}
__device__ __forceinline__ void gla_s1_item(const Params& p, int item, int next_item, GlaPF& pf, LAS unsigned char* l, unsigned lbase, int tid) {
    const int lane = tid & 63, w = __builtin_amdgcn_readfirstlane(tid >> 6);
    const int h = item & 3, c = (item >> 2) & 63, seq = item >> 8, r0 = seq * 4096 + c * 64;
    const bf16_t* proj = (const bf16_t*)(p.ws + WS_PROJ);
    float* gdec = (float*)(p.ws + WS_GDEC) + (size_t)((seq * 64 + c) * 2) * 256;
    gla_pf_store<false>(pf, l, tid);
    u32x4 vr[2];
#pragma unroll
    for (int k = 0; k < 2; ++k) { const int i = tid + 512 * k, row = i >> 4, ch = i & 15; vr[k] = *(const u32x4*)(proj + (size_t)(r0 + row) * PC + C_V + 128 * h + ch * 8); }
    LBAR();
    gla_prep<false>(l, lane, w, h, gdec, pf, (unsigned short*)(p.ws + WS_LG) + (size_t)item * 8192);
#pragma unroll
    for (int k = 0; k < 2; ++k) { const int i = tid + 512 * k, row = i >> 4, ch = i & 15; *(LAS u32x4*)(l + G_V + row * G_RSV + ch * 16) = vr[k]; }
    if (next_item >= 0) gla_pf_load<false>(pf, p, next_item, tid);
    LBAR();
    const int dir = w >> 2, dvb0 = (w & 3) * 2, g = lane >> 4, ln = lane & 15;
    LAS unsigned char* stg = l + G_STG1 + w * 4608;
#pragma unroll
    for (int i = 0; i < 2; ++i) {
        bf16x8 A[2];
#pragma unroll
        for (int ks = 0; ks < 2; ++ks) A[ks] = frag_tr(lbase + G_V, G_RSV, 32 * ks, 16 * (dvb0 + i), lane);
#pragma unroll
        for (int n = 0; n < 4; ++n) { f32x4 acc = {0.f, 0.f, 0.f, 0.f};
#pragma unroll
            for (int ks = 0; ks < 2; ++ks) acc = MFMA16(A[ks], frag_row(l + G_QF + dir * 64 * G_RS, G_RS, 16 * n, 32 * ks, lane), acc);
#pragma unroll
            for (int r = 0; r < 4; ++r) *(LAS bf16_t*)(stg + (16 * i + 4 * g + r) * G_RS + (16 * n + ln) * 2) = f2bf(acc[r]); }
    }
    asm volatile("" ::: "memory");
    bf16_t* GS = (bf16_t*)(p.ws + WS_GS) + ((size_t)(((seq * 64 + c) * 2 + dir) * 4 + h)) * 8192 + (size_t)dvb0 * 16 * 64;
#pragma unroll
    for (int k = 0; k < 4; ++k) { const int i = lane + 64 * k, row = i >> 3, ch = i & 7; *(u32x4*)(GS + row * 64 + ch * 8) = *(const LAS u32x4*)(stg + row * G_RS + ch * 16); }
    LBAR();
}
__device__ __forceinline__ void gla_s3_item(const Params& p, int item, int next_item, GlaPF& pf, LAS unsigned char* l, unsigned lbase, int tid) {
    const int lane = tid & 63, w = __builtin_amdgcn_readfirstlane(tid >> 6);
    const int h = item & 3, c = (item >> 2) & 63, seq = item >> 8, r0 = seq * 4096 + c * 64;
    const bf16_t* proj = (const bf16_t*)(p.ws + WS_PROJ);
    gla_pf_store<true>(pf, l, tid);
    u32x4 vr[2], ogr[2], str[4];
    const bf16_t* GSb = (const bf16_t*)(p.ws + WS_GS);
#pragma unroll
    for (int k = 0; k < 2; ++k) { const int i = tid + 512 * k, row = i >> 4, ch = i & 15; const bf16_t* pr = proj + (size_t)(r0 + row) * PC;
        vr[k] = *(const u32x4*)(pr + C_V + 128 * h + ch * 8); ogr[k] = *(const u32x4*)(pr + C_OG + 128 * h + ch * 8); }
#pragma unroll
    for (int k = 0; k < 4; ++k) { const int i = tid + 512 * k, dir = i >> 10, row = (i >> 3) & 127, ch = i & 7;
        str[k] = *(const u32x4*)(GSb + ((size_t)(((seq * 64 + c) * 2 + dir) * 4 + h)) * 8192 + row * 64 + ch * 8); }
    const int g = lane >> 4, ln = lane & 15, tb = w >> 1, dvh = w & 1;
    LBAR();
    gla_prep<true>(l, lane, w, h, nullptr, pf, nullptr);
#pragma unroll
    for (int k = 0; k < 2; ++k) { const int i = tid + 512 * k, row = i >> 4, ch = i & 15; *(LAS u32x4*)(l + G_V + row * G_RSV + ch * 16) = vr[k]; *(LAS u32x4*)(l + G_OGR + row * G_RSV + ch * 16) = ogr[k]; }
#pragma unroll
    for (int k = 0; k < 4; ++k) { const int i = tid + 512 * k, dir = i >> 10, row = (i >> 3) & 127, ch = i & 7; *(LAS u32x4*)(l + (dir ? G_SBT : G_SFT) + row * G_RS + ch * 16) = str[k]; }
    if (next_item >= 0) gla_pf_load<true>(pf, p, next_item, tid);
    LBAR();
    {
        const int ti = w >> 1;
#pragma unroll
        for (int k = 0; k < 2; ++k) { const int si = 2 * (w & 1) + k; f32x4 af = {0.f, 0.f, 0.f, 0.f}, ab = {0.f, 0.f, 0.f, 0.f};
            if (ti >= si) {
#pragma unroll
                for (int ks = 0; ks < 2; ++ks) af = MFMA16(frag_row(l + G_QF, G_RS, 16 * ti, 32 * ks, lane), frag_row(l + G_KF, G_RS, 16 * si, 32 * ks, lane), af); }
            if (ti <= si) {
#pragma unroll
                for (int ks = 0; ks < 2; ++ks) ab = MFMA16(frag_row(l + G_QB, G_RS, 16 * ti, 32 * ks, lane), frag_row(l + G_KB, G_RS, 16 * si, 32 * ks, lane), ab); }
#pragma unroll
            for (int r = 0; r < 4; ++r) { const int t = 16 * ti + 4 * g + r, s = 16 * si + ln; *(LAS bf16_t*)(l + G_ATT + t * G_RS + s * 2) = f2bf(s <= t ? af[r] : ab[r]); }
        }
    }
    LBAR();
    f32x4 acc[4];
#pragma unroll
    for (int i = 0; i < 4; ++i) acc[i] = (f32x4){0.f, 0.f, 0.f, 0.f};
#pragma unroll
    for (int ks = 0; ks < 2; ++ks) {
        const bf16x8 a_att = frag_row(l + G_ATT, G_RS, 16 * tb, 32 * ks, lane), a_qf = frag_row(l + G_QF, G_RS, 16 * tb, 32 * ks, lane), a_qb = frag_row(l + G_QB, G_RS, 16 * tb, 32 * ks, lane);
        bf16x8 vb[4]; frag_tr4(vb, lbase + G_V, G_RSV, 32 * ks, 64 * dvh, 16, lane);
#pragma unroll
        for (int i = 0; i < 4; ++i) { const int dvb = dvh * 4 + i;
            acc[i] = MFMA16(a_att, vb[i], acc[i]);
            acc[i] = MFMA16(a_qf, frag_row(l + G_SFT, G_RS, 16 * dvb, 32 * ks, lane), acc[i]);
            acc[i] = MFMA16(a_qb, frag_row(l + G_SBT, G_RS, 16 * dvb, 32 * ks, lane), acc[i]); }
    }
#pragma unroll
    for (int r = 0; r < 4; ++r) { float s = 0.f;
#pragma unroll
        for (int i = 0; i < 4; ++i) s += acc[i][r] * acc[i][r];
        s += shfl_idx(s, lane ^ 1); s += shfl_idx(s, lane ^ 2); s += shfl_idx(s, lane ^ 4); s += shfl_idx(s, lane ^ 8);
        if (ln == 0) *(LAS float*)(l + G_SSQ + ((16 * tb + 4 * g + r) * 2 + dvh) * 4) = s; }
    LBAR();
    LAS unsigned char* stg = l + G_STG3 + w * 2304;
#pragma unroll
    for (int r = 0; r < 4; ++r) { const int t = 16 * tb + 4 * g + r; const LAS float* sp = (const LAS float*)(l + G_SSQ + t * 8);
        const float rstd = rsqrtf((sp[0] + sp[1]) * (1.0f / 128.0f) + EPS);
#pragma unroll
        for (int i = 0; i < 4; ++i) { const int dvl = 16 * i + ln; const float og = bf2f(*(const LAS bf16_t*)(l + G_OGR + t * G_RSV + (64 * dvh + dvl) * 2));
            *(LAS bf16_t*)(stg + (4 * g + r) * G_RS + dvl * 2) = f2bf(acc[i][r] * rstd * ((const LAS float*)(l + G_GNW))[64 * dvh + dvl] * siluf_(og)); } }
    asm volatile("" ::: "memory");
    bf16_t* OG = (bf16_t*)(p.ws + WS_OG) + (size_t)(r0 + 16 * tb) * 512 + 128 * h + 64 * dvh;
#pragma unroll
    for (int k = 0; k < 2; ++k) { const int i = lane + 64 * k, row = i >> 3, ch = i & 7; *(u32x4*)(OG + (size_t)row * 512 + ch * 8) = *(const LAS u32x4*)(stg + row * G_RS + ch * 16); }
    LBAR();
}

constexpr int S_XS = 0, S_BM = 67584, S_CM = 86016, S_MB = 104448, S_DT = 139264, S_AC = 143360, S_W8 = 147456, S_RSX = 528, S_RS = 144, S_RSM = 272;
template <bool S3>
__device__ __forceinline__ void ssd_prep(const Params& p, const bf16_t* proj, int seq, int c, int gi, LAS unsigned char* l, int tid, float* sdec_out) {
    const int lane = tid & 63, w = __builtin_amdgcn_readfirstlane(tid >> 6);
    const int tok0 = c * 128; constexpr int NV = S3 ? 16 : 40, NST = S3 ? 32 : 12, TS = S3 ? 4 : 11, CV0 = S3 ? 32 : 0;
    bf16_t* XSG = (bf16_t*)(p.ws + WS_Y);
    const int dir = w >> 2, j = w & 3, hd = 4 * gi + j, r0 = seq * 4096 + tok0;
    const int dcol = (dir ? C_DTB : C_DTF) + hd;
    const float raw0 = bf2f(proj[(size_t)(r0 + lane) * PC + dcol]), raw1 = bf2f(proj[(size_t)(r0 + lane + 64) * PC + dcol]);
    const float dtb = (dir ? p.dt_bias_b : p.dt_bias_f)[hd], alog = (dir ? p.a_log_b : p.a_log_f)[hd];
    u32x4 xsr[8];
    if (S3) {
#pragma unroll
        for (int k = 0; k < 8; ++k) { const int i = tid + 512 * k, row = i >> 5, ch = i & 31; xsr[k] = *(const u32x4*)(XSG + (size_t)(r0 + row) * 1024 + 256 * gi + ch * 8); }
    }
    if (tid < NV * NST) {
        const int cv = CV0 + tid % NV, t0 = (tid / NV) * TS;
        const int col = cv < 32 ? C_XBC + 256 * gi + 8 * cv : (cv < 40 ? C_BM + 64 * gi + 8 * (cv - 32) : C_CM + 64 * gi + 8 * (cv - 40));
        const int ch = col - C_XBC;
        u32x4 raw[TS + 4];
#pragma unroll
        for (int i = 0; i < TS + 4; ++i) { const int tt = tok0 + t0 + i - 2; raw[i] = (u32x4){0u, 0u, 0u, 0u};
            if (tt >= 0 && tt < 4096 && t0 + i - 2 < 130) raw[i] = *(const u32x4*)(proj + (size_t)(seq * 4096 + tt) * PC + col); }
        typedef float f32x2 __attribute__((ext_vector_type(2)));
        f32x2 wv[5][4], bv[4];
#pragma unroll
        for (int i = 0; i < 5; ++i) { const f32x4 a = *(const f32x4*)(p.conv_w + i * 1536 + ch), b = *(const f32x4*)(p.conv_w + i * 1536 + ch + 4);
            wv[i][0] = (f32x2){a[0], a[1]}; wv[i][1] = (f32x2){a[2], a[3]}; wv[i][2] = (f32x2){b[0], b[1]}; wv[i][3] = (f32x2){b[2], b[3]}; }
        { const f32x4 a = *(const f32x4*)(p.conv_b + ch), b = *(const f32x4*)(p.conv_b + ch + 4); bv[0] = (f32x2){a[0], a[1]}; bv[1] = (f32x2){a[2], a[3]}; bv[2] = (f32x2){b[0], b[1]}; bv[3] = (f32x2){b[2], b[3]}; }
        LAS unsigned char* dst0 = cv < 32 ? l + S_XS + cv * 16 : (cv < 40 ? l + S_BM + (cv - 32) * 16 : l + S_CM + (cv - 40) * 16); const int drs = cv < 32 ? S_RSX : S_RS;
        f32x2 xw[5][4];
#pragma unroll
        for (int i = 0; i < 4; ++i) { const u32x4 rr = raw[i]; xw[i][0] = (f32x2){bflo(rr.x), bfhi(rr.x)}; xw[i][1] = (f32x2){bflo(rr.y), bfhi(rr.y)}; xw[i][2] = (f32x2){bflo(rr.z), bfhi(rr.z)}; xw[i][3] = (f32x2){bflo(rr.w), bfhi(rr.w)}; }
#pragma unroll
        for (int o = 0; o < TS; ++o) { const int t = t0 + o;
            { const u32x4 rr = raw[o + 4]; xw[4][0] = (f32x2){bflo(rr.x), bfhi(rr.x)}; xw[4][1] = (f32x2){bflo(rr.y), bfhi(rr.y)}; xw[4][2] = (f32x2){bflo(rr.z), bfhi(rr.z)}; xw[4][3] = (f32x2){bflo(rr.w), bfhi(rr.w)}; }
            if (t < 128) { u32x4 pk;
#pragma unroll
                for (int k = 0; k < 4; ++k) { f32x2 a = bv[k];
#pragma unroll
                    for (int i = 0; i < 5; ++i) a = xw[i][k] * wv[i][k] + a;
                    const unsigned pw = cvt_pk_bf16(siluf_(a[0]), siluf_(a[1])); if (k == 0) pk.x = pw; else if (k == 1) pk.y = pw; else if (k == 2) pk.z = pw; else pk.w = pw; }
                *(LAS u32x4*)(dst0 + t * drs) = pk;
                if (!S3 && cv < 32) *(u32x4*)(XSG + (size_t)(r0 + t) * 1024 + 256 * gi + 8 * cv) = pk; }
#pragma unroll
            for (int i = 0; i < 4; ++i)
#pragma unroll
                for (int k = 0; k < 4; ++k) xw[i][k] = xw[i + 1][k];
        }
    }
    if (S3) {
#pragma unroll
        for (int k = 0; k < 8; ++k) { const int i = tid + 512 * k, row = i >> 5, ch = i & 31; *(LAS u32x4*)(l + S_XS + row * S_RSX + ch * 16) = xsr[k]; }
    }
    {
        const float A = -__expf(alog);
        const float dt0 = softplusf_(raw0 + dtb), dt1 = softplusf_(raw1 + dtb);
        const float la0 = dt0 * A, la1 = dt1 * A;
        float tot0, tot1; const float s0 = wave_incl_scan_tot(la0, lane, tot0), s1 = wave_incl_scan_tot(la1, lane, tot1); const float total = tot0 + tot1;
        float ac0, ac1;
        if (dir == 0) { ac0 = s0; ac1 = tot0 + s1; } else { ac0 = total - (s0 - la0); ac1 = total - (tot0 + s1 - la1); }
        LAS float* DT = (LAS float*)(l + S_DT) + (dir * 4 + j) * 128; LAS float* AC = (LAS float*)(l + S_AC) + (dir * 4 + j) * 128;
        DT[lane] = dt0; DT[lane + 64] = dt1; AC[lane] = ac0; AC[lane + 64] = ac1;
        if (!S3) { LAS float* W8 = (LAS float*)(l + S_W8) + (dir * 4 + j) * 128; W8[lane] = dt0 * __expf(total - ac0); W8[lane + 64] = dt1 * __expf(total - ac1);
            if (lane == 0) sdec_out[dir * 16 + hd] = __expf(total); }
    }
}
__device__ __forceinline__ void ssd_s1_item(const Params& p, int item, LAS unsigned char* l, unsigned lbase, int tid) {
    const int lane = tid & 63, w = __builtin_amdgcn_readfirstlane(tid >> 6);
    const int gi = item & 3, c = (item >> 2) & 31, seq = item >> 7;
    const bf16_t* proj = (const bf16_t*)(p.ws + WS_PROJ);
    float* sdec = (float*)(p.ws + WS_SDEC) + (size_t)((seq * 32 + c) * 2) * 16;
    ssd_prep<false>(p, proj, seq, c, gi, l, tid, sdec);
    __syncthreads();
    const int dir = w >> 2, j = w & 3, hd = 4 * gi + j, g = lane >> 4, ln = lane & 15;
    f32x4 acc[4][4];
#pragma unroll
    for (int a = 0; a < 4; ++a)
#pragma unroll
        for (int b = 0; b < 4; ++b) acc[a][b] = (f32x4){0.f, 0.f, 0.f, 0.f};
#pragma unroll
    for (int ks = 0; ks < 4; ++ks) {
        bf16x8 A[4], B[4], Braw[4];
        frag_tr4(A, lbase + S_XS, S_RSX, 32 * ks, 64 * j, 16, lane);
        frag_tr4(Braw, lbase + S_BM, S_RS, 32 * ks, 0, 16, lane);
        const LAS float* wp = (const LAS float*)(l + S_W8) + (dir * 4 + j) * 128 + 32 * ks + 8 * g;
        const f32x4 w0 = *(const LAS f32x4*)wp, w1 = *(const LAS f32x4*)(wp + 4);
#pragma unroll
        for (int ni = 0; ni < 4; ++ni) { const bf16x8 b = Braw[ni]; float o[8];
#pragma unroll
            for (int jj = 0; jj < 8; ++jj) o[jj] = bf2f((unsigned short)b[jj]) * (jj < 4 ? w0[jj & 3] : w1[jj & 3]);
            const u32x4 pk = pack8(o); B[ni] = __builtin_bit_cast(bf16x8, pk); }
#pragma unroll
        for (int pi = 0; pi < 4; ++pi)
#pragma unroll
            for (int ni = 0; ni < 4; ++ni) acc[pi][ni] = MFMA16(A[pi], B[ni], acc[pi][ni]);
    }
    __syncthreads();
    LAS unsigned char* stg = l + S_XS + w * 9216;
#pragma unroll
    for (int pi = 0; pi < 4; ++pi)
#pragma unroll
        for (int ni = 0; ni < 4; ++ni)
#pragma unroll
            for (int r = 0; r < 4; ++r) *(LAS bf16_t*)(stg + (16 * pi + 4 * g + r) * S_RS + (16 * ni + ln) * 2) = f2bf(acc[pi][ni][r]);
    asm volatile("" ::: "memory");
    bf16_t* SS = (bf16_t*)(p.ws + WS_SS) + ((size_t)(((seq * 32 + c) * 2 + dir) * 16 + hd)) * 4096;
#pragma unroll
    for (int k = 0; k < 8; ++k) { const int i = lane + 64 * k, row = i >> 3, ch = i & 7; *(u32x4*)(SS + row * 64 + ch * 8) = *(const LAS u32x4*)(stg + row * S_RS + ch * 16); }
    __syncthreads();
}
__device__ __forceinline__ void ssd_s3_item(const Params& p, int row0, int item, LAS unsigned char* l, unsigned lbase, int tid) {
    const int lane = tid & 63, w = __builtin_amdgcn_readfirstlane(tid >> 6);
    const int gi = item & 3, c = (item >> 2) & 31, seq = item >> 7, r0 = seq * 4096 + c * 128;
    const bf16_t* proj = (const bf16_t*)(p.ws + WS_PROJ);
    const bf16_t* SSb = (const bf16_t*)(p.ws + WS_SS);
    const int sdir = tid >> 8, si_ = tid & 255, srow0 = si_ >> 3, sch = si_ & 7;
    const bf16_t* sp0 = SSb + ((size_t)(((seq * 32 + c) * 2 + sdir) * 16 + 4 * gi)) * 4096 + srow0 * 64 + sch * 8;
    u32x4 sa = *(const u32x4*)sp0, sb = *(const u32x4*)(sp0 + 32 * 64);
    ssd_prep<true>(p, proj, seq, c, gi, l, tid, nullptr);
    __syncthreads();
    const int g = lane >> 4, ln = lane & 15;
    f32x4 cb[8];
#pragma unroll
    for (int si = 0; si < 8; ++si) { cb[si] = (f32x4){0.f, 0.f, 0.f, 0.f};
#pragma unroll
        for (int ks = 0; ks < 2; ++ks) cb[si] = MFMA16(frag_row(l + S_CM, S_RS, 16 * w, 32 * ks, lane), frag_row(l + S_BM, S_RS, 16 * si, 32 * ks, lane), cb[si]); }
    __syncthreads();
    bf16_t* Y = (bf16_t*)(p.ws + WS_Y);
    const int erow = lane >> 2, epc = lane & 3;
    float ssq = 0.f;
    for (int j = 0; j < 4; ++j) {
        const int hd = 4 * gi + j;
        *(LAS u32x4*)(l + S_BM + sdir * 9216 + srow0 * S_RS + sch * 16) = sa; *(LAS u32x4*)(l + S_BM + sdir * 9216 + (srow0 + 32) * S_RS + sch * 16) = sb;
        if (j < 3) { sa = *(const u32x4*)(sp0 + (size_t)(j + 1) * 4096); sb = *(const u32x4*)(sp0 + (size_t)(j + 1) * 4096 + 32 * 64); }
        const bf16_t* zp = proj + (size_t)(r0 + 16 * w + erow) * PC + C_Z + 64 * hd + 16 * epc;
        const u32x4 z0 = *(const u32x4*)zp, z1 = *(const u32x4*)(zp + 8);
        const LAS float* DTf = (const LAS float*)(l + S_DT) + j * 128; const LAS float* DTb = DTf + 512;
        const LAS float* ACf = (const LAS float*)(l + S_AC) + j * 128; const LAS float* ACb = ACf + 512;
        const float dsk = p.d_skip[hd];
#pragma unroll
        for (int si = 0; si < 8; ++si) { const int s = 16 * si + ln;
            if (si < w) { const float afs = ACf[s], dfs = DTf[s];
#pragma unroll
                for (int r = 0; r < 4; ++r) { const int lr = 16 * w + 4 * g + r; *(LAS bf16_t*)(l + S_MB + lr * S_RSM + s * 2) = f2bf(cb[si][r] * __expf(ACf[lr] - afs) * dfs); } }
            else if (si > w) { const float abs_ = ACb[s], dbs = DTb[s];
#pragma unroll
                for (int r = 0; r < 4; ++r) { const int lr = 16 * w + 4 * g + r; *(LAS bf16_t*)(l + S_MB + lr * S_RSM + s * 2) = f2bf(cb[si][r] * __expf(ACb[lr] - abs_) * dbs); } }
            else { const float afs = ACf[s], abs_ = ACb[s], dfs = DTf[s], dbs = DTb[s];
#pragma unroll
                for (int r = 0; r < 4; ++r) { const int lr = 16 * w + 4 * g + r;
                    const float wt = (s <= lr) ? __expf(ACf[lr] - afs) * dfs : __expf(ACb[lr] - abs_) * dbs;
                    const float v = cb[si][r] * wt + (s == lr ? dsk : 0.f);
                    *(LAS bf16_t*)(l + S_MB + lr * S_RSM + s * 2) = f2bf(v); } } }
        __syncthreads();
        f32x4 ay[4], af[4], ab[4];
#pragma unroll
        for (int pi = 0; pi < 4; ++pi) { ay[pi] = (f32x4){0.f, 0.f, 0.f, 0.f}; af[pi] = ay[pi]; ab[pi] = ay[pi]; }
#pragma unroll
        for (int ks = 0; ks < 4; ++ks) { const bf16x8 am = frag_row(l + S_MB, S_RSM, 16 * w, 32 * ks, lane); bf16x8 xb[4]; frag_tr4(xb, lbase + S_XS, S_RSX, 32 * ks, 64 * j, 16, lane);
#pragma unroll
            for (int pi = 0; pi < 4; ++pi) ay[pi] = MFMA16(am, xb[pi], ay[pi]); }
#pragma unroll
        for (int ks = 0; ks < 2; ++ks) { const bf16x8 ac = frag_row(l + S_CM, S_RS, 16 * w, 32 * ks, lane);
#pragma unroll
            for (int pi = 0; pi < 4; ++pi) { af[pi] = MFMA16(ac, frag_row(l + S_BM, S_RS, 16 * pi, 32 * ks, lane), af[pi]);
                ab[pi] = MFMA16(ac, frag_row(l + S_BM + 9216, S_RS, 16 * pi, 32 * ks, lane), ab[pi]); } }
#pragma unroll
        for (int r = 0; r < 4; ++r) { const int lr = 16 * w + 4 * g + r; const float ef = __expf(ACf[lr]), eb = __expf(ACb[lr]);
#pragma unroll
            for (int pi = 0; pi < 4; ++pi) *(LAS float*)(l + S_MB + lr * S_RSM + (16 * pi + ln) * 4) = ay[pi][r] + ef * af[pi][r] + eb * ab[pi][r]; }
        asm volatile("" ::: "memory");
        {   float zv[16], yv[16];
            unpack8(z0, zv); unpack8(z1, zv + 8);
            const LAS unsigned char* yp = l + S_MB + (16 * w + erow) * S_RSM + epc * 64;
#pragma unroll
            for (int q = 0; q < 4; ++q) { const f32x4 t4 = *(const LAS f32x4*)(yp + 16 * q); yv[4 * q] = t4[0]; yv[4 * q + 1] = t4[1]; yv[4 * q + 2] = t4[2]; yv[4 * q + 3] = t4[3]; }
#pragma unroll
            for (int q = 0; q < 16; ++q) { yv[q] *= siluf_(zv[q]); ssq += yv[q] * yv[q]; }
            bf16_t* yo = Y + (size_t)(r0 + 16 * w + erow) * 1024 + 64 * hd + 16 * epc;
            *(u32x4*)yo = pack8(yv); *(u32x4*)(yo + 8) = pack8(yv + 8); }
        __syncthreads();
    }
    float* rssy = (float*)(p.ws + WS_RSSY) + (size_t)row0;
    ssq += shfl_idx(ssq, lane ^ 1); ssq += shfl_idx(ssq, lane ^ 2);
    if (epc == 0) atomicAdd(rssy + r0 + 16 * w + erow, ssq);
}

template <bool GLA>
__device__ __forceinline__ void scan_job(bf16_t* base, const float* dec, int dir) {
    constexpr int NCH = GLA ? 64 : 32; constexpr size_t CST = GLA ? 65536 : 131072; constexpr int DST = GLA ? 512 : 32; constexpr int UN = 4;
    float run[8];
#pragma unroll
    for (int e = 0; e < 8; ++e) run[e] = 0.f;
    const long long cstep = dir ? -(long long)CST : (long long)CST; const int dstep = dir ? -DST : DST;
    bf16_t* bp = base + (dir ? (size_t)(NCH - 1) * CST : 0); const float* dp = dec + (dir ? (NCH - 1) * DST : 0);
    for (int c0 = 0; c0 < NCH; c0 += UN) {
        u32x4 loc[UN]; f32x4 d0[UN], d1[UN];
#pragma unroll
        for (int u = 0; u < UN; ++u) { loc[u] = *(const u32x4*)(bp + u * cstep);
            if (GLA) { d0[u] = *(const f32x4*)(dp + u * dstep); d1[u] = *(const f32x4*)(dp + u * dstep + 4); } else { const float dv = dp[u * dstep]; d0[u] = (f32x4){dv, dv, dv, dv}; d1[u] = d0[u]; } }
#pragma unroll
        for (int u = 0; u < UN; ++u) { float lv[8]; unpack8(loc[u], lv);
            *(u32x4*)(bp + u * cstep) = pack8(run);
#pragma unroll
            for (int e = 0; e < 8; ++e) run[e] = (e < 4 ? d0[u][e & 3] : d1[u][e & 3]) * run[e] + lv[e]; }
        bp += UN * cstep; dp += UN * dstep;
    }
}
__device__ __forceinline__ void phase_scan(const Params& p, int nseq, int tid) {
    const int NG = nseq * 8192, NS = nseq * 16384;
    const int gt = blockIdx.x * 512 + tid, GT = gridDim.x * 512;
    for (int job = gt; job < NG + NS; job += GT) {
        if (job < NG) { const int e8 = job & 1023, h = (job >> 10) & 3, dir = (job >> 12) & 1, seq = job >> 13;
            scan_job<true>((bf16_t*)(p.ws + WS_GS) + ((size_t)((seq * 64 * 2 + dir) * 4 + h)) * 8192 + e8 * 8, (const float*)(p.ws + WS_GDEC) + (size_t)((seq * 64 * 2 + dir) * 4 + h) * 64 + ((e8 * 8) & 63), dir);
        } else { const int j2 = job - NG, e8 = j2 & 511, hd = (j2 >> 9) & 15, dir = (j2 >> 13) & 1, seq = j2 >> 14;
            scan_job<false>((bf16_t*)(p.ws + WS_SS) + ((size_t)((seq * 32 * 2 + dir) * 16 + hd)) * 4096 + e8 * 8, (const float*)(p.ws + WS_SDEC) + (size_t)((seq * 32 * 2 + dir) * 16 + hd), dir); }
    }
}

constexpr int LDS_BYTES = 160 * 1024;
#if defined(__HIP_DEVICE_COMPILE__)
typedef const __attribute__((address_space(4))) Params* KP;
#define KPARAMS() ({ unsigned long long k_ = (unsigned long long)__builtin_amdgcn_kernarg_segment_ptr(); asm volatile("" : "+s"(k_)); *(KP)k_; })
#define KWS() ({ unsigned long long k_ = (unsigned long long)__builtin_amdgcn_kernarg_segment_ptr(); asm volatile("" : "+s"(k_)); (unsigned char*)*(const __attribute__((address_space(4))) unsigned long long*)(k_ + 26 * 8); })
#else
#define KPARAMS() (p_unused)
#define KWS() (p_unused.ws)
#endif
#define GBAR() do { XcdBarrier b_; b_.bar = (unsigned*)(KWS() + WS_BAR); b_.x = xb_xcc_id(); b_.st = (volatile LAS unsigned*)(l + LDS_BYTES - 16); xcd_barrier(b_); } while (0)
#define OTID() ({ int t_ = threadIdx.x; asm volatile("" : "+v"(t_)); t_; })

template <int hb>
__device__ __forceinline__ void half_pass(const Params& p_unused, LAS unsigned char* l, const unsigned lbase, cg::grid_group& grid, const int G, const int bx) {
        constexpr int ROW0 = PASS_ROW0[hb], NR = PASS_ROWS[hb], NSQ = PASS_SEQ[hb], NSSD = NSQ * 128, NIT = NSQ * 384;
        { const Params q = KPARAMS(); phase_u(q, ROW0, NR, OTID()); }
        if (hb == 0) grid.sync(); else GBAR();
        {
            const Params q = KPARAMS(); unsigned char* ws = q.ws; bf16_t* PROJ = (bf16_t*)(ws + WS_PROJ);
            pg8::Gemm g{(const bf16_t*)(ws + WS_U), (const bf16_t*)(ws + WS_WIN), NR, 6400, 1024}; pg8::StaticOrder S; S.init(NR, 6400, G, bx);
            EpiProj E{PROJ}; pg8::gemm_phase<EpiProj, pg8::StaticOrder, true, true>(l, g, S, E);
        }
        GBAR();
        {   GlaPF pf; const int itg0 = bx + ((NSSD - bx + G - 1) / G) * G;
            if (itg0 < NIT) { const Params p = KPARAMS(); gla_pf_load<false>(pf, p, itg0 - NSSD, OTID()); }
            for (int it = bx; it < NIT; it += G) { const Params p = KPARAMS(); const int tid = OTID(); if (it < NSSD) ssd_s1_item(p, it, l, lbase, tid); else gla_s1_item(p, it - NSSD, it + G < NIT ? it + G - NSSD : -1, pf, l, lbase, tid); }
        }
        GBAR();
        { const Params q = KPARAMS(); phase_scan(q, NSQ, OTID()); }
        GBAR();
        {   GlaPF pf; const int itg0 = bx + ((NSSD - bx + G - 1) / G) * G;
            if (itg0 < NIT) { const Params p = KPARAMS(); gla_pf_load<true>(pf, p, itg0 - NSSD, OTID()); }
            for (int it = bx; it < NIT; it += G) { const Params p = KPARAMS(); const int tid = OTID(); if (it < NSSD) ssd_s3_item(p, ROW0, it, l, lbase, tid); else gla_s3_item(p, it - NSSD, it + G < NIT ? it + G - NSSD : -1, pf, l, lbase, tid); }
        }
        GBAR();
        {
            const Params p = KPARAMS(); unsigned char* ws = p.ws; bf16_t* PROJ = (bf16_t*)(ws + WS_PROJ);
            pg8::StaticOrder S; S.init(NR, 1024, G, bx);
            pg8::Gemm g1{(const bf16_t*)(ws + WS_OG), (const bf16_t*)(ws + WS_WB1), NR, 1024, 512};
            EpiM1 E1{PROJ, (bf16_t*)(ws + WS_T)}; pg8::gemm_phase<EpiM1, pg8::StaticOrder, true, true>(l, g1, S, E1);
            pg8::Gemm g2{(const bf16_t*)(ws + WS_Y), (const bf16_t*)(ws + WS_WB2), NR, 1024, 1024};
            EpiM2 E2{PROJ, (const bf16_t*)(ws + WS_T), (bf16_t*)(ws + WS_MM), (const float*)(ws + WS_RSSY) + (size_t)ROW0}; pg8::gemm_phase<EpiM2, pg8::StaticOrder, true, true>(l, g2, S, E2);
        }
        GBAR();
        {
            const Params p = KPARAMS(); unsigned char* ws = p.ws; bf16_t* PROJ = (bf16_t*)(ws + WS_PROJ);
            pg8::StaticOrder S; S.init(NR, 1024, G, bx);
            pg8::Gemm g{(const bf16_t*)(ws + WS_MM), (const bf16_t*)(ws + WS_WOUT), NR, 1024, 1024};
            EpiOut E{p, ROW0, (bf16_t*)(ws + WS_X1B), (float*)(ws + WS_RSS1)}; pg8::gemm_phase<EpiOut, pg8::StaticOrder, true, true>(l, g, S, E);
        }
        GBAR();
        {
            const Params p = KPARAMS(); unsigned char* ws = p.ws; bf16_t* PROJ = (bf16_t*)(ws + WS_PROJ);
            pg8::StaticOrder S; S.init(NR, 5632, G, bx);
            pg8::Gemm g{(const bf16_t*)(ws + WS_X1B), (const bf16_t*)(ws + WS_WGU), NR, 5632, 1024};
            EpiSwi E{(const float*)(ws + WS_RSS1) + (size_t)ROW0, PROJ}; pg8::gemm_phase<EpiSwi, pg8::StaticOrder, true, true>(l, g, S, E);
        }
        GBAR();
        {
            const Params p = KPARAMS(); unsigned char* ws = p.ws; bf16_t* PROJ = (bf16_t*)(ws + WS_PROJ);
            pg8::StaticOrder S; S.init(NR, 1024, G, bx);
            pg8::Gemm g{(const bf16_t*)PROJ, (const bf16_t*)(ws + WS_WD), NR, 1024, DFF};
            EpiDown E{p.out, ROW0, (float*)(ws + WS_RSS2)}; pg8::gemm_phase<EpiDown, pg8::StaticOrder, true, true>(l, g, S, E);
        }
    __syncthreads();
}

__global__ void __launch_bounds__(512) mega(Params p_unused) {
    extern __shared__ __attribute__((aligned(16))) unsigned char lds_raw[];
    cg::grid_group grid = cg::this_grid();
    LAS unsigned char* l = (LAS unsigned char*)lds_raw;
    const unsigned lbase = (unsigned)(size_t)l;
    const int G = gridDim.x, bx = blockIdx.x;
    volatile LAS unsigned* xst = (volatile LAS unsigned*)(l + LDS_BYTES - 16);
    { const int t0_ = OTID(); if (t0_ < 4) xst[t0_] = 0u; }
    __syncthreads();
    (void)xcd_barrier_post((unsigned*)(KWS() + WS_BAR), xst);
    { const Params q = KPARAMS(); phase_weights(q, l, OTID()); }
    half_pass<0>(p_unused, l, lbase, grid, G, bx);
    half_pass<1>(p_unused, l, lbase, grid, G, bx);
    GBAR();
    {
        const Params p = KPARAMS(); unsigned char* ws = p.ws; const int tid = OTID();
        const float* rss2 = (const float*)(ws + WS_RSS2);
        const size_t GT = (size_t)G * 512;
        for (size_t i0 = (size_t)bx * 512 + tid; i0 < (size_t)NTOK * 256; i0 += 4 * GT) {
            f32x4 v[4]; float rs[4];
#pragma unroll
            for (int k = 0; k < 4; ++k) { const size_t i = i0 + k * GT; if (i < (size_t)NTOK * 256) { v[k] = ((const f32x4*)p.out)[i]; rs[k] = rss2[i >> 8]; } }
#pragma unroll
            for (int k = 0; k < 4; ++k) { const size_t i = i0 + k * GT; if (i < (size_t)NTOK * 256) { const float r = rsqrtf(rs[k] * (1.0f / 1024.0f) + EPS); const f32x4 w = ((const f32x4*)p.norm_final_w)[i & 255];
                f32x4 o = v[k]; o[0] *= r * w[0]; o[1] *= r * w[1]; o[2] *= r * w[2]; o[3] *= r * w[3]; ((f32x4*)p.out)[i] = o; } }
        }
    }
}

extern "C" void kernel_launch(void* const* d_in, const int* in_sizes, int n_in, void* d_out, int out_size, void* d_ws, size_t ws_size, hipStream_t stream) {
    static int grid_blocks = 0;
    if (!grid_blocks) {
        int dev = 0, cus = 0, per_cu = 0;
        (void)hipGetDevice(&dev);
        (void)hipDeviceGetAttribute(&cus, hipDeviceAttributeMultiprocessorCount, dev);
        (void)hipFuncSetAttribute((const void*)mega, hipFuncAttributeMaxDynamicSharedMemorySize, LDS_BYTES);
        (void)hipOccupancyMaxActiveBlocksPerMultiprocessor(&per_cu, (const void*)mega, 512, LDS_BYTES);
        if (per_cu < 1) per_cu = 1;
        grid_blocks = cus * per_cu;
        if (ws_size < WS_END) fprintf(stderr, "workspace too small: %zu < %zu\n", ws_size, (size_t)WS_END);
    }
    Params p{};
    const float** pp = (const float**)&p;
    for (int i = 0; i < 25; ++i) pp[i] = (const float*)d_in[i];
    p.out = (float*)d_out; p.ws = (unsigned char*)d_ws;
    (void)hipMemsetAsync((unsigned char*)d_ws + WS_BAR, 0, (size_t)XCD_BAR_WORDS_ * 4, stream);
    void* args[] = {&p};
    hipError_t e = hipLaunchCooperativeKernel((const void*)mega, dim3(grid_blocks), dim3(512), args, LDS_BYTES, stream);
    if (e != hipSuccess) fprintf(stderr, "cooperative launch failed: %s (grid %d)\n", hipGetErrorString(e), grid_blocks);
}
```

```cpp
#include <hip/hip_runtime.h>
#include <hip/hip_cooperative_groups.h>
#include <cstdio>
namespace cg = cooperative_groups;

namespace pg8 {
#define PG8_LAS __attribute__((address_space(3)))
typedef unsigned short bf16_t;
typedef short bf16x8 __attribute__((ext_vector_type(8)));
typedef float f32x4 __attribute__((ext_vector_type(4)));
typedef unsigned u32x4 __attribute__((ext_vector_type(4)));
constexpr int BM = 256, BK = 64, HALF = 128, HTB = HALF * BK * 2  , STAGE_BYTES = 8 * HTB, NXCD = 8, WGM = 8;

__host__ __device__ __forceinline__ int lds_byte(int r, int c) { const int st = (r >> 4) * 2 + (c >> 5), rr = r & 15, cc = c & 31, ob = rr * 64 + cc * 2; return st * 1024 + (ob ^ (((ob >> 9) & 1) << 5)); }
__host__ __device__ __forceinline__ void stage_rc(int b, int& R, int& C) { const int st = b / 1024, sb = b % 1024, swz = sb ^ (((sb >> 9) & 1) << 5); R = (st >> 1) * 16 + swz / 64; C = (st & 1) * 32 + (swz % 64) / 2; }
__host__ __device__ __forceinline__ int perm32(int rho) { const int n = rho >> 4, i = rho & 15; return 8 * (i >> 2) + 4 * n + (i & 3); }

struct Unit { int pm, pn; };
struct Gemm { const bf16_t* A; const bf16_t* Bt; int M, N, K; };

struct StaticOrder {
    int nM, nN, nwg, G, c;
    __host__ __device__ void init(int M, int N, int G_, int c_) { nM = M / BM; nN = N / BM; nwg = nM * nN; G = G_; c = c_; }
    __host__ __device__ bool next(int i, Unit& u) const {
        const long L = (long)i * G + c; if (L >= nwg) return false;
        int wgid = (int)L; { const int q = nwg / NXCD, r = nwg % NXCD, xcd = wgid % NXCD, off = wgid / NXCD; wgid = (xcd < r ? xcd * (q + 1) : r * (q + 1) + (xcd - r) * q) + off; }
        const int nig = WGM * nN, gid = wgid / nig, fm = gid * WGM, gsz = (nM - fm) < WGM ? (nM - fm) : WGM;
        u.pm = fm + ((wgid % nig) % gsz); u.pn = (wgid % nig) / gsz; return true;
    }
    __device__ __forceinline__ void a_ready(const Unit&) const {}
    __device__ __forceinline__ void done(const Unit&) const {}
};
typedef float f32x2_t_ __attribute__((ext_vector_type(2)));
typedef __bf16 bf16x2_t_ __attribute__((ext_vector_type(2)));
__device__ __forceinline__ unsigned cvt_pk_bf16(float lo, float hi) { const f32x2_t_ v = {lo, hi}; const bf16x2_t_ b = __builtin_convertvector(v, bf16x2_t_); return __builtin_bit_cast(unsigned, b); }
template <class Epi, class Sched, bool ALIGN_EPI = false, bool SP2 = false>
__device__ __forceinline__ void gemm_phase(PG8_LAS unsigned char* lds, const Gemm g, const Sched& S, const Epi& E) {
    int tid_ = threadIdx.x; asm volatile("" : "+v"(tid_)); const int tid = tid_, wid = __builtin_amdgcn_readfirstlane(tid >> 6), lane = tid & 63, wr = wid >> 2, wc = wid & 3, fr = lane & 15, fq = lane >> 4;
    const int K = g.K, nt = K / BK;
    unsigned voffA[2], voffB[2];
#pragma unroll
    for (int i = 0; i < 2; ++i) { int R, C; stage_rc(tid * 16 + i * 8192, R, C); const int Rb = Epi::PERM ? ((R & ~31) + perm32(R & 31)) : R;
        voffA[i] = (unsigned)(R * K + C) * 2u; voffB[i] = (unsigned)(Rb * K + C) * 2u; }
    const size_t kstep = (size_t)(BK * 2);
    const size_t hstep = (size_t)HALF * K * 2;
    const size_t tstep = 2 * hstep;
    const unsigned ldsw = (unsigned)wid * 1024u;
    const int aoff = lds_byte(wr * 64 + fr, fq * 8), boff = lds_byte(wc * 32 + fr, fq * 8);
#define PG8_SA(b, h) (((b) * 2 + (h)) * HTB)
#define PG8_SB(b, h) ((4 + (b) * 2 + (h)) * HTB)
#define PG8_STAGE(bufoff, gbase, voff) do { _Pragma("unroll") for (int _i = 0; _i < 2; ++_i) \
        __builtin_amdgcn_global_load_lds((const unsigned*)((const char*)(gbase) + (voff)[_i]), (PG8_LAS unsigned*)(lds + (bufoff) + ldsw + _i * 8192), 16, 0, 0); } while (0)
#define PG8_LDA(dst, b, h) do { _Pragma("unroll") for (int m = 0; m < 4; ++m) _Pragma("unroll") for (int k = 0; k < 2; ++k) dst[m][k] = *(const PG8_LAS bf16x8*)(lds + PG8_SA(b, h) + aoff + m * 2048 + k * 1024); } while (0)
#define PG8_LDB(dst, b, h) do { _Pragma("unroll") for (int n = 0; n < 2; ++n) _Pragma("unroll") for (int k = 0; k < 2; ++k) dst[n][k] = *(const PG8_LAS bf16x8*)(lds + PG8_SB(b, h) + boff + n * 2048 + k * 1024); } while (0)
#define PG8_MMA(ai, bj, At, Bt) do { __builtin_amdgcn_s_setprio(1); _Pragma("unroll") for (int m = 0; m < 4; ++m) _Pragma("unroll") for (int n = 0; n < 2; ++n) _Pragma("unroll") for (int k = 0; k < 2; ++k) \
        acc[ai][bj][m][n] = __builtin_amdgcn_mfma_f32_16x16x32_bf16(Bt[n][k], At[m][k], acc[ai][bj][m][n], 0, 0, 0); __builtin_amdgcn_s_setprio(0); } while (0)
#define PG8_WAIT_V(n) asm volatile("s_waitcnt vmcnt(" #n ")" ::: "memory")
#define PG8_WAIT_L(n) asm volatile("s_waitcnt lgkmcnt(" #n ")" ::: "memory")
#define PG8_BAR __builtin_amdgcn_s_barrier()
#define PG8_SCHED __builtin_amdgcn_sched_barrier(0)
    Unit cur, nxt; int ui = 0;
    if (!S.next(0, cur)) return;
    f32x4 acc[2][2][4][2];
#pragma unroll
    for (int a = 0; a < 2; ++a)
#pragma unroll
        for (int b = 0; b < 2; ++b)
#pragma unroll
            for (int m = 0; m < 4; ++m)
#pragma unroll
                for (int n = 0; n < 2; ++n) acc[a][b][m][n] = (f32x4){0.f, 0.f, 0.f, 0.f};
    bf16x8 At[4][2], B0[2][2], B1[2][2];
    const char* cA = (const char*)g.A + (size_t)cur.pm * tstep; const char* cB = (const char*)g.Bt + (size_t)cur.pn * tstep;
    S.a_ready(cur);
    if constexpr (SP2) {
        PG8_STAGE(PG8_SB(0, 0), cB, voffB); PG8_STAGE(PG8_SB(0, 1), cB + hstep, voffB); PG8_STAGE(PG8_SA(0, 0), cA, voffA); PG8_STAGE(PG8_SA(0, 1), cA + hstep, voffA);
        if (wr == 1) PG8_BAR;
        PG8_WAIT_V(2); PG8_BAR;
        PG8_STAGE(PG8_SB(1, 0), cB + kstep, voffB); PG8_STAGE(PG8_SA(1, 0), cA + kstep, voffA); PG8_STAGE(PG8_SB(1, 1), cB + hstep + kstep, voffB);
        PG8_WAIT_V(6); PG8_BAR;
    } else {
        PG8_STAGE(PG8_SB(0, 0), cB, voffB); PG8_STAGE(PG8_SA(0, 0), cA, voffA); PG8_STAGE(PG8_SB(0, 1), cB + hstep, voffB); PG8_STAGE(PG8_SA(0, 1), cA + hstep, voffA);
        if (wr == 1) PG8_BAR;
        PG8_WAIT_V(4); PG8_BAR;
        PG8_STAGE(PG8_SB(1, 0), cB + kstep, voffB); PG8_STAGE(PG8_SA(1, 0), cA + kstep, voffA); PG8_STAGE(PG8_SB(1, 1), cB + hstep + kstep, voffB);
        PG8_WAIT_V(6); PG8_BAR;
    }
    for (;;) {
        const bool has_next = S.next(ui + 1, nxt);
        const char* nA = has_next ? (const char*)g.A + (size_t)nxt.pm * tstep : cA; const char* nB = has_next ? (const char*)g.Bt + (size_t)nxt.pn * tstep : cB;
        for (int t = 0; t < nt; t += 2) {
            const bool last = (t == nt - 2);
            const char* a1 = cA + (size_t)(t + 1) * kstep;
            const char* a2 = last ? nA : cA + (size_t)(t + 2) * kstep; const char* b2 = last ? nB : cB + (size_t)(t + 2) * kstep;
            const char* a3 = a2 + kstep; const char* b3 = b2 + kstep;
            if (last && has_next) S.a_ready(nxt);
            if constexpr (SP2) {
            PG8_LDB(B0, 0, 0); PG8_LDB(B1, 0, 1); PG8_SCHED; PG8_LDA(At, 0, 0); PG8_STAGE(PG8_SA(1, 1), a1 + hstep, voffA);
            PG8_WAIT_V(8); PG8_WAIT_L(0); PG8_BAR; PG8_MMA(0, 0, At, B0); PG8_MMA(0, 1, At, B1); PG8_BAR; PG8_SCHED;
            PG8_LDA(At, 0, 1); PG8_STAGE(PG8_SB(0, 0), b2, voffB); PG8_STAGE(PG8_SB(0, 1), b2 + hstep, voffB); PG8_STAGE(PG8_SA(0, 0), a2, voffA);
            PG8_WAIT_V(8); PG8_WAIT_L(0); PG8_BAR; PG8_MMA(1, 0, At, B0); PG8_MMA(1, 1, At, B1); PG8_BAR; PG8_SCHED;
            PG8_LDB(B0, 1, 0); PG8_LDB(B1, 1, 1); PG8_SCHED; PG8_LDA(At, 1, 0); PG8_STAGE(PG8_SA(0, 1), a2 + hstep, voffA);
            PG8_WAIT_V(8); PG8_WAIT_L(0); PG8_BAR; PG8_MMA(0, 0, At, B0); PG8_MMA(0, 1, At, B1); PG8_BAR; PG8_SCHED;
            PG8_LDA(At, 1, 1); PG8_STAGE(PG8_SB(1, 0), b3, voffB); PG8_STAGE(PG8_SB(1, 1), b3 + hstep, voffB); PG8_STAGE(PG8_SA(1, 0), a3, voffA);
            PG8_WAIT_V(8); PG8_WAIT_L(0); PG8_BAR; PG8_MMA(1, 0, At, B0); PG8_MMA(1, 1, At, B1); PG8_BAR; PG8_SCHED;
            } else {
            PG8_LDB(B0, 0, 0); PG8_SCHED; PG8_LDA(At, 0, 0); PG8_STAGE(PG8_SA(1, 1), a1 + hstep, voffA);
            PG8_WAIT_L(8); PG8_BAR; PG8_WAIT_L(0); PG8_MMA(0, 0, At, B0); PG8_BAR; PG8_SCHED;
            PG8_LDB(B1, 0, 1); PG8_STAGE(PG8_SB(0, 0), b2, voffB);
            PG8_BAR; PG8_WAIT_L(0); PG8_MMA(0, 1, At, B1); PG8_BAR;
            PG8_LDA(At, 0, 1); PG8_STAGE(PG8_SA(0, 0), a2, voffA);
            PG8_BAR; PG8_WAIT_L(0); PG8_MMA(1, 0, At, B0); PG8_BAR; PG8_SCHED;
            PG8_STAGE(PG8_SB(0, 1), b2 + hstep, voffB);
            PG8_WAIT_V(6); PG8_BAR; PG8_MMA(1, 1, At, B1); PG8_BAR;
            PG8_LDB(B0, 1, 0); PG8_SCHED; PG8_LDA(At, 1, 0); PG8_STAGE(PG8_SA(0, 1), a2 + hstep, voffA);
            PG8_WAIT_L(8); PG8_BAR; PG8_WAIT_L(0); PG8_MMA(0, 0, At, B0); PG8_BAR; PG8_SCHED;
            PG8_LDB(B1, 1, 1); PG8_STAGE(PG8_SB(1, 0), b3, voffB);
            PG8_BAR; PG8_WAIT_L(0); PG8_MMA(0, 1, At, B1); PG8_BAR;
            PG8_LDA(At, 1, 1); PG8_STAGE(PG8_SA(1, 0), a3, voffA);
            PG8_BAR; PG8_WAIT_L(0); PG8_MMA(1, 0, At, B0); PG8_BAR; PG8_SCHED;
            PG8_STAGE(PG8_SB(1, 1), b3 + hstep, voffB);
            PG8_WAIT_V(6); PG8_BAR; PG8_MMA(1, 1, At, B1); PG8_BAR;
            }
        }
        if constexpr (ALIGN_EPI) { if (wr == 0) PG8_BAR; }
        if constexpr (!Epi::AFTER_DRAIN) { E(acc, cur, wr, wc, fr, fq); S.done(cur); }
        if (!has_next) break;
#pragma unroll
        for (int a = 0; a < 2; ++a)
#pragma unroll
            for (int b = 0; b < 2; ++b)
#pragma unroll
                for (int m = 0; m < 4; ++m)
#pragma unroll
                    for (int n = 0; n < 2; ++n) acc[a][b][m][n] = (f32x4){0.f, 0.f, 0.f, 0.f};
        cur = nxt; cA = nA; cB = nB; ++ui;
        if constexpr (ALIGN_EPI) { if (wr == 1) PG8_BAR; }
    }
    PG8_WAIT_V(0);
    if constexpr (!ALIGN_EPI) { if (wr == 0) PG8_BAR; }
    PG8_BAR;
    if constexpr (Epi::AFTER_DRAIN) { E.fused(acc, cur, wr, wc, fr, fq, lds, wid, lane); S.done(cur); }
#undef PG8_SA
#undef PG8_SB
#undef PG8_STAGE
#undef PG8_LDA
#undef PG8_LDB
#undef PG8_MMA
#undef PG8_WAIT_V
#undef PG8_WAIT_L
#undef PG8_BAR
#undef PG8_SCHED
}
}


#define LAS __attribute__((address_space(3)))
typedef unsigned short bf16_t;
typedef short bf16x8 __attribute__((ext_vector_type(8)));
typedef float f32x4 __attribute__((ext_vector_type(4)));
typedef unsigned u32x4 __attribute__((ext_vector_type(4)));
typedef unsigned u32x2 __attribute__((ext_vector_type(2)));
typedef unsigned short u16x4 __attribute__((ext_vector_type(4)));
using pg8::cvt_pk_bf16;

constexpr int DM = 1024, NTOK = 81920, MH = 49152  , NSEQH = 12, NPTOK = 16384, PC = 6208, DFF = 2816;
constexpr int PASS_ROW0[2] = {0, 49152}, PASS_ROWS[2] = {49152, 32768}, PASS_SEQ[2] = {12, 8};
constexpr int C_Q = 0, C_K = 256, C_V = 512, C_OG = 1024, C_RF = 1536, C_Z = 1568, C_XBC = 2592, C_BM = 3616, C_CM = 3872, C_DTF = 4128, C_DTB = 4144, C_G1 = 4160, C_G2 = 5184;
constexpr float EPS = 1e-6f;
constexpr int XCD_BAR_WORDS_ = 3456;

constexpr size_t WS_WIN = 0;
constexpr size_t WS_WB1 = WS_WIN + (size_t)6400 * 1024 * 2;
constexpr size_t WS_WB2 = WS_WB1 + (size_t)1024 * 512 * 2;
constexpr size_t WS_WOUT = WS_WB2 + (size_t)1024 * 1024 * 2;
constexpr size_t WS_WGU = WS_WOUT + (size_t)1024 * 1024 * 2;
constexpr size_t WS_WD = WS_WGU + (size_t)5632 * 1024 * 2;
constexpr size_t WS_RSS1 = WS_WD + (size_t)1024 * 2816 * 2;
constexpr size_t WS_RSS2 = WS_RSS1 + (size_t)NTOK * 4;
constexpr size_t WS_RSSY = WS_RSS2 + (size_t)NTOK * 4;
constexpr size_t WS_GDEC = WS_RSSY + (size_t)NTOK * 4;
constexpr size_t WS_SDEC = WS_GDEC + (size_t)NSEQH * 64 * 2 * 4 * 64 * 4;
constexpr size_t WS_PROJ = WS_SDEC + (size_t)NSEQH * 32 * 2 * 16 * 4;
constexpr size_t WS_U = WS_PROJ + (size_t)MH * PC * 2;
constexpr size_t WS_OG = WS_U;
constexpr size_t WS_Y = WS_U + (size_t)MH * 512 * 2;
constexpr size_t WS_ST = WS_U + (size_t)MH * 1536 * 2;
constexpr size_t WS_GS = WS_ST;
constexpr size_t WS_SS = WS_ST + (size_t)MH * 2048;
constexpr size_t WS_T = WS_ST;
constexpr size_t WS_MM = WS_ST + (size_t)MH * 2048;
constexpr size_t WS_X1B = WS_U;
constexpr size_t WS_BAR = WS_ST + (size_t)MH * 4096;
constexpr size_t WS_LG = WS_BAR + 16384;
constexpr size_t WS_END = WS_LG + (size_t)NSEQH * 256 * 8192 * 2;
static_assert(WS_PROJ % 256 == 0 && WS_U % 256 == 0 && WS_ST % 256 == 0 && WS_END < (size_t)1070 * 1000 * 1000, "ws map");

struct Params {
    const float* xp; const float* xs; const float* norm_mix_w; const float* w_in; const float* gla_up_f; const float* gla_bias_f; const float* gla_up_b; const float* gla_bias_b;
    const float* gla_norm_w; const float* conv_w; const float* conv_b; const float* dt_bias_f; const float* dt_bias_b; const float* a_log_f; const float* a_log_b; const float* d_skip;
    const float* ssm_norm_w; const float* w_br_gla; const float* w_br_ssm; const float* w_out; const float* norm_ffn_w; const float* w_ffn_gate; const float* w_ffn_up; const float* w_ffn_down;
    const float* norm_final_w; float* out; unsigned char* ws;
};

__device__ __forceinline__ float bf2f(unsigned short b) { return __uint_as_float(((unsigned)b) << 16); }
__device__ __forceinline__ float bflo(unsigned u) { return __uint_as_float(u << 16); }
__device__ __forceinline__ float bfhi(unsigned u) { return __uint_as_float(u & 0xffff0000u); }
__device__ __forceinline__ unsigned short f2bf(float f) { return (unsigned short)(cvt_pk_bf16(f, 0.f) & 0xffffu); }
__device__ __forceinline__ float sigmoidf_(float x) { return __builtin_amdgcn_rcpf(1.0f + __expf(-x)); }
__device__ __forceinline__ float siluf_(float x) { return x * __builtin_amdgcn_rcpf(1.0f + __expf(-x)); }
__device__ __forceinline__ float softplusf_(float x) { return fmaxf(x, 0.f) + log1pf(__expf(-fabsf(x))); }
__device__ __forceinline__ const float* xrow(const Params& p, int grow) { return grow < NPTOK ? p.xp + (size_t)grow * DM : p.xs + (size_t)(grow - NPTOK) * DM; }
__device__ __forceinline__ void unpack8(const u32x4 v, float* o) { o[0] = bflo(v.x); o[1] = bfhi(v.x); o[2] = bflo(v.y); o[3] = bfhi(v.y); o[4] = bflo(v.z); o[5] = bfhi(v.z); o[6] = bflo(v.w); o[7] = bfhi(v.w); }
__device__ __forceinline__ u32x4 pack8(const float* o) { u32x4 w; w.x = cvt_pk_bf16(o[0], o[1]); w.y = cvt_pk_bf16(o[2], o[3]); w.z = cvt_pk_bf16(o[4], o[5]); w.w = cvt_pk_bf16(o[6], o[7]); return w; }
__device__ __forceinline__ float shfl_idx(float x, int src_lane) { return __int_as_float(__builtin_amdgcn_ds_bpermute(src_lane << 2, __float_as_int(x))); }
__device__ __forceinline__ float bcast_lane63(float x) { return __int_as_float(__builtin_amdgcn_readlane(__float_as_int(x), 63)); }
template <int N> __device__ __forceinline__ float dpp_row_shr(float x) { return __int_as_float(__builtin_amdgcn_update_dpp(0, __float_as_int(x), 0x110 + N, 0xf, 0xf, true)); }
__device__ __forceinline__ float wave_incl_scan_tot(float x, int lane, float& tot) {
    x += dpp_row_shr<1>(x); x += dpp_row_shr<2>(x); x += dpp_row_shr<4>(x); x += dpp_row_shr<8>(x);
    const float t0 = __int_as_float(__builtin_amdgcn_readlane(__float_as_int(x), 15)), t1 = __int_as_float(__builtin_amdgcn_readlane(__float_as_int(x), 31));
    const float t2 = __int_as_float(__builtin_amdgcn_readlane(__float_as_int(x), 47)), t3 = __int_as_float(__builtin_amdgcn_readlane(__float_as_int(x), 63));
    const int row = lane >> 4;
    const float add = (row >= 1 ? t0 : 0.f) + (row >= 2 ? t1 : 0.f) + (row >= 3 ? t2 : 0.f);
    tot = (t0 + t1) + (t2 + t3);
    return x + add;
}
__device__ __forceinline__ bf16x8 frag_row(const LAS unsigned char* base, int RS, int row0, int k0, int lane) {
    return *(const LAS bf16x8*)(base + (row0 + (lane & 15)) * RS + (k0 + 8 * (lane >> 4)) * 2);
}
__device__ __forceinline__ bf16x8 frag_tr(unsigned base_addr, int RS, int k0, int c0, int lane) {
    const int g = lane >> 4, q = (lane & 15) >> 2, pp = lane & 3;
    const unsigned a0 = base_addr + (unsigned)((k0 + 8 * g + q) * RS + (c0 + 4 * pp) * 2), a1 = a0 + 4u * (unsigned)RS;
    u16x4 lo, hi;
    asm volatile("ds_read_b64_tr_b16 %0, %2\n\tds_read_b64_tr_b16 %1, %3\n\ts_waitcnt lgkmcnt(0)" : "=&v"(lo), "=&v"(hi) : "v"(a0), "v"(a1) : "memory");
    bf16x8 r; r[0] = (short)lo[0]; r[1] = (short)lo[1]; r[2] = (short)lo[2]; r[3] = (short)lo[3]; r[4] = (short)hi[0]; r[5] = (short)hi[1]; r[6] = (short)hi[2]; r[7] = (short)hi[3];
    return r;
}
#define MFMA16(a, b, c) __builtin_amdgcn_mfma_f32_16x16x32_bf16(a, b, c, 0, 0, 0)
__device__ __forceinline__ void frag_tr4(bf16x8 (&r)[4], unsigned base_addr, int RS, int k0, int c0, int cstep, int lane) {
    const int g = lane >> 4, q = (lane & 15) >> 2, pp = lane & 3;
    const unsigned a0 = base_addr + (unsigned)((k0 + 8 * g + q) * RS + (c0 + 4 * pp) * 2), a1 = a0 + 4u * (unsigned)RS; const unsigned cs = (unsigned)cstep * 2u;
    u16x4 lo[4], hi[4];
#pragma unroll
    for (int i = 0; i < 4; ++i) { asm volatile("ds_read_b64_tr_b16 %0, %1" : "=&v"(lo[i]) : "v"(a0 + cs * i) : "memory"); asm volatile("ds_read_b64_tr_b16 %0, %1" : "=&v"(hi[i]) : "v"(a1 + cs * i) : "memory"); }
    asm volatile("s_waitcnt lgkmcnt(0)" : "+v"(lo[0]), "+v"(lo[1]), "+v"(lo[2]), "+v"(lo[3]), "+v"(hi[0]), "+v"(hi[1]), "+v"(hi[2]), "+v"(hi[3]) :: "memory");
#pragma unroll
    for (int i = 0; i < 4; ++i) { r[i][0] = (short)lo[i][0]; r[i][1] = (short)lo[i][1]; r[i][2] = (short)lo[i][2]; r[i][3] = (short)lo[i][3]; r[i][4] = (short)hi[i][0]; r[i][5] = (short)hi[i][1]; r[i][6] = (short)hi[i][2]; r[i][7] = (short)hi[i][3]; }
}


#define XB_TMO      128
#define XB_XCNT(j)  (256  + 64 * (j))
#define XB_XSUB(j)  (1280 + 64 * (j))
#define XB_XGEN(j)  (2304 + 64 * (j))
#define XB_TOP      3328
#define XB_TOPGEN   3392
#define XCD_BAR_WORDS 3456
#define XB_SPIN_CAP (1u << 18)

__device__ __forceinline__ unsigned xb_tid() { unsigned t_ = threadIdx.x; asm volatile("" : "+v"(t_)); return t_; }
__device__ __forceinline__ unsigned xb_ld(unsigned* p)              { return __hip_atomic_load(p, __ATOMIC_RELAXED, __HIP_MEMORY_SCOPE_AGENT); }
__device__ __forceinline__ unsigned xb_add(unsigned* p, unsigned v) { return __hip_atomic_fetch_add(p, v, __ATOMIC_RELAXED, __HIP_MEMORY_SCOPE_AGENT); }
__device__ __forceinline__ unsigned xb_xcc_id() { return (unsigned)__builtin_amdgcn_s_getreg((3 << 11) | 20) & 0xFu; }
#define XB_SPIN(cond, bar) do { unsigned _sp = 0; while (cond) { __builtin_amdgcn_s_sleep(1); \
    if ((++_sp & 255u) == 0u) { if (xb_ld(&(bar)[XB_TMO])) break; if (_sp > XB_SPIN_CAP) { atomicAdd(&(bar)[XB_TMO], 1u); break; } } } } while (0)

struct XcdBarrier {
    unsigned* bar; unsigned x;
    volatile LAS unsigned* st;
};

__device__ __forceinline__ XcdBarrier xcd_barrier_post(unsigned* bar, volatile LAS unsigned* st) {
    XcdBarrier b; b.bar = bar; b.x = xb_xcc_id(); b.st = st;
    if (xb_tid() == 0) (void)xb_add(&bar[XB_XCNT(b.x)], 1u);
    return b;
}
__device__ __forceinline__ void xcd_barrier_complete(unsigned* bar, unsigned x, unsigned& nloc, unsigned& nx) {
    const unsigned G = gridDim.x * gridDim.y * gridDim.z;
    unsigned sum, cnt, mine, sp = 0u;
    for (;;) {
        sum = 0u; cnt = 0u; mine = 0u;
#pragma unroll
        for (unsigned j = 0; j < 16; ++j) { const unsigned c = xb_ld(&bar[XB_XCNT(j)]); sum += c; cnt += (c > 0u) ? 1u : 0u; mine = (j == x) ? c : mine; }
        if (sum == G) break;
        __builtin_amdgcn_s_sleep(1);
        if ((++sp & 255u) == 0u) { if (xb_ld(&bar[XB_TMO])) break; if (sp > XB_SPIN_CAP) { atomicAdd(&bar[XB_TMO], 1u); break; } }
    }
    nloc = mine > 0u ? mine : 1u; nx = cnt > 0u ? cnt : 1u;
}

__device__ __forceinline__ void xcd_barrier(const XcdBarrier& b) {
    asm volatile("s_waitcnt vmcnt(0)" ::: "memory");
    __syncthreads();
    if (xb_tid() == 0) {
        unsigned* bar = b.bar;
        __builtin_amdgcn_s_waitcnt(0);
        unsigned nloc = b.st[0], nx = b.st[1];
        if (nloc == 0u) { xcd_barrier_complete(bar, b.x, nloc, nx); b.st[0] = nloc; b.st[1] = nx; }
        const unsigned old = xb_add(&bar[XB_XSUB(b.x)], 1u);
        const unsigned gen = old / nloc;
        if (old + 1u == (gen + 1u) * nloc) {
            __builtin_amdgcn_fence(__ATOMIC_RELEASE, "agent");
            asm volatile("s_waitcnt vmcnt(0)" ::: "memory");
            const unsigned og = xb_add(&bar[XB_TOP], 1u);
            const unsigned tg = og / nx;
            if (og + 1u == (tg + 1u) * nx) xb_add(&bar[XB_TOPGEN], 1u);
            else XB_SPIN(xb_ld(&bar[XB_TOPGEN]) == tg, bar);
            __builtin_amdgcn_fence(__ATOMIC_ACQUIRE, "agent");
            xb_add(&bar[XB_XGEN(b.x)], 1u);
            asm volatile("s_waitcnt vmcnt(0)" ::: "memory");
        } else {
            XB_SPIN(xb_ld(&bar[XB_XGEN(b.x)]) == gen, bar);
            __builtin_amdgcn_fence(__ATOMIC_ACQUIRE, "agent");
            asm volatile("s_waitcnt vmcnt(0)" ::: "memory");
        }
    }
    __syncthreads();
}

struct EpiProj {
    static constexpr bool PERM = true, AFTER_DRAIN = false;
    bf16_t* O;
    __device__ __forceinline__ void operator()(const f32x4 (&acc)[2][2][4][2], const pg8::Unit& u, int wr, int wc, int fr, int fq) const {
        const int row0 = u.pm * 256 + wr * 64 + fr, col0 = u.pn * 256 + wc * 32 + 8 * fq;
#pragma unroll
        for (int ai = 0; ai < 2; ++ai)
#pragma unroll
            for (int m = 0; m < 4; ++m) { bf16_t* rowp = O + (size_t)(row0 + ai * 128 + m * 16) * PC;
#pragma unroll
                for (int bj = 0; bj < 2; ++bj) { const int c = col0 + bj * 128; const f32x4 v0 = acc[ai][bj][m][0], v1 = acc[ai][bj][m][1];
                    u32x4 w; w.x = cvt_pk_bf16(v0[0], v0[1]); w.y = cvt_pk_bf16(v0[2], v0[3]); w.z = cvt_pk_bf16(v1[0], v1[1]); w.w = cvt_pk_bf16(v1[2], v1[3]);
                    if (c < PC) *(u32x4*)(rowp + c) = w; } }
    }
};
struct EpiM1 {
    static constexpr bool PERM = true, AFTER_DRAIN = false;
    const bf16_t* proj; bf16_t* T;
    __device__ __forceinline__ void operator()(const f32x4 (&acc)[2][2][4][2], const pg8::Unit& u, int wr, int wc, int fr, int fq) const {
        const int row0 = u.pm * 256 + wr * 64 + fr, col0 = u.pn * 256 + wc * 32 + 8 * fq;
#pragma unroll
        for (int ai = 0; ai < 2; ++ai) {
            u32x4 gq[4][2];
#pragma unroll
            for (int m = 0; m < 4; ++m)
#pragma unroll
                for (int bj = 0; bj < 2; ++bj) gq[m][bj] = *(const u32x4*)(proj + (size_t)(row0 + ai * 128 + m * 16) * PC + C_G1 + col0 + bj * 128);
#pragma unroll
            for (int m = 0; m < 4; ++m) { const int row = row0 + ai * 128 + m * 16;
#pragma unroll
                for (int bj = 0; bj < 2; ++bj) { const int c = col0 + bj * 128; float gv[8], o[8];
                    unpack8(gq[m][bj], gv);
#pragma unroll
                    for (int j = 0; j < 8; ++j) o[j] = sigmoidf_(gv[j]) * acc[ai][bj][m][j >> 2][j & 3];
                    *(u32x4*)(T + (size_t)row * DM + c) = pack8(o); } }
        }
    }
};
struct EpiM2 {
    static constexpr bool PERM = true, AFTER_DRAIN = false;
    const bf16_t* proj; const bf16_t* T; bf16_t* MMo; const float* rssy;
    __device__ __forceinline__ void operator()(const f32x4 (&acc)[2][2][4][2], const pg8::Unit& u, int wr, int wc, int fr, int fq) const {
        const int row0 = u.pm * 256 + wr * 64 + fr, col0 = u.pn * 256 + wc * 32 + 8 * fq;
#pragma unroll
        for (int ai = 0; ai < 2; ++ai)
#pragma unroll
            for (int mh = 0; mh < 2; ++mh) {
                u32x4 gq[2][2], tq[2][2]; float rsv[2];
#pragma unroll
                for (int mm = 0; mm < 2; ++mm) { const int row = row0 + ai * 128 + (2 * mh + mm) * 16; rsv[mm] = rssy[row];
#pragma unroll
                    for (int bj = 0; bj < 2; ++bj) { const int c = col0 + bj * 128; gq[mm][bj] = *(const u32x4*)(proj + (size_t)row * PC + C_G2 + c); tq[mm][bj] = *(const u32x4*)(T + (size_t)row * DM + c); } }
#pragma unroll
                for (int mm = 0; mm < 2; ++mm) { const int m = 2 * mh + mm, row = row0 + ai * 128 + m * 16; const float rs = rsqrtf(rsv[mm] * (1.0f / 1024.0f) + EPS);
#pragma unroll
                    for (int bj = 0; bj < 2; ++bj) { const int c = col0 + bj * 128; float gv[8], tv[8], o[8];
                        unpack8(gq[mm][bj], gv); unpack8(tq[mm][bj], tv);
#pragma unroll
                        for (int j = 0; j < 8; ++j) o[j] = tv[j] + sigmoidf_(gv[j]) * rs * acc[ai][bj][m][j >> 2][j & 3];
                        *(u32x4*)(MMo + (size_t)row * DM + c) = pack8(o); } }
            }
    }
};
struct EpiOut {
    static constexpr bool PERM = true, AFTER_DRAIN = false;
    Params p; int grow0; bf16_t* X1B; float* rss;
    __device__ __forceinline__ void operator()(const f32x4 (&acc)[2][2][4][2], const pg8::Unit& u, int wr, int wc, int fr, int fq) const {
        const int row0 = u.pm * 256 + wr * 64 + fr, col0 = u.pn * 256 + wc * 32 + 8 * fq, ln_ = fq * 16 + fr;
#pragma unroll
        for (int ai = 0; ai < 2; ++ai)
#pragma unroll
            for (int mh = 0; mh < 2; ++mh) {
                f32x4 xa[2][2][2];
#pragma unroll
                for (int mm = 0; mm < 2; ++mm) { const float* xr = xrow(p, grow0 + row0 + ai * 128 + (2 * mh + mm) * 16);
#pragma unroll
                    for (int bj = 0; bj < 2; ++bj) { xa[mm][bj][0] = *(const f32x4*)(xr + col0 + bj * 128); xa[mm][bj][1] = *(const f32x4*)(xr + col0 + bj * 128 + 4); } }
#pragma unroll
                for (int mm = 0; mm < 2; ++mm) { const int m = 2 * mh + mm, row = row0 + ai * 128 + m * 16, grow = grow0 + row; float* orow = p.out + (size_t)grow * DM; float ss = 0.f;
#pragma unroll
                    for (int bj = 0; bj < 2; ++bj) { const int c = col0 + bj * 128;
                        const f32x4 a = xa[mm][bj][0] + acc[ai][bj][m][0], b = xa[mm][bj][1] + acc[ai][bj][m][1];
                        *(f32x4*)(orow + c) = a; *(f32x4*)(orow + c + 4) = b;
                        ss += a[0] * a[0] + a[1] * a[1] + a[2] * a[2] + a[3] * a[3] + b[0] * b[0] + b[1] * b[1] + b[2] * b[2] + b[3] * b[3];
                        u32x4 w; w.x = cvt_pk_bf16(a[0], a[1]); w.y = cvt_pk_bf16(a[2], a[3]); w.z = cvt_pk_bf16(b[0], b[1]); w.w = cvt_pk_bf16(b[2], b[3]);
                        *(u32x4*)(X1B + (size_t)row * DM + c) = w; }
                    ss += shfl_idx(ss, ln_ ^ 16); ss += shfl_idx(ss, ln_ ^ 32);
                    if (fq == 0) atomicAdd(rss + grow, ss); }
            }
    }
};
struct EpiSwi {
    static constexpr bool PERM = true, AFTER_DRAIN = false;
    const float* rss; bf16_t* H;
    __device__ __forceinline__ void operator()(const f32x4 (&acc)[2][2][4][2], const pg8::Unit& u, int wr, int wc, int fr, int fq) const {
        const int row0 = u.pm * 256 + wr * 64 + fr, hc = u.pn * 128 + wc * 32 + 8 * fq;
        float rsv[2][4];
#pragma unroll
        for (int ai = 0; ai < 2; ++ai)
#pragma unroll
            for (int m = 0; m < 4; ++m) rsv[ai][m] = rss[row0 + ai * 128 + m * 16];
#pragma unroll
        for (int ai = 0; ai < 2; ++ai)
#pragma unroll
            for (int m = 0; m < 4; ++m) { const int row = row0 + ai * 128 + m * 16; const float rs = rsqrtf(rsv[ai][m] * (1.0f / 1024.0f) + EPS); float o[8];
#pragma unroll
                for (int j = 0; j < 8; ++j) { const float gt = rs * acc[ai][0][m][j >> 2][j & 3], up = rs * acc[ai][1][m][j >> 2][j & 3]; o[j] = siluf_(gt) * up; }
                *(u32x4*)(H + (size_t)row * DFF + hc) = pack8(o); }
    }
};
struct EpiDown {
    static constexpr bool PERM = true, AFTER_DRAIN = false;
    float* out; int grow0; float* rss;
    __device__ __forceinline__ void operator()(const f32x4 (&acc)[2][2][4][2], const pg8::Unit& u, int wr, int wc, int fr, int fq) const {
        const int row0 = u.pm * 256 + wr * 64 + fr, col0 = u.pn * 256 + wc * 32 + 8 * fq, ln_ = fq * 16 + fr;
#pragma unroll
        for (int ai = 0; ai < 2; ++ai)
#pragma unroll
            for (int mh = 0; mh < 2; ++mh) {
                f32x4 xa[2][2][2];
#pragma unroll
                for (int mm = 0; mm < 2; ++mm) { const float* xr = out + (size_t)(grow0 + row0 + ai * 128 + (2 * mh + mm) * 16) * DM;
#pragma unroll
                    for (int bj = 0; bj < 2; ++bj) { xa[mm][bj][0] = *(const f32x4*)(xr + col0 + bj * 128); xa[mm][bj][1] = *(const f32x4*)(xr + col0 + bj * 128 + 4); } }
#pragma unroll
                for (int mm = 0; mm < 2; ++mm) { const int m = 2 * mh + mm, grow = grow0 + row0 + ai * 128 + m * 16; float* orow = out + (size_t)grow * DM; float ss = 0.f;
#pragma unroll
                    for (int bj = 0; bj < 2; ++bj) { const int c = col0 + bj * 128;
                        const f32x4 a = xa[mm][bj][0] + acc[ai][bj][m][0], b = xa[mm][bj][1] + acc[ai][bj][m][1];
                        *(f32x4*)(orow + c) = a; *(f32x4*)(orow + c + 4) = b;
                        ss += a[0] * a[0] + a[1] * a[1] + a[2] * a[2] + a[3] * a[3] + b[0] * b[0] + b[1] * b[1] + b[2] * b[2] + b[3] * b[3]; }
                    ss += shfl_idx(ss, ln_ ^ 16); ss += shfl_idx(ss, ln_ ^ 32);
                    if (fq == 0) atomicAdd(rss + grow, ss); }
            }
    }
};

__device__ __forceinline__ void transpose_tile(const float* src, int N, int k0, int n0, bf16_t* dst, int K, int mode, const float* kscale, LAS float* tl, int tid) {
    for (int i = tid; i < 1024; i += 512) { const int kk = i >> 4, n4 = (i & 15) * 4; f32x4 v = *(const f32x4*)(src + (size_t)(k0 + kk) * N + n0 + n4); if (kscale) v *= kscale[k0 + kk];
        tl[kk * 65 + n4] = v[0]; tl[kk * 65 + n4 + 1] = v[1]; tl[kk * 65 + n4 + 2] = v[2]; tl[kk * 65 + n4 + 3] = v[3]; }
    __syncthreads();
    for (int i = tid; i < 2048; i += 512) { const int nn = i >> 5, kp = i & 31; const float a = tl[(2 * kp) * 65 + nn], b = tl[(2 * kp + 1) * 65 + nn]; const int n = n0 + nn;
        const int row = mode == 0 ? n : (256 * (n >> 7) + (n & 127) + (mode == 2 ? 128 : 0));
        *(unsigned*)(dst + (size_t)row * K + k0 + 2 * kp) = cvt_pk_bf16(a, b); }
    __syncthreads();
}
__device__ __forceinline__ void phase_weights(const Params& p, LAS unsigned char* l, int tid) {
    unsigned char* ws = p.ws; LAS float* tl = (LAS float*)l;
    for (int j = blockIdx.x; j < 4304; j += gridDim.x) {
        if (j < 1552) transpose_tile(p.w_in, PC, (j / 97) * 64, (j % 97) * 64, (bf16_t*)(ws + WS_WIN), 1024, 0, nullptr, tl, tid);
        else if (j < 1680) { const int t = j - 1552; transpose_tile(p.w_br_gla, 1024, (t / 16) * 64, (t % 16) * 64, (bf16_t*)(ws + WS_WB1), 512, 0, nullptr, tl, tid); }
        else if (j < 1936) { const int t = j - 1680; transpose_tile(p.w_br_ssm, 1024, (t / 16) * 64, (t % 16) * 64, (bf16_t*)(ws + WS_WB2), 1024, 0, p.ssm_norm_w, tl, tid); }
        else if (j < 2192) { const int t = j - 1936; transpose_tile(p.w_out, 1024, (t / 16) * 64, (t % 16) * 64, (bf16_t*)(ws + WS_WOUT), 1024, 0, nullptr, tl, tid); }
        else if (j < 2896) { const int t = j - 2192; transpose_tile(p.w_ffn_gate, DFF, (t / 44) * 64, (t % 44) * 64, (bf16_t*)(ws + WS_WGU), 1024, 1, p.norm_ffn_w, tl, tid); }
        else if (j < 3600) { const int t = j - 2896; transpose_tile(p.w_ffn_up, DFF, (t / 44) * 64, (t % 44) * 64, (bf16_t*)(ws + WS_WGU), 1024, 2, p.norm_ffn_w, tl, tid); }
        else { const int t = j - 3600; transpose_tile(p.w_ffn_down, 1024, (t / 16) * 64, (t % 16) * 64, (bf16_t*)(ws + WS_WD), DFF, 0, nullptr, tl, tid); }
    }
    const int gt = blockIdx.x * 512 + tid, GT = gridDim.x * 512;
    unsigned* zw = (unsigned*)(ws + WS_WIN + (size_t)PC * 1024 * 2);
    for (int i = gt; i < 192 * 1024 / 2; i += GT) zw[i] = 0u;
    float* rs = (float*)(ws + WS_RSS1);
    for (int i = gt; i < 3 * NTOK; i += GT) rs[i] = 0.f;
}
__device__ __forceinline__ void phase_u(const Params& p, int row0, int nrows, int tid) {
    const int wave = tid >> 6, lane = tid & 63; bf16_t* U = (bf16_t*)(p.ws + WS_U);
    const int RST = gridDim.x * 8;
    for (int rb = blockIdx.x * 8 + wave; rb < nrows; rb += 2 * RST) {
        f32x4 v[2][4]; float ss[2] = {0.f, 0.f};
#pragma unroll
        for (int q = 0; q < 2; ++q) { const int r = rb + q * RST; if (r < nrows) { const float* xr = xrow(p, row0 + r);
#pragma unroll
            for (int i = 0; i < 4; ++i) v[q][i] = ((const f32x4*)xr)[lane + 64 * i]; } else {
#pragma unroll
            for (int i = 0; i < 4; ++i) v[q][i] = (f32x4){0.f, 0.f, 0.f, 0.f}; } }
        f32x4 wv[4];
#pragma unroll
        for (int i = 0; i < 4; ++i) wv[i] = ((const f32x4*)p.norm_mix_w)[lane + 64 * i];
#pragma unroll
        for (int q = 0; q < 2; ++q) {
#pragma unroll
            for (int i = 0; i < 4; ++i) ss[q] += v[q][i][0] * v[q][i][0] + v[q][i][1] * v[q][i][1] + v[q][i][2] * v[q][i][2] + v[q][i][3] * v[q][i][3];
#pragma unroll
            for (int o = 1; o < 64; o <<= 1) ss[q] += shfl_idx(ss[q], lane ^ o);
            const float rstd = rsqrtf(ss[q] * (1.0f / 1024.0f) + EPS); const int r = rb + q * RST;
            if (r < nrows) {
#pragma unroll
                for (int i = 0; i < 4; ++i) { u32x2 o; o.x = cvt_pk_bf16(v[q][i][0] * rstd * wv[i][0], v[q][i][1] * rstd * wv[i][1]); o.y = cvt_pk_bf16(v[q][i][2] * rstd * wv[i][2], v[q][i][3] * rstd * wv[i][3]);
                    *(u32x2*)(U + (size_t)r * DM + 4 * (lane + 64 * i)) = o; } }
        }
    }
}

constexpr int G_QF = 0, G_KF = 9216, G_QB = 18432, G_KB = 27648, G_V = 36864, G_ATT = 54272, G_SFT = 63488, G_SBT = 81920, G_SSQ = 100352, G_RS = 144, G_RSV = 272,
              G_UP = 101376, G_BIAS = 109568, G_KR = 110080, G_QR = 119296, G_RFB = 128512, G_RSR = 80, G_OGR = 133632, G_STG3 = 110080, G_STG1 = 63488, G_GNW = 151040;
struct GlaPF { u32x4 k, q, rf; f32x4 up, bias, gnw; unsigned short lg[16]; };
template <bool S3>
__device__ __forceinline__ void gla_pf_load(GlaPF& f, const Params& p, int item, int tid) {
    const int h = item & 3, c = (item >> 2) & 63, seq = item >> 8, r0 = seq * 4096 + c * 64;
    const bf16_t* proj = (const bf16_t*)(p.ws + WS_PROJ);
    { const int row = tid >> 3, ch = tid & 7; const bf16_t* pr = proj + (size_t)(r0 + row) * PC; f.k = *(const u32x4*)(pr + C_K + 64 * h + ch * 8); if (S3) f.q = *(const u32x4*)(pr + C_Q + 64 * h + ch * 8); }
    if (!S3) {
        if (tid < 256) { const int row = tid >> 2, ch = tid & 3; f.rf = *(const u32x4*)(proj + (size_t)(r0 + row) * PC + C_RF + ch * 8); }
        { const int dr = tid >> 8, r = (tid >> 4) & 15, d4 = tid & 15; f.up = *(const f32x4*)((dr ? p.gla_up_b : p.gla_up_f) + r * 256 + 64 * h + 4 * d4); }
        if (tid < 32) f.bias = *(const f32x4*)(((tid >> 4) ? p.gla_bias_b : p.gla_bias_f) + 64 * h + 4 * (tid & 15));
    } else {
        if (tid >= 64 && tid < 96) f.gnw = *(const f32x4*)(p.gla_norm_w + 4 * (tid - 64));
        const unsigned short* lgp = (const unsigned short*)(p.ws + WS_LG) + (size_t)item * 8192 + (size_t)((tid >> 8) * 64 + ((tid >> 6) & 3) * 16) * 64 + (tid & 63);
#pragma unroll
        for (int dd = 0; dd < 16; ++dd) f.lg[dd] = lgp[dd * 64];
    }
}
template <bool S3>
__device__ __forceinline__ void gla_pf_store(const GlaPF& f, LAS unsigned char* l, int tid) {
    { const int row = tid >> 3, ch = tid & 7; *(LAS u32x4*)(l + G_KR + row * G_RS + ch * 16) = f.k; if (S3) *(LAS u32x4*)(l + G_QR + row * G_RS + ch * 16) = f.q; }
    if (!S3) {
        if (tid < 256) { const int row = tid >> 2, ch = tid & 3; *(LAS u32x4*)(l + G_RFB + row * G_RSR + ch * 16) = f.rf; }
        *(LAS f32x4*)(l + G_UP + tid * 16) = f.up;
        if (tid < 32) *(LAS f32x4*)(l + G_BIAS + tid * 16) = f.bias;
    } else if (tid >= 64 && tid < 96) *(LAS f32x4*)(l + G_GNW + (tid - 64) * 16) = f.gnw;
}
#define LBAR() do { asm volatile("s_waitcnt lgkmcnt(0)" ::: "memory"); __builtin_amdgcn_s_barrier(); asm volatile("" ::: "memory"); } while (0)
template <bool S3>
__device__ __forceinline__ void gla_prep(LAS unsigned char* l, int lane, int w, int h, float* gdec_out, const GlaPF& pf, unsigned short* lgbuf) {
    const int dir = w >> 2, dq = w & 3;
    float rv[16];
    if (!S3) { const LAS unsigned char* rp = l + G_RFB + lane * G_RSR + 32 * dir; unpack8(*(const LAS u32x4*)rp, rv); unpack8(*(const LAS u32x4*)(rp + 16), rv + 8); }
    const LAS float* UPL = (const LAS float*)(l + G_UP) + dir * 1024; const LAS float* BIASL = (const LAS float*)(l + G_BIAS) + dir * 64;
#pragma unroll
    for (int grp = 0; grp < 4; ++grp) {
        float lgv[4];
        if (!S3) {
            f32x4 z4 = *(const LAS f32x4*)(BIASL + 16 * dq + 4 * grp);
#pragma unroll
            for (int r = 0; r < 16; ++r) z4 += rv[r] * *(const LAS f32x4*)(UPL + r * 64 + 16 * dq + 4 * grp);
#pragma unroll
            for (int q = 0; q < 4; ++q) { lgv[q] = -(fmaxf(-z4[q], 0.f) + __logf(1.0f + __expf(-fabsf(z4[q])))) * 0.0625f;
                lgbuf[(size_t)(dir * 64 + 16 * dq + 4 * grp + q) * 64 + lane] = __builtin_bit_cast(unsigned short, (_Float16)lgv[q]); }
        } else {
#pragma unroll
            for (int q = 0; q < 4; ++q) lgv[q] = (float)__builtin_bit_cast(_Float16, pf.lg[4 * grp + q]);
        }
        __builtin_amdgcn_sched_barrier(0);
        const u32x2 kraw = *(const LAS u32x2*)(l + G_KR + lane * G_RS + 32 * dq + 8 * grp);
        const float kv[4] = {bflo(kraw.x), bfhi(kraw.x), bflo(kraw.y), bfhi(kraw.y)};
        float qv[4] = {0.f, 0.f, 0.f, 0.f};
        if (S3) { const u32x2 qraw = *(const LAS u32x2*)(l + G_QR + lane * G_RS + 32 * dq + 8 * grp); qv[0] = bflo(qraw.x); qv[1] = bfhi(qraw.x); qv[2] = bflo(qraw.y); qv[3] = bfhi(qraw.y); }
        float qd[4], kd[4];
#pragma unroll
        for (int q = 0; q < 4; ++q) {
            const int d = 16 * dq + 4 * grp + q;
            const float lg = lgv[q];
            float tot;
            const float incl = wave_incl_scan_tot(lg, lane, tot);
            const float G = dir ? (tot - incl + lg) : incl;
            if (!S3) {
                const float kp = kv[q] * __expf(tot - G);
                *(LAS bf16_t*)(l + G_QF + (dir * 64 + d) * G_RS + lane * 2) = f2bf(kp);
                if (lane == 0) gdec_out[dir * 256 + h * 64 + d] = __expf(tot);
            } else {
                qd[q] = qv[q] * 0.125f * __expf(G); kd[q] = kv[q] * __expf(-G);
            }
        }
        if (S3) {
            u32x2 qo, ko; qo.x = cvt_pk_bf16(qd[0], qd[1]); qo.y = cvt_pk_bf16(qd[2], qd[3]); ko.x = cvt_pk_bf16(kd[0], kd[1]); ko.y = cvt_pk_bf16(kd[2], kd[3]);
            *(LAS u32x2*)(l + (dir ? G_QB : G_QF) + lane * G_RS + 32 * dq + 8 * grp) = qo;
            *(LAS u32x2*)(l + (dir ? G_KB : G_KF) + lane * G_RS + 32 * dq + 8 * grp) = ko;
        }
        __builtin_amdgcn_sched_barrier(0);
    }
}
__device__ __forceinline__ void gla_s1_item(const Params& p, int item, int next_item, GlaPF& pf, LAS unsigned char* l, unsigned lbase, int tid) {
    const int lane = tid & 63, w = __builtin_amdgcn_readfirstlane(tid >> 6);
    const int h = item & 3, c = (item >> 2) & 63, seq = item >> 8, r0 = seq * 4096 + c * 64;
    const bf16_t* proj = (const bf16_t*)(p.ws + WS_PROJ);
    float* gdec = (float*)(p.ws + WS_GDEC) + (size_t)((seq * 64 + c) * 2) * 256;
    gla_pf_store<false>(pf, l, tid);
    u32x4 vr[2];
#pragma unroll
    for (int k = 0; k < 2; ++k) { const int i = tid + 512 * k, row = i >> 4, ch = i & 15; vr[k] = *(const u32x4*)(proj + (size_t)(r0 + row) * PC + C_V + 128 * h + ch * 8); }
    LBAR();
    gla_prep<false>(l, lane, w, h, gdec, pf, (unsigned short*)(p.ws + WS_LG) + (size_t)item * 8192);
#pragma unroll
    for (int k = 0; k < 2; ++k) { const int i = tid + 512 * k, row = i >> 4, ch = i & 15; *(LAS u32x4*)(l + G_V + row * G_RSV + ch * 16) = vr[k]; }
    if (next_item >= 0) gla_pf_load<false>(pf, p, next_item, tid);
    LBAR();
    const int dir = w >> 2, dvb0 = (w & 3) * 2, g = lane >> 4, ln = lane & 15;
    LAS unsigned char* stg = l + G_STG1 + w * 4608;
#pragma unroll
    for (int i = 0; i < 2; ++i) {
        bf16x8 A[2];
#pragma unroll
        for (int ks = 0; ks < 2; ++ks) A[ks] = frag_tr(lbase + G_V, G_RSV, 32 * ks, 16 * (dvb0 + i), lane);
#pragma unroll
        for (int n = 0; n < 4; ++n) { f32x4 acc = {0.f, 0.f, 0.f, 0.f};
#pragma unroll
            for (int ks = 0; ks < 2; ++ks) acc = MFMA16(A[ks], frag_row(l + G_QF + dir * 64 * G_RS, G_RS, 16 * n, 32 * ks, lane), acc);
#pragma unroll
            for (int r = 0; r < 4; ++r) *(LAS bf16_t*)(stg + (16 * i + 4 * g + r) * G_RS + (16 * n + ln) * 2) = f2bf(acc[r]); }
    }
    asm volatile("" ::: "memory");
    bf16_t* GS = (bf16_t*)(p.ws + WS_GS) + ((size_t)(((seq * 64 + c) * 2 + dir) * 4 + h)) * 8192 + (size_t)dvb0 * 16 * 64;
#pragma unroll
    for (int k = 0; k < 4; ++k) { const int i = lane + 64 * k, row = i >> 3, ch = i & 7; *(u32x4*)(GS + row * 64 + ch * 8) = *(const LAS u32x4*)(stg + row * G_RS + ch * 16); }
    LBAR();
}
__device__ __forceinline__ void gla_s3_item(const Params& p, int item, int next_item, GlaPF& pf, LAS unsigned char* l, unsigned lbase, int tid) {
    const int lane = tid & 63, w = __builtin_amdgcn_readfirstlane(tid >> 6);
    const int h = item & 3, c = (item >> 2) & 63, seq = item >> 8, r0 = seq * 4096 + c * 64;
    const bf16_t* proj = (const bf16_t*)(p.ws + WS_PROJ);
    gla_pf_store<true>(pf, l, tid);
    u32x4 vr[2], ogr[2], str[4];
    const bf16_t* GSb = (const bf16_t*)(p.ws + WS_GS);
#pragma unroll
    for (int k = 0; k < 2; ++k) { const int i = tid + 512 * k, row = i >> 4, ch = i & 15; const bf16_t* pr = proj + (size_t)(r0 + row) * PC;
        vr[k] = *(const u32x4*)(pr + C_V + 128 * h + ch * 8); ogr[k] = *(const u32x4*)(pr + C_OG + 128 * h + ch * 8); }
#pragma unroll
    for (int k = 0; k < 4; ++k) { const int i = tid + 512 * k, dir = i >> 10, row = (i >> 3) & 127, ch = i & 7;
        str[k] = *(const u32x4*)(GSb + ((size_t)(((seq * 64 + c) * 2 + dir) * 4 + h)) * 8192 + row * 64 + ch * 8); }
    const int g = lane >> 4, ln = lane & 15, tb = w >> 1, dvh = w & 1;
    LBAR();
    gla_prep<true>(l, lane, w, h, nullptr, pf, nullptr);
#pragma unroll
    for (int k = 0; k < 2; ++k) { const int i = tid + 512 * k, row = i >> 4, ch = i & 15; *(LAS u32x4*)(l + G_V + row * G_RSV + ch * 16) = vr[k]; *(LAS u32x4*)(l + G_OGR + row * G_RSV + ch * 16) = ogr[k]; }
#pragma unroll
    for (int k = 0; k < 4; ++k) { const int i = tid + 512 * k, dir = i >> 10, row = (i >> 3) & 127, ch = i & 7; *(LAS u32x4*)(l + (dir ? G_SBT : G_SFT) + row * G_RS + ch * 16) = str[k]; }
    if (next_item >= 0) gla_pf_load<true>(pf, p, next_item, tid);
    LBAR();
    {
        const int ti = w >> 1;
#pragma unroll
        for (int k = 0; k < 2; ++k) { const int si = 2 * (w & 1) + k; f32x4 af = {0.f, 0.f, 0.f, 0.f}, ab = {0.f, 0.f, 0.f, 0.f};
            if (ti >= si) {
#pragma unroll
                for (int ks = 0; ks < 2; ++ks) af = MFMA16(frag_row(l + G_QF, G_RS, 16 * ti, 32 * ks, lane), frag_row(l + G_KF, G_RS, 16 * si, 32 * ks, lane), af); }
            if (ti <= si) {
#pragma unroll
                for (int ks = 0; ks < 2; ++ks) ab = MFMA16(frag_row(l + G_QB, G_RS, 16 * ti, 32 * ks, lane), frag_row(l + G_KB, G_RS, 16 * si, 32 * ks, lane), ab); }
#pragma unroll
            for (int r = 0; r < 4; ++r) { const int t = 16 * ti + 4 * g + r, s = 16 * si + ln; *(LAS bf16_t*)(l + G_ATT + t * G_RS + s * 2) = f2bf(s <= t ? af[r] : ab[r]); }
        }
    }
    LBAR();
    f32x4 acc[4];
#pragma unroll
    for (int i = 0; i < 4; ++i) acc[i] = (f32x4){0.f, 0.f, 0.f, 0.f};
#pragma unroll
    for (int ks = 0; ks < 2; ++ks) {
        const bf16x8 a_att = frag_row(l + G_ATT, G_RS, 16 * tb, 32 * ks, lane), a_qf = frag_row(l + G_QF, G_RS, 16 * tb, 32 * ks, lane), a_qb = frag_row(l + G_QB, G_RS, 16 * tb, 32 * ks, lane);
        bf16x8 vb[4]; frag_tr4(vb, lbase + G_V, G_RSV, 32 * ks, 64 * dvh, 16, lane);
#pragma unroll
        for (int i = 0; i < 4; ++i) { const int dvb = dvh * 4 + i;
            acc[i] = MFMA16(a_att, vb[i], acc[i]);
            acc[i] = MFMA16(a_qf, frag_row(l + G_SFT, G_RS, 16 * dvb, 32 * ks, lane), acc[i]);
            acc[i] = MFMA16(a_qb, frag_row(l + G_SBT, G_RS, 16 * dvb, 32 * ks, lane), acc[i]); }
    }
#pragma unroll
    for (int r = 0; r < 4; ++r) { float s = 0.f;
#pragma unroll
        for (int i = 0; i < 4; ++i) s += acc[i][r] * acc[i][r];
        s += shfl_idx(s, lane ^ 1); s += shfl_idx(s, lane ^ 2); s += shfl_idx(s, lane ^ 4); s += shfl_idx(s, lane ^ 8);
        if (ln == 0) *(LAS float*)(l + G_SSQ + ((16 * tb + 4 * g + r) * 2 + dvh) * 4) = s; }
    LBAR();
    LAS unsigned char* stg = l + G_STG3 + w * 2304;
#pragma unroll
    for (int r = 0; r < 4; ++r) { const int t = 16 * tb + 4 * g + r; const LAS float* sp = (const LAS float*)(l + G_SSQ + t * 8);
        const float rstd = rsqrtf((sp[0] + sp[1]) * (1.0f / 128.0f) + EPS);
#pragma unroll
        for (int i = 0; i < 4; ++i) { const int dvl = 16 * i + ln; const float og = bf2f(*(const LAS bf16_t*)(l + G_OGR + t * G_RSV + (64 * dvh + dvl) * 2));
            *(LAS bf16_t*)(stg + (4 * g + r) * G_RS + dvl * 2) = f2bf(acc[i][r] * rstd * ((const LAS float*)(l + G_GNW))[64 * dvh + dvl] * siluf_(og)); } }
    asm volatile("" ::: "memory");
    bf16_t* OG = (bf16_t*)(p.ws + WS_OG) + (size_t)(r0 + 16 * tb) * 512 + 128 * h + 64 * dvh;
#pragma unroll
    for (int k = 0; k < 2; ++k) { const int i = lane + 64 * k, row = i >> 3, ch = i & 7; *(u32x4*)(OG + (size_t)row * 512 + ch * 8) = *(const LAS u32x4*)(stg + row * G_RS + ch * 16); }
    LBAR();
}

constexpr int S_XS = 0, S_BM = 67584, S_CM = 86016, S_MB = 104448, S_DT = 139264, S_AC = 143360, S_W8 = 147456, S_RSX = 528, S_RS = 144, S_RSM = 272;
template <bool S3>
__device__ __forceinline__ void ssd_prep(const Params& p, const bf16_t* proj, int seq, int c, int gi, LAS unsigned char* l, int tid, float* sdec_out) {
    const int lane = tid & 63, w = __builtin_amdgcn_readfirstlane(tid >> 6);
    const int tok0 = c * 128; constexpr int NV = S3 ? 16 : 40, NST = S3 ? 32 : 12, TS = S3 ? 4 : 11, CV0 = S3 ? 32 : 0;
    bf16_t* XSG = (bf16_t*)(p.ws + WS_Y);
    const int dir = w >> 2, j = w & 3, hd = 4 * gi + j, r0 = seq * 4096 + tok0;
    const int dcol = (dir ? C_DTB : C_DTF) + hd;
    const float raw0 = bf2f(proj[(size_t)(r0 + lane) * PC + dcol]), raw1 = bf2f(proj[(size_t)(r0 + lane + 64) * PC + dcol]);
    const float dtb = (dir ? p.dt_bias_b : p.dt_bias_f)[hd], alog = (dir ? p.a_log_b : p.a_log_f)[hd];
    u32x4 xsr[8];
    if (S3) {
#pragma unroll
        for (int k = 0; k < 8; ++k) { const int i = tid + 512 * k, row = i >> 5, ch = i & 31; xsr[k] = *(const u32x4*)(XSG + (size_t)(r0 + row) * 1024 + 256 * gi + ch * 8); }
    }
    if (tid < NV * NST) {
        const int cv = CV0 + tid % NV, t0 = (tid / NV) * TS;
        const int col = cv < 32 ? C_XBC + 256 * gi + 8 * cv : (cv < 40 ? C_BM + 64 * gi + 8 * (cv - 32) : C_CM + 64 * gi + 8 * (cv - 40));
        const int ch = col - C_XBC;
        u32x4 raw[TS + 4];
#pragma unroll
        for (int i = 0; i < TS + 4; ++i) { const int tt = tok0 + t0 + i - 2; raw[i] = (u32x4){0u, 0u, 0u, 0u};
            if (tt >= 0 && tt < 4096 && t0 + i - 2 < 130) raw[i] = *(const u32x4*)(proj + (size_t)(seq * 4096 + tt) * PC + col); }
        typedef float f32x2 __attribute__((ext_vector_type(2)));
        f32x2 wv[5][4], bv[4];
#pragma unroll
        for (int i = 0; i < 5; ++i) { const f32x4 a = *(const f32x4*)(p.conv_w + i * 1536 + ch), b = *(const f32x4*)(p.conv_w + i * 1536 + ch + 4);
            wv[i][0] = (f32x2){a[0], a[1]}; wv[i][1] = (f32x2){a[2], a[3]}; wv[i][2] = (f32x2){b[0], b[1]}; wv[i][3] = (f32x2){b[2], b[3]}; }
        { const f32x4 a = *(const f32x4*)(p.conv_b + ch), b = *(const f32x4*)(p.conv_b + ch + 4); bv[0] = (f32x2){a[0], a[1]}; bv[1] = (f32x2){a[2], a[3]}; bv[2] = (f32x2){b[0], b[1]}; bv[3] = (f32x2){b[2], b[3]}; }
        LAS unsigned char* dst0 = cv < 32 ? l + S_XS + cv * 16 : (cv < 40 ? l + S_BM + (cv - 32) * 16 : l + S_CM + (cv - 40) * 16); const int drs = cv < 32 ? S_RSX : S_RS;
        f32x2 xw[5][4];
#pragma unroll
        for (int i = 0; i < 4; ++i) { const u32x4 rr = raw[i]; xw[i][0] = (f32x2){bflo(rr.x), bfhi(rr.x)}; xw[i][1] = (f32x2){bflo(rr.y), bfhi(rr.y)}; xw[i][2] = (f32x2){bflo(rr.z), bfhi(rr.z)}; xw[i][3] = (f32x2){bflo(rr.w), bfhi(rr.w)}; }
#pragma unroll
        for (int o = 0; o < TS; ++o) { const int t = t0 + o;
            { const u32x4 rr = raw[o + 4]; xw[4][0] = (f32x2){bflo(rr.x), bfhi(rr.x)}; xw[4][1] = (f32x2){bflo(rr.y), bfhi(rr.y)}; xw[4][2] = (f32x2){bflo(rr.z), bfhi(rr.z)}; xw[4][3] = (f32x2){bflo(rr.w), bfhi(rr.w)}; }
            if (t < 128) { u32x4 pk;
#pragma unroll
                for (int k = 0; k < 4; ++k) { f32x2 a = bv[k];
#pragma unroll
                    for (int i = 0; i < 5; ++i) a = xw[i][k] * wv[i][k] + a;
                    const unsigned pw = cvt_pk_bf16(siluf_(a[0]), siluf_(a[1])); if (k == 0) pk.x = pw; else if (k == 1) pk.y = pw; else if (k == 2) pk.z = pw; else pk.w = pw; }
                *(LAS u32x4*)(dst0 + t * drs) = pk;
                if (!S3 && cv < 32) *(u32x4*)(XSG + (size_t)(r0 + t) * 1024 + 256 * gi + 8 * cv) = pk; }
#pragma unroll
            for (int i = 0; i < 4; ++i)
#pragma unroll
                for (int k = 0; k < 4; ++k) xw[i][k] = xw[i + 1][k];
        }
    }
    if (S3) {
#pragma unroll
        for (int k = 0; k < 8; ++k) { const int i = tid + 512 * k, row = i >> 5, ch = i & 31; *(LAS u32x4*)(l + S_XS + row * S_RSX + ch * 16) = xsr[k]; }
    }
    {
        const float A = -__expf(alog);
        const float dt0 = softplusf_(raw0 + dtb), dt1 = softplusf_(raw1 + dtb);
        const float la0 = dt0 * A, la1 = dt1 * A;
        float tot0, tot1; const float s0 = wave_incl_scan_tot(la0, lane, tot0), s1 = wave_incl_scan_tot(la1, lane, tot1); const float total = tot0 + tot1;
        float ac0, ac1;
        if (dir == 0) { ac0 = s0; ac1 = tot0 + s1; } else { ac0 = total - (s0 - la0); ac1 = total - (tot0 + s1 - la1); }
        LAS float* DT = (LAS float*)(l + S_DT) + (dir * 4 + j) * 128; LAS float* AC = (LAS float*)(l + S_AC) + (dir * 4 + j) * 128;
        DT[lane] = dt0; DT[lane + 64] = dt1; AC[lane] = ac0; AC[lane + 64] = ac1;
        if (!S3) { LAS float* W8 = (LAS float*)(l + S_W8) + (dir * 4 + j) * 128; W8[lane] = dt0 * __expf(total - ac0); W8[lane + 64] = dt1 * __expf(total - ac1);
            if (lane == 0) sdec_out[dir * 16 + hd] = __expf(total); }
    }
}
__device__ __forceinline__ void ssd_s1_item(const Params& p, int item, LAS unsigned char* l, unsigned lbase, int tid) {
    const int lane = tid & 63, w = __builtin_amdgcn_readfirstlane(tid >> 6);
    const int gi = item & 3, c = (item >> 2) & 31, seq = item >> 7;
    const bf16_t* proj = (const bf16_t*)(p.ws + WS_PROJ);
    float* sdec = (float*)(p.ws + WS_SDEC) + (size_t)((seq * 32 + c) * 2) * 16;
    ssd_prep<false>(p, proj, seq, c, gi, l, tid, sdec);
    __syncthreads();
    const int dir = w >> 2, j = w & 3, hd = 4 * gi + j, g = lane >> 4, ln = lane & 15;
    f32x4 acc[4][4];
#pragma unroll
    for (int a = 0; a < 4; ++a)
#pragma unroll
        for (int b = 0; b < 4; ++b) acc[a][b] = (f32x4){0.f, 0.f, 0.f, 0.f};
#pragma unroll
    for (int ks = 0; ks < 4; ++ks) {
        bf16x8 A[4], B[4], Braw[4];
        frag_tr4(A, lbase + S_XS, S_RSX, 32 * ks, 64 * j, 16, lane);
        frag_tr4(Braw, lbase + S_BM, S_RS, 32 * ks, 0, 16, lane);
        const LAS float* wp = (const LAS float*)(l + S_W8) + (dir * 4 + j) * 128 + 32 * ks + 8 * g;
        const f32x4 w0 = *(const LAS f32x4*)wp, w1 = *(const LAS f32x4*)(wp + 4);
#pragma unroll
        for (int ni = 0; ni < 4; ++ni) { const bf16x8 b = Braw[ni]; float o[8];
#pragma unroll
            for (int jj = 0; jj < 8; ++jj) o[jj] = bf2f((unsigned short)b[jj]) * (jj < 4 ? w0[jj & 3] : w1[jj & 3]);
            const u32x4 pk = pack8(o); B[ni] = __builtin_bit_cast(bf16x8, pk); }
#pragma unroll
        for (int pi = 0; pi < 4; ++pi)
#pragma unroll
            for (int ni = 0; ni < 4; ++ni) acc[pi][ni] = MFMA16(A[pi], B[ni], acc[pi][ni]);
    }
    __syncthreads();
    LAS unsigned char* stg = l + S_XS + w * 9216;
#pragma unroll
    for (int pi = 0; pi < 4; ++pi)
#pragma unroll
        for (int ni = 0; ni < 4; ++ni)
#pragma unroll
            for (int r = 0; r < 4; ++r) *(LAS bf16_t*)(stg + (16 * pi + 4 * g + r) * S_RS + (16 * ni + ln) * 2) = f2bf(acc[pi][ni][r]);
    asm volatile("" ::: "memory");
    bf16_t* SS = (bf16_t*)(p.ws + WS_SS) + ((size_t)(((seq * 32 + c) * 2 + dir) * 16 + hd)) * 4096;
#pragma unroll
    for (int k = 0; k < 8; ++k) { const int i = lane + 64 * k, row = i >> 3, ch = i & 7; *(u32x4*)(SS + row * 64 + ch * 8) = *(const LAS u32x4*)(stg + row * S_RS + ch * 16); }
    __syncthreads();
}
__device__ __forceinline__ void ssd_s3_item(const Params& p, int row0, int item, LAS unsigned char* l, unsigned lbase, int tid) {
    const int lane = tid & 63, w = __builtin_amdgcn_readfirstlane(tid >> 6);
    const int gi = item & 3, c = (item >> 2) & 31, seq = item >> 7, r0 = seq * 4096 + c * 128;
    const bf16_t* proj = (const bf16_t*)(p.ws + WS_PROJ);
    const bf16_t* SSb = (const bf16_t*)(p.ws + WS_SS);
    const int sdir = tid >> 8, si_ = tid & 255, srow0 = si_ >> 3, sch = si_ & 7;
    const bf16_t* sp0 = SSb + ((size_t)(((seq * 32 + c) * 2 + sdir) * 16 + 4 * gi)) * 4096 + srow0 * 64 + sch * 8;
    u32x4 sa = *(const u32x4*)sp0, sb = *(const u32x4*)(sp0 + 32 * 64);
    ssd_prep<true>(p, proj, seq, c, gi, l, tid, nullptr);
    __syncthreads();
    const int g = lane >> 4, ln = lane & 15;
    f32x4 cb[8];
#pragma unroll
    for (int si = 0; si < 8; ++si) { cb[si] = (f32x4){0.f, 0.f, 0.f, 0.f};
#pragma unroll
        for (int ks = 0; ks < 2; ++ks) cb[si] = MFMA16(frag_row(l + S_CM, S_RS, 16 * w, 32 * ks, lane), frag_row(l + S_BM, S_RS, 16 * si, 32 * ks, lane), cb[si]); }
    __syncthreads();
    bf16_t* Y = (bf16_t*)(p.ws + WS_Y);
    const int erow = lane >> 2, epc = lane & 3;
    float ssq = 0.f;
    for (int j = 0; j < 4; ++j) {
        const int hd = 4 * gi + j;
        *(LAS u32x4*)(l + S_BM + sdir * 9216 + srow0 * S_RS + sch * 16) = sa; *(LAS u32x4*)(l + S_BM + sdir * 9216 + (srow0 + 32) * S_RS + sch * 16) = sb;
        if (j < 3) { sa = *(const u32x4*)(sp0 + (size_t)(j + 1) * 4096); sb = *(const u32x4*)(sp0 + (size_t)(j + 1) * 4096 + 32 * 64); }
        const bf16_t* zp = proj + (size_t)(r0 + 16 * w + erow) * PC + C_Z + 64 * hd + 16 * epc;
        const u32x4 z0 = *(const u32x4*)zp, z1 = *(const u32x4*)(zp + 8);
        const LAS float* DTf = (const LAS float*)(l + S_DT) + j * 128; const LAS float* DTb = DTf + 512;
        const LAS float* ACf = (const LAS float*)(l + S_AC) + j * 128; const LAS float* ACb = ACf + 512;
        const float dsk = p.d_skip[hd];
        const float Rf = ACf[16 * w], Rb = ACb[16 * w + 15];
        float rowf[4], rowb[4];
#pragma unroll
        for (int r = 0; r < 4; ++r) { const int lr = 16 * w + 4 * g + r; rowf[r] = __expf(ACf[lr] - Rf); rowb[r] = __expf(ACb[lr] - Rb); }
#pragma unroll
        for (int si = 0; si < 8; ++si) { const int s = 16 * si + ln;
            if (si < w) {
                const float colf = __expf(Rf - ACf[s]) * DTf[s];
#pragma unroll
                for (int r = 0; r < 4; ++r) { const int lr = 16 * w + 4 * g + r; *(LAS bf16_t*)(l + S_MB + lr * S_RSM + s * 2) = f2bf(cb[si][r] * rowf[r] * colf); } }
            else if (si > w) {
                const float colb = __expf(Rb - ACb[s]) * DTb[s];
#pragma unroll
                for (int r = 0; r < 4; ++r) { const int lr = 16 * w + 4 * g + r; *(LAS bf16_t*)(l + S_MB + lr * S_RSM + s * 2) = f2bf(cb[si][r] * rowb[r] * colb); } }
            else { const float afs = ACf[s], abs_ = ACb[s], dfs = DTf[s], dbs = DTb[s];
#pragma unroll
                for (int r = 0; r < 4; ++r) { const int lr = 16 * w + 4 * g + r; const bool fw = (s <= lr);
                    const float wt = __expf(fw ? ACf[lr] - afs : ACb[lr] - abs_) * (fw ? dfs : dbs);
                    const float v = cb[si][r] * wt + (s == lr ? dsk : 0.f);
                    *(LAS bf16_t*)(l + S_MB + lr * S_RSM + s * 2) = f2bf(v); } } }
        __syncthreads();
        f32x4 ay[4], af[4], ab[4];
#pragma unroll
        for (int pi = 0; pi < 4; ++pi) { ay[pi] = (f32x4){0.f, 0.f, 0.f, 0.f}; af[pi] = ay[pi]; ab[pi] = ay[pi]; }
#pragma unroll
        for (int ks = 0; ks < 4; ++ks) { const bf16x8 am = frag_row(l + S_MB, S_RSM, 16 * w, 32 * ks, lane); bf16x8 xb[4]; frag_tr4(xb, lbase + S_XS, S_RSX, 32 * ks, 64 * j, 16, lane);
#pragma unroll
            for (int pi = 0; pi < 4; ++pi) ay[pi] = MFMA16(am, xb[pi], ay[pi]); }
#pragma unroll
        for (int ks = 0; ks < 2; ++ks) { const bf16x8 ac = frag_row(l + S_CM, S_RS, 16 * w, 32 * ks, lane);
#pragma unroll
            for (int pi = 0; pi < 4; ++pi) { af[pi] = MFMA16(ac, frag_row(l + S_BM, S_RS, 16 * pi, 32 * ks, lane), af[pi]);
                ab[pi] = MFMA16(ac, frag_row(l + S_BM + 9216, S_RS, 16 * pi, 32 * ks, lane), ab[pi]); } }
#pragma unroll
        for (int r = 0; r < 4; ++r) { const int lr = 16 * w + 4 * g + r; const float ef = __expf(ACf[lr]), eb = __expf(ACb[lr]);
#pragma unroll
            for (int pi = 0; pi < 4; ++pi) *(LAS float*)(l + S_MB + lr * S_RSM + (16 * pi + ln) * 4) = ay[pi][r] + ef * af[pi][r] + eb * ab[pi][r]; }
        asm volatile("" ::: "memory");
        {   float zv[16], yv[16];
            unpack8(z0, zv); unpack8(z1, zv + 8);
            const LAS unsigned char* yp = l + S_MB + (16 * w + erow) * S_RSM + epc * 64;
#pragma unroll
            for (int q = 0; q < 4; ++q) { const f32x4 t4 = *(const LAS f32x4*)(yp + 16 * q); yv[4 * q] = t4[0]; yv[4 * q + 1] = t4[1]; yv[4 * q + 2] = t4[2]; yv[4 * q + 3] = t4[3]; }
#pragma unroll
            for (int q = 0; q < 16; ++q) { yv[q] *= siluf_(zv[q]); ssq += yv[q] * yv[q]; }
            bf16_t* yo = Y + (size_t)(r0 + 16 * w + erow) * 1024 + 64 * hd + 16 * epc;
            *(u32x4*)yo = pack8(yv); *(u32x4*)(yo + 8) = pack8(yv + 8); }
        __syncthreads();
    }
    float* rssy = (float*)(p.ws + WS_RSSY) + (size_t)row0;
    ssq += shfl_idx(ssq, lane ^ 1); ssq += shfl_idx(ssq, lane ^ 2);
    if (epc == 0) atomicAdd(rssy + r0 + 16 * w + erow, ssq);
}

template <bool GLA>
__device__ __forceinline__ void scan_job(bf16_t* base, const float* dec, int dir) {
    constexpr int NCH = GLA ? 64 : 32; constexpr size_t CST = GLA ? 65536 : 131072; constexpr int DST = GLA ? 512 : 32; constexpr int UN = 4;
    float run[8];
#pragma unroll
    for (int e = 0; e < 8; ++e) run[e] = 0.f;
    const long long cstep = dir ? -(long long)CST : (long long)CST; const int dstep = dir ? -DST : DST;
    bf16_t* bp = base + (dir ? (size_t)(NCH - 1) * CST : 0); const float* dp = dec + (dir ? (NCH - 1) * DST : 0);
    for (int c0 = 0; c0 < NCH; c0 += UN) {
        u32x4 loc[UN]; f32x4 d0[UN], d1[UN];
#pragma unroll
        for (int u = 0; u < UN; ++u) { loc[u] = *(const u32x4*)(bp + u * cstep);
            if (GLA) { d0[u] = *(const f32x4*)(dp + u * dstep); d1[u] = *(const f32x4*)(dp + u * dstep + 4); } else { const float dv = dp[u * dstep]; d0[u] = (f32x4){dv, dv, dv, dv}; d1[u] = d0[u]; } }
#pragma unroll
        for (int u = 0; u < UN; ++u) { float lv[8]; unpack8(loc[u], lv);
            *(u32x4*)(bp + u * cstep) = pack8(run);
#pragma unroll
            for (int e = 0; e < 8; ++e) run[e] = (e < 4 ? d0[u][e & 3] : d1[u][e & 3]) * run[e] + lv[e]; }
        bp += UN * cstep; dp += UN * dstep;
    }
}
__device__ __forceinline__ void phase_scan(const Params& p, int nseq, int tid) {
    const int NG = nseq * 8192, NS = nseq * 16384;
    const int gt = blockIdx.x * 512 + tid, GT = gridDim.x * 512;
    for (int job = gt; job < NG + NS; job += GT) {
        if (job < NG) { const int e8 = job & 1023, h = (job >> 10) & 3, dir = (job >> 12) & 1, seq = job >> 13;
            scan_job<true>((bf16_t*)(p.ws + WS_GS) + ((size_t)((seq * 64 * 2 + dir) * 4 + h)) * 8192 + e8 * 8, (const float*)(p.ws + WS_GDEC) + (size_t)((seq * 64 * 2 + dir) * 4 + h) * 64 + ((e8 * 8) & 63), dir);
        } else { const int j2 = job - NG, e8 = j2 & 511, hd = (j2 >> 9) & 15, dir = (j2 >> 13) & 1, seq = j2 >> 14;
            scan_job<false>((bf16_t*)(p.ws + WS_SS) + ((size_t)((seq * 32 * 2 + dir) * 16 + hd)) * 4096 + e8 * 8, (const float*)(p.ws + WS_SDEC) + (size_t)((seq * 32 * 2 + dir) * 16 + hd), dir); }
    }
}

constexpr int LDS_BYTES = 160 * 1024;
#if defined(__HIP_DEVICE_COMPILE__)
typedef const __attribute__((address_space(4))) Params* KP;
#define KPARAMS() ({ unsigned long long k_ = (unsigned long long)__builtin_amdgcn_kernarg_segment_ptr(); asm volatile("" : "+s"(k_)); *(KP)k_; })
#define KWS() ({ unsigned long long k_ = (unsigned long long)__builtin_amdgcn_kernarg_segment_ptr(); asm volatile("" : "+s"(k_)); (unsigned char*)*(const __attribute__((address_space(4))) unsigned long long*)(k_ + 26 * 8); })
#else
#define KPARAMS() (p_unused)
#define KWS() (p_unused.ws)
#endif
#define GBAR() do { XcdBarrier b_; b_.bar = (unsigned*)(KWS() + WS_BAR); b_.x = xb_xcc_id(); b_.st = (volatile LAS unsigned*)(l + LDS_BYTES - 16); xcd_barrier(b_); } while (0)
#define OTID() ({ int t_ = threadIdx.x; asm volatile("" : "+v"(t_)); t_; })

template <int hb>
__device__ __forceinline__ void half_pass(const Params& p_unused, LAS unsigned char* l, const unsigned lbase, cg::grid_group& grid, const int G, const int bx) {
        constexpr int ROW0 = PASS_ROW0[hb], NR = PASS_ROWS[hb], NSQ = PASS_SEQ[hb], NSSD = NSQ * 128, NIT = NSQ * 384;
        { const Params q = KPARAMS(); phase_u(q, ROW0, NR, OTID()); }
        if (hb == 0) grid.sync(); else GBAR();
        {
            const Params q = KPARAMS(); unsigned char* ws = q.ws; bf16_t* PROJ = (bf16_t*)(ws + WS_PROJ);
            pg8::Gemm g{(const bf16_t*)(ws + WS_U), (const bf16_t*)(ws + WS_WIN), NR, 6400, 1024}; pg8::StaticOrder S; S.init(NR, 6400, G, bx);
            EpiProj E{PROJ}; pg8::gemm_phase<EpiProj, pg8::StaticOrder, true, true>(l, g, S, E);
        }
        GBAR();
        {   GlaPF pf; const int itg0 = bx + ((NSSD - bx + G - 1) / G) * G;
            if (itg0 < NIT) { const Params p = KPARAMS(); gla_pf_load<false>(pf, p, itg0 - NSSD, OTID()); }
            for (int it = bx; it < NIT; it += G) { const Params p = KPARAMS(); const int tid = OTID(); if (it < NSSD) ssd_s1_item(p, it, l, lbase, tid); else gla_s1_item(p, it - NSSD, it + G < NIT ? it + G - NSSD : -1, pf, l, lbase, tid); }
        }
        GBAR();
        { const Params q = KPARAMS(); phase_scan(q, NSQ, OTID()); }
        GBAR();
        {   GlaPF pf; const int itg0 = bx + ((NSSD - bx + G - 1) / G) * G;
            if (itg0 < NIT) { const Params p = KPARAMS(); gla_pf_load<true>(pf, p, itg0 - NSSD, OTID()); }
            for (int it = bx; it < NIT; it += G) { const Params p = KPARAMS(); const int tid = OTID(); if (it < NSSD) ssd_s3_item(p, ROW0, it, l, lbase, tid); else gla_s3_item(p, it - NSSD, it + G < NIT ? it + G - NSSD : -1, pf, l, lbase, tid); }
        }
        GBAR();
        {
            const Params p = KPARAMS(); unsigned char* ws = p.ws; bf16_t* PROJ = (bf16_t*)(ws + WS_PROJ);
            pg8::StaticOrder S; S.init(NR, 1024, G, bx);
            pg8::Gemm g1{(const bf16_t*)(ws + WS_OG), (const bf16_t*)(ws + WS_WB1), NR, 1024, 512};
            EpiM1 E1{PROJ, (bf16_t*)(ws + WS_T)}; pg8::gemm_phase<EpiM1, pg8::StaticOrder, true, true>(l, g1, S, E1);
            pg8::Gemm g2{(const bf16_t*)(ws + WS_Y), (const bf16_t*)(ws + WS_WB2), NR, 1024, 1024};
            EpiM2 E2{PROJ, (const bf16_t*)(ws + WS_T), (bf16_t*)(ws + WS_MM), (const float*)(ws + WS_RSSY) + (size_t)ROW0}; pg8::gemm_phase<EpiM2, pg8::StaticOrder, true, true>(l, g2, S, E2);
        }
        GBAR();
        {
            const Params p = KPARAMS(); unsigned char* ws = p.ws; bf16_t* PROJ = (bf16_t*)(ws + WS_PROJ);
            pg8::StaticOrder S; S.init(NR, 1024, G, bx);
            pg8::Gemm g{(const bf16_t*)(ws + WS_MM), (const bf16_t*)(ws + WS_WOUT), NR, 1024, 1024};
            EpiOut E{p, ROW0, (bf16_t*)(ws + WS_X1B), (float*)(ws + WS_RSS1)}; pg8::gemm_phase<EpiOut, pg8::StaticOrder, true, true>(l, g, S, E);
        }
        GBAR();
        {
            const Params p = KPARAMS(); unsigned char* ws = p.ws; bf16_t* PROJ = (bf16_t*)(ws + WS_PROJ);
            pg8::StaticOrder S; S.init(NR, 5632, G, bx);
            pg8::Gemm g{(const bf16_t*)(ws + WS_X1B), (const bf16_t*)(ws + WS_WGU), NR, 5632, 1024};
            EpiSwi E{(const float*)(ws + WS_RSS1) + (size_t)ROW0, PROJ}; pg8::gemm_phase<EpiSwi, pg8::StaticOrder, true, true>(l, g, S, E);
        }
        GBAR();
        {
            const Params p = KPARAMS(); unsigned char* ws = p.ws; bf16_t* PROJ = (bf16_t*)(ws + WS_PROJ);
            pg8::StaticOrder S; S.init(NR, 1024, G, bx);
            pg8::Gemm g{(const bf16_t*)PROJ, (const bf16_t*)(ws + WS_WD), NR, 1024, DFF};
            EpiDown E{p.out, ROW0, (float*)(ws + WS_RSS2)}; pg8::gemm_phase<EpiDown, pg8::StaticOrder, true, true>(l, g, S, E);
        }
    __syncthreads();
}

__global__ void __launch_bounds__(512) mega(Params p_unused) {
    extern __shared__ __attribute__((aligned(16))) unsigned char lds_raw[];
    cg::grid_group grid = cg::this_grid();
    LAS unsigned char* l = (LAS unsigned char*)lds_raw;
    const unsigned lbase = (unsigned)(size_t)l;
    const int G = gridDim.x, bx = blockIdx.x;
    volatile LAS unsigned* xst = (volatile LAS unsigned*)(l + LDS_BYTES - 16);
    { const int t0_ = OTID(); if (t0_ < 4) xst[t0_] = 0u; }
    __syncthreads();
    (void)xcd_barrier_post((unsigned*)(KWS() + WS_BAR), xst);
    { const Params q = KPARAMS(); phase_weights(q, l, OTID()); }
    half_pass<0>(p_unused, l, lbase, grid, G, bx);
    half_pass<1>(p_unused, l, lbase, grid, G, bx);
    GBAR();
    {
        const Params p = KPARAMS(); unsigned char* ws = p.ws; const int tid = OTID();
        const float* rss2 = (const float*)(ws + WS_RSS2);
        const size_t GT = (size_t)G * 512;
        for (size_t i0 = (size_t)bx * 512 + tid; i0 < (size_t)NTOK * 256; i0 += 4 * GT) {
            f32x4 v[4]; float rs[4];
#pragma unroll
            for (int k = 0; k < 4; ++k) { const size_t i = i0 + k * GT; if (i < (size_t)NTOK * 256) { v[k] = ((const f32x4*)p.out)[i]; rs[k] = rss2[i >> 8]; } }
#pragma unroll
            for (int k = 0; k < 4; ++k) { const size_t i = i0 + k * GT; if (i < (size_t)NTOK * 256) { const float r = rsqrtf(rs[k] * (1.0f / 1024.0f) + EPS); const f32x4 w = ((const f32x4*)p.norm_final_w)[i & 255];
                f32x4 o = v[k]; o[0] *= r * w[0]; o[1] *= r * w[1]; o[2] *= r * w[2]; o[3] *= r * w[3]; ((f32x4*)p.out)[i] = o; } }
        }
    }
}

extern "C" void kernel_launch(void* const* d_in, const int* in_sizes, int n_in, void* d_out, int out_size, void* d_ws, size_t ws_size, hipStream_t stream) {
    static int grid_blocks = 0;
    if (!grid_blocks) {
        int dev = 0, cus = 0, per_cu = 0;
        (void)hipGetDevice(&dev);
        (void)hipDeviceGetAttribute(&cus, hipDeviceAttributeMultiprocessorCount, dev);
        (void)hipFuncSetAttribute((const void*)mega, hipFuncAttributeMaxDynamicSharedMemorySize, LDS_BYTES);
        (void)hipOccupancyMaxActiveBlocksPerMultiprocessor(&per_cu, (const void*)mega, 512, LDS_BYTES);
        if (per_cu < 1) per_cu = 1;
        grid_blocks = cus * per_cu;
        if (ws_size < WS_END) fprintf(stderr, "workspace too small: %zu < %zu\n", ws_size, (size_t)WS_END);
    }
    Params p{};
    const float** pp = (const float**)&p;
    for (int i = 0; i < 25; ++i) pp[i] = (const float*)d_in[i];
    p.out = (float*)d_out; p.ws = (unsigned char*)d_ws;
    (void)hipMemsetAsync((unsigned char*)d_ws + WS_BAR, 0, (size_t)XCD_BAR_WORDS_ * 4, stream);
    void* args[] = {&p};
    hipError_t e = hipLaunchCooperativeKernel((const void*)mega, dim3(grid_blocks), dim3(512), args, LDS_BYTES, stream);
    if (e != hipSuccess) fprintf(stderr, "cooperative launch failed: %s (grid %d)\n", hipGetErrorString(e), grid_blocks);
}
```

```cpp
#include <hip/hip_runtime.h>
#include <hip/hip_cooperative_groups.h>
#include <cstdio>
namespace cg = cooperative_groups;

namespace pg8 {
#define PG8_LAS __attribute__((address_space(3)))
typedef unsigned short bf16_t;
typedef short bf16x8 __attribute__((ext_vector_type(8)));
typedef float f32x4 __attribute__((ext_vector_type(4)));
typedef unsigned u32x4 __attribute__((ext_vector_type(4)));
constexpr int BM = 256, BK = 64, HALF = 128, HTB = HALF * BK * 2  , STAGE_BYTES = 8 * HTB, NXCD = 8, WGM = 8;

__host__ __device__ __forceinline__ int lds_byte(int r, int c) { const int st = (r >> 4) * 2 + (c >> 5), rr = r & 15, cc = c & 31, ob = rr * 64 + cc * 2; return st * 1024 + (ob ^ (((ob >> 9) & 1) << 5)); }
__host__ __device__ __forceinline__ void stage_rc(int b, int& R, int& C) { const int st = b / 1024, sb = b % 1024, swz = sb ^ (((sb >> 9) & 1) << 5); R = (st >> 1) * 16 + swz / 64; C = (st & 1) * 32 + (swz % 64) / 2; }
__host__ __device__ __forceinline__ int perm32(int rho) { const int n = rho >> 4, i = rho & 15; return 8 * (i >> 2) + 4 * n + (i & 3); }

struct Unit { int pm, pn; };
struct Gemm { const bf16_t* A; const bf16_t* Bt; int M, N, K; };

struct StaticOrder {
    int nM, nN, nwg, G, c;
    __host__ __device__ void init(int M, int N, int G_, int c_) { nM = M / BM; nN = N / BM; nwg = nM * nN; G = G_; c = c_; }
    __host__ __device__ bool next(int i, Unit& u) const {
        const long L = (long)i * G + c; if (L >= nwg) return false;
        int wgid = (int)L; { const int q = nwg / NXCD, r = nwg % NXCD, xcd = wgid % NXCD, off = wgid / NXCD; wgid = (xcd < r ? xcd * (q + 1) : r * (q + 1) + (xcd - r) * q) + off; }
        const int nig = WGM * nN, gid = wgid / nig, fm = gid * WGM, gsz = (nM - fm) < WGM ? (nM - fm) : WGM;
        u.pm = fm + ((wgid % nig) % gsz); u.pn = (wgid % nig) / gsz; return true;
    }
    __device__ __forceinline__ void a_ready(const Unit&) const {}
    __device__ __forceinline__ void done(const Unit&) const {}
};
typedef float f32x2_t_ __attribute__((ext_vector_type(2)));
typedef __bf16 bf16x2_t_ __attribute__((ext_vector_type(2)));
__device__ __forceinline__ unsigned cvt_pk_bf16(float lo, float hi) { const f32x2_t_ v = {lo, hi}; const bf16x2_t_ b = __builtin_convertvector(v, bf16x2_t_); return __builtin_bit_cast(unsigned, b); }
template <class Epi, class Sched, bool ALIGN_EPI = false, bool SP2 = false>
__device__ __forceinline__ void gemm_phase(PG8_LAS unsigned char* lds, const Gemm g, const Sched& S, const Epi& E) {
    int tid_ = threadIdx.x; asm volatile("" : "+v"(tid_)); const int tid = tid_, wid = __builtin_amdgcn_readfirstlane(tid >> 6), lane = tid & 63, wr = wid >> 2, wc = wid & 3, fr = lane & 15, fq = lane >> 4;
    const int K = g.K, nt = K / BK;
    unsigned voffA[2], voffB[2];
#pragma unroll
    for (int i = 0; i < 2; ++i) { int R, C; stage_rc(tid * 16 + i * 8192, R, C); const int Rb = Epi::PERM ? ((R & ~31) + perm32(R & 31)) : R;
        voffA[i] = (unsigned)(R * K + C) * 2u; voffB[i] = (unsigned)(Rb * K + C) * 2u; }
    const size_t kstep = (size_t)(BK * 2);
    const size_t hstep = (size_t)HALF * K * 2;
    const size_t tstep = 2 * hstep;
    const unsigned ldsw = (unsigned)wid * 1024u;
    const int aoff = lds_byte(wr * 64 + fr, fq * 8), boff = lds_byte(wc * 32 + fr, fq * 8);
#define PG8_SA(b, h) (((b) * 2 + (h)) * HTB)
#define PG8_SB(b, h) ((4 + (b) * 2 + (h)) * HTB)
#define PG8_STAGE(bufoff, gbase, voff) do { _Pragma("unroll") for (int _i = 0; _i < 2; ++_i) \
        __builtin_amdgcn_global_load_lds((const unsigned*)((const char*)(gbase) + (voff)[_i]), (PG8_LAS unsigned*)(lds + (bufoff) + ldsw + _i * 8192), 16, 0, 0); } while (0)
#define PG8_LDA(dst, b, h) do { _Pragma("unroll") for (int m = 0; m < 4; ++m) _Pragma("unroll") for (int k = 0; k < 2; ++k) dst[m][k] = *(const PG8_LAS bf16x8*)(lds + PG8_SA(b, h) + aoff + m * 2048 + k * 1024); } while (0)
#define PG8_LDB(dst, b, h) do { _Pragma("unroll") for (int n = 0; n < 2; ++n) _Pragma("unroll") for (int k = 0; k < 2; ++k) dst[n][k] = *(const PG8_LAS bf16x8*)(lds + PG8_SB(b, h) + boff + n * 2048 + k * 1024); } while (0)
#define PG8_MMA(ai, bj, At, Bt) do { __builtin_amdgcn_s_setprio(1); _Pragma("unroll") for (int m = 0; m < 4; ++m) _Pragma("unroll") for (int n = 0; n < 2; ++n) _Pragma("unroll") for (int k = 0; k < 2; ++k) \
        acc[ai][bj][m][n] = __builtin_amdgcn_mfma_f32_16x16x32_bf16(Bt[n][k], At[m][k], acc[ai][bj][m][n], 0, 0, 0); __builtin_amdgcn_s_setprio(0); } while (0)
#define PG8_WAIT_V(n) asm volatile("s_waitcnt vmcnt(" #n ")" ::: "memory")
#define PG8_WAIT_L(n) asm volatile("s_waitcnt lgkmcnt(" #n ")" ::: "memory")
#define PG8_BAR __builtin_amdgcn_s_barrier()
#define PG8_SCHED __builtin_amdgcn_sched_barrier(0)
    Unit cur, nxt; int ui = 0;
    if (!S.next(0, cur)) return;
    f32x4 acc[2][2][4][2];
#pragma unroll
    for (int a = 0; a < 2; ++a)
#pragma unroll
        for (int b = 0; b < 2; ++b)
#pragma unroll
            for (int m = 0; m < 4; ++m)
#pragma unroll
                for (int n = 0; n < 2; ++n) acc[a][b][m][n] = (f32x4){0.f, 0.f, 0.f, 0.f};
    bf16x8 At[4][2], B0[2][2], B1[2][2];
    const char* cA = (const char*)g.A + (size_t)cur.pm * tstep; const char* cB = (const char*)g.Bt + (size_t)cur.pn * tstep;
    S.a_ready(cur);
    if constexpr (SP2) {
        PG8_STAGE(PG8_SB(0, 0), cB, voffB); PG8_STAGE(PG8_SB(0, 1), cB + hstep, voffB); PG8_STAGE(PG8_SA(0, 0), cA, voffA); PG8_STAGE(PG8_SA(0, 1), cA + hstep, voffA);
        if (wr == 1) PG8_BAR;
        PG8_WAIT_V(2); PG8_BAR;
        PG8_STAGE(PG8_SB(1, 0), cB + kstep, voffB); PG8_STAGE(PG8_SA(1, 0), cA + kstep, voffA); PG8_STAGE(PG8_SB(1, 1), cB + hstep + kstep, voffB);
        PG8_WAIT_V(6); PG8_BAR;
    } else {
        PG8_STAGE(PG8_SB(0, 0), cB, voffB); PG8_STAGE(PG8_SA(0, 0), cA, voffA); PG8_STAGE(PG8_SB(0, 1), cB + hstep, voffB); PG8_STAGE(PG8_SA(0, 1), cA + hstep, voffA);
        if (wr == 1) PG8_BAR;
        PG8_WAIT_V(4); PG8_BAR;
        PG8_STAGE(PG8_SB(1, 0), cB + kstep, voffB); PG8_STAGE(PG8_SA(1, 0), cA + kstep, voffA); PG8_STAGE(PG8_SB(1, 1), cB + hstep + kstep, voffB);
        PG8_WAIT_V(6); PG8_BAR;
    }
    for (;;) {
        const bool has_next = S.next(ui + 1, nxt);
        const char* nA = has_next ? (const char*)g.A + (size_t)nxt.pm * tstep : cA; const char* nB = has_next ? (const char*)g.Bt + (size_t)nxt.pn * tstep : cB;
        for (int t = 0; t < nt; t += 2) {
            const bool last = (t == nt - 2);
            const char* a1 = cA + (size_t)(t + 1) * kstep;
            const char* a2 = last ? nA : cA + (size_t)(t + 2) * kstep; const char* b2 = last ? nB : cB + (size_t)(t + 2) * kstep;
            const char* a3 = a2 + kstep; const char* b3 = b2 + kstep;
            if (last && has_next) S.a_ready(nxt);
            if constexpr (SP2) {
            PG8_LDB(B0, 0, 0); PG8_LDB(B1, 0, 1); PG8_SCHED; PG8_LDA(At, 0, 0); PG8_STAGE(PG8_SA(1, 1), a1 + hstep, voffA);
            PG8_WAIT_V(8); PG8_WAIT_L(0); PG8_BAR; PG8_MMA(0, 0, At, B0); PG8_MMA(0, 1, At, B1); PG8_BAR; PG8_SCHED;
            PG8_LDA(At, 0, 1); PG8_STAGE(PG8_SB(0, 0), b2, voffB); PG8_STAGE(PG8_SB(0, 1), b2 + hstep, voffB); PG8_STAGE(PG8_SA(0, 0), a2, voffA);
            PG8_WAIT_V(8); PG8_WAIT_L(0); PG8_BAR; PG8_MMA(1, 0, At, B0); PG8_MMA(1, 1, At, B1); PG8_BAR; PG8_SCHED;
            PG8_LDB(B0, 1, 0); PG8_LDB(B1, 1, 1); PG8_SCHED; PG8_LDA(At, 1, 0); PG8_STAGE(PG8_SA(0, 1), a2 + hstep, voffA);
            PG8_WAIT_V(8); PG8_WAIT_L(0); PG8_BAR; PG8_MMA(0, 0, At, B0); PG8_MMA(0, 1, At, B1); PG8_BAR; PG8_SCHED;
            PG8_LDA(At, 1, 1); PG8_STAGE(PG8_SB(1, 0), b3, voffB); PG8_STAGE(PG8_SB(1, 1), b3 + hstep, voffB); PG8_STAGE(PG8_SA(1, 0), a3, voffA);
            PG8_WAIT_V(8); PG8_WAIT_L(0); PG8_BAR; PG8_MMA(1, 0, At, B0); PG8_MMA(1, 1, At, B1); PG8_BAR; PG8_SCHED;
            } else {
            PG8_LDB(B0, 0, 0); PG8_SCHED; PG8_LDA(At, 0, 0); PG8_STAGE(PG8_SA(1, 1), a1 + hstep, voffA);
            PG8_WAIT_L(8); PG8_BAR; PG8_WAIT_L(0); PG8_MMA(0, 0, At, B0); PG8_BAR; PG8_SCHED;
            PG8_LDB(B1, 0, 1); PG8_STAGE(PG8_SB(0, 0), b2, voffB);
            PG8_BAR; PG8_WAIT_L(0); PG8_MMA(0, 1, At, B1); PG8_BAR;
            PG8_LDA(At, 0, 1); PG8_STAGE(PG8_SA(0, 0), a2, voffA);
            PG8_BAR; PG8_WAIT_L(0); PG8_MMA(1, 0, At, B0); PG8_BAR; PG8_SCHED;
            PG8_STAGE(PG8_SB(0, 1), b2 + hstep, voffB);
            PG8_WAIT_V(6); PG8_BAR; PG8_MMA(1, 1, At, B1); PG8_BAR;
            PG8_LDB(B0, 1, 0); PG8_SCHED; PG8_LDA(At, 1, 0); PG8_STAGE(PG8_SA(0, 1), a2 + hstep, voffA);
            PG8_WAIT_L(8); PG8_BAR; PG8_WAIT_L(0); PG8_MMA(0, 0, At, B0); PG8_BAR; PG8_SCHED;
            PG8_LDB(B1, 1, 1); PG8_STAGE(PG8_SB(1, 0), b3, voffB);
            PG8_BAR; PG8_WAIT_L(0); PG8_MMA(0, 1, At, B1); PG8_BAR;
            PG8_LDA(At, 1, 1); PG8_STAGE(PG8_SA(1, 0), a3, voffA);
            PG8_BAR; PG8_WAIT_L(0); PG8_MMA(1, 0, At, B0); PG8_BAR; PG8_SCHED;
            PG8_STAGE(PG8_SB(1, 1), b3 + hstep, voffB);
            PG8_WAIT_V(6); PG8_BAR; PG8_MMA(1, 1, At, B1); PG8_BAR;
            }
        }
        if constexpr (ALIGN_EPI) { if (wr == 0) PG8_BAR; }
        if constexpr (!Epi::AFTER_DRAIN) { E(acc, cur, wr, wc, fr, fq); S.done(cur); }
        if (!has_next) break;
#pragma unroll
        for (int a = 0; a < 2; ++a)
#pragma unroll
            for (int b = 0; b < 2; ++b)
#pragma unroll
                for (int m = 0; m < 4; ++m)
#pragma unroll
                    for (int n = 0; n < 2; ++n) acc[a][b][m][n] = (f32x4){0.f, 0.f, 0.f, 0.f};
        cur = nxt; cA = nA; cB = nB; ++ui;
        if constexpr (ALIGN_EPI) { if (wr == 1) PG8_BAR; }
    }
    PG8_WAIT_V(0);
    if constexpr (!ALIGN_EPI) { if (wr == 0) PG8_BAR; }
    PG8_BAR;
    if constexpr (Epi::AFTER_DRAIN) { E.fused(acc, cur, wr, wc, fr, fq, lds, wid, lane); S.done(cur); }
#undef PG8_SA
#undef PG8_SB
#undef PG8_STAGE
#undef PG8_LDA
#undef PG8_LDB
#undef PG8_MMA
#undef PG8_WAIT_V
#undef PG8_WAIT_L
#undef PG8_BAR
#undef PG8_SCHED
}
}


#define LAS __attribute__((address_space(3)))
typedef unsigned short bf16_t;
typedef short bf16x8 __attribute__((ext_vector_type(8)));
typedef float f32x4 __attribute__((ext_vector_type(4)));
typedef unsigned u32x4 __attribute__((ext_vector_type(4)));
typedef unsigned u32x2 __attribute__((ext_vector_type(2)));
typedef unsigned short u16x4 __attribute__((ext_vector_type(4)));
using pg8::cvt_pk_bf16;

constexpr int DM = 1024, NTOK = 81920, MH = 49152  , NSEQH = 12, NPTOK = 16384, PC = 6208, DFF = 2816;
constexpr int PASS_ROW0[2] = {0, 49152}, PASS_ROWS[2] = {49152, 32768}, PASS_SEQ[2] = {12, 8};
constexpr int C_Q = 0, C_K = 256, C_V = 512, C_OG = 1024, C_RF = 1536, C_Z = 1568, C_XBC = 2592, C_BM = 3616, C_CM = 3872, C_DTF = 4128, C_DTB = 4144, C_G1 = 4160, C_G2 = 5184;
constexpr float EPS = 1e-6f;
constexpr int XCD_BAR_WORDS_ = 3456;

constexpr size_t WS_WIN = 0;
constexpr size_t WS_WB1 = WS_WIN + (size_t)6400 * 1024 * 2;
constexpr size_t WS_WB2 = WS_WB1 + (size_t)1024 * 512 * 2;
constexpr size_t WS_WOUT = WS_WB2 + (size_t)1024 * 1024 * 2;
constexpr size_t WS_WGU = WS_WOUT + (size_t)1024 * 1024 * 2;
constexpr size_t WS_WD = WS_WGU + (size_t)5632 * 1024 * 2;
constexpr size_t WS_RSS1 = WS_WD + (size_t)1024 * 2816 * 2;
constexpr size_t WS_RSS2 = WS_RSS1 + (size_t)NTOK * 4;
constexpr size_t WS_RSSY = WS_RSS2 + (size_t)NTOK * 4;
constexpr size_t WS_GDEC = WS_RSSY + (size_t)NTOK * 4;
constexpr size_t WS_SDEC = WS_GDEC + (size_t)NSEQH * 64 * 2 * 4 * 64 * 4;
constexpr size_t WS_PROJ = WS_SDEC + (size_t)NSEQH * 32 * 2 * 16 * 4;
constexpr size_t WS_U = WS_PROJ + (size_t)MH * PC * 2;
constexpr size_t WS_OG = WS_U;
constexpr size_t WS_Y = WS_U + (size_t)MH * 512 * 2;
constexpr size_t WS_ST = WS_U + (size_t)MH * 1536 * 2;
constexpr size_t WS_GS = WS_ST;
constexpr size_t WS_SS = WS_ST + (size_t)MH * 2048;
constexpr size_t WS_T = WS_ST;
constexpr size_t WS_MM = WS_ST + (size_t)MH * 2048;
constexpr size_t WS_X1B = WS_U;
constexpr size_t WS_BAR = WS_ST + (size_t)MH * 4096;
constexpr size_t WS_LG = WS_BAR + 16384;
constexpr size_t WS_END = WS_LG + (size_t)NSEQH * 256 * 8192 * 2;
static_assert(WS_PROJ % 256 == 0 && WS_U % 256 == 0 && WS_ST % 256 == 0 && WS_END < (size_t)1070 * 1000 * 1000, "ws map");

struct Params {
    const float* xp; const float* xs; const float* norm_mix_w; const float* w_in; const float* gla_up_f; const float* gla_bias_f; const float* gla_up_b; const float* gla_bias_b;
    const float* gla_norm_w; const float* conv_w; const float* conv_b; const float* dt_bias_f; const float* dt_bias_b; const float* a_log_f; const float* a_log_b; const float* d_skip;
    const float* ssm_norm_w; const float* w_br_gla; const float* w_br_ssm; const float* w_out; const float* norm_ffn_w; const float* w_ffn_gate; const float* w_ffn_up; const float* w_ffn_down;
    const float* norm_final_w; float* out; unsigned char* ws;
};

__device__ __forceinline__ float bf2f(unsigned short b) { return __uint_as_float(((unsigned)b) << 16); }
__device__ __forceinline__ float bflo(unsigned u) { return __uint_as_float(u << 16); }
__device__ __forceinline__ float bfhi(unsigned u) { return __uint_as_float(u & 0xffff0000u); }
__device__ __forceinline__ unsigned short f2bf(float f) { return (unsigned short)(cvt_pk_bf16(f, 0.f) & 0xffffu); }
__device__ __forceinline__ float sigmoidf_(float x) { return __builtin_amdgcn_rcpf(1.0f + __expf(-x)); }
__device__ __forceinline__ float siluf_(float x) { return x * __builtin_amdgcn_rcpf(1.0f + __expf(-x)); }
__device__ __forceinline__ float softplusf_(float x) { return fmaxf(x, 0.f) + log1pf(__expf(-fabsf(x))); }
__device__ __forceinline__ const float* xrow(const Params& p, int grow) { return grow < NPTOK ? p.xp + (size_t)grow * DM : p.xs + (size_t)(grow - NPTOK) * DM; }
__device__ __forceinline__ void unpack8(const u32x4 v, float* o) { o[0] = bflo(v.x); o[1] = bfhi(v.x); o[2] = bflo(v.y); o[3] = bfhi(v.y); o[4] = bflo(v.z); o[5] = bfhi(v.z); o[6] = bflo(v.w); o[7] = bfhi(v.w); }
__device__ __forceinline__ u32x4 pack8(const float* o) { u32x4 w; w.x = cvt_pk_bf16(o[0], o[1]); w.y = cvt_pk_bf16(o[2], o[3]); w.z = cvt_pk_bf16(o[4], o[5]); w.w = cvt_pk_bf16(o[6], o[7]); return w; }
__device__ __forceinline__ float shfl_idx(float x, int src_lane) { return __int_as_float(__builtin_amdgcn_ds_bpermute(src_lane << 2, __float_as_int(x))); }
__device__ __forceinline__ float bcast_lane63(float x) { return __int_as_float(__builtin_amdgcn_readlane(__float_as_int(x), 63)); }
template <int N> __device__ __forceinline__ float dpp_row_shr(float x) { return __int_as_float(__builtin_amdgcn_update_dpp(0, __float_as_int(x), 0x110 + N, 0xf, 0xf, true)); }
__device__ __forceinline__ float wave_incl_scan_tot(float x, int lane, float& tot) {
    x += dpp_row_shr<1>(x); x += dpp_row_shr<2>(x); x += dpp_row_shr<4>(x); x += dpp_row_shr<8>(x);
    const float t0 = __int_as_float(__builtin_amdgcn_readlane(__float_as_int(x), 15)), t1 = __int_as_float(__builtin_amdgcn_readlane(__float_as_int(x), 31));
    const float t2 = __int_as_float(__builtin_amdgcn_readlane(__float_as_int(x), 47)), t3 = __int_as_float(__builtin_amdgcn_readlane(__float_as_int(x), 63));
    const int row = lane >> 4;
    const float add = (row >= 1 ? t0 : 0.f) + (row >= 2 ? t1 : 0.f) + (row >= 3 ? t2 : 0.f);
    tot = (t0 + t1) + (t2 + t3);
    return x + add;
}
__device__ __forceinline__ bf16x8 frag_row(const LAS unsigned char* base, int RS, int row0, int k0, int lane) {
    return *(const LAS bf16x8*)(base + (row0 + (lane & 15)) * RS + (k0 + 8 * (lane >> 4)) * 2);
}
__device__ __forceinline__ bf16x8 frag_tr(unsigned base_addr, int RS, int k0, int c0, int lane) {
    const int g = lane >> 4, q = (lane & 15) >> 2, pp = lane & 3;
    const unsigned a0 = base_addr + (unsigned)((k0 + 8 * g + q) * RS + (c0 + 4 * pp) * 2), a1 = a0 + 4u * (unsigned)RS;
    u16x4 lo, hi;
    asm volatile("ds_read_b64_tr_b16 %0, %2\n\tds_read_b64_tr_b16 %1, %3\n\ts_waitcnt lgkmcnt(0)" : "=&v"(lo), "=&v"(hi) : "v"(a0), "v"(a1) : "memory");
    bf16x8 r; r[0] = (short)lo[0]; r[1] = (short)lo[1]; r[2] = (short)lo[2]; r[3] = (short)lo[3]; r[4] = (short)hi[0]; r[5] = (short)hi[1]; r[6] = (short)hi[2]; r[7] = (short)hi[3];
    return r;
}
#define MFMA16(a, b, c) __builtin_amdgcn_mfma_f32_16x16x32_bf16(a, b, c, 0, 0, 0)
__device__ __forceinline__ void frag_tr4(bf16x8 (&r)[4], unsigned base_addr, int RS, int k0, int c0, int cstep, int lane) {
    const int g = lane >> 4, q = (lane & 15) >> 2, pp = lane & 3;
    const unsigned a0 = base_addr + (unsigned)((k0 + 8 * g + q) * RS + (c0 + 4 * pp) * 2), a1 = a0 + 4u * (unsigned)RS; const unsigned cs = (unsigned)cstep * 2u;
    u16x4 lo[4], hi[4];
#pragma unroll
    for (int i = 0; i < 4; ++i) { asm volatile("ds_read_b64_tr_b16 %0, %1" : "=&v"(lo[i]) : "v"(a0 + cs * i) : "memory"); asm volatile("ds_read_b64_tr_b16 %0, %1" : "=&v"(hi[i]) : "v"(a1 + cs * i) : "memory"); }
    asm volatile("s_waitcnt lgkmcnt(0)" : "+v"(lo[0]), "+v"(lo[1]), "+v"(lo[2]), "+v"(lo[3]), "+v"(hi[0]), "+v"(hi[1]), "+v"(hi[2]), "+v"(hi[3]) :: "memory");
#pragma unroll
    for (int i = 0; i < 4; ++i) { r[i][0] = (short)lo[i][0]; r[i][1] = (short)lo[i][1]; r[i][2] = (short)lo[i][2]; r[i][3] = (short)lo[i][3]; r[i][4] = (short)hi[i][0]; r[i][5] = (short)hi[i][1]; r[i][6] = (short)hi[i][2]; r[i][7] = (short)hi[i][3]; }
}


#define XB_TMO      128
#define XB_XCNT(j)  (256  + 64 * (j))
#define XB_XSUB(j)  (1280 + 64 * (j))
#define XB_XGEN(j)  (2304 + 64 * (j))
#define XB_TOP      3328
#define XB_TOPGEN   3392
#define XCD_BAR_WORDS 3456
#define XB_SPIN_CAP (1u << 18)

__device__ __forceinline__ unsigned xb_tid() { unsigned t_ = threadIdx.x; asm volatile("" : "+v"(t_)); return t_; }
__device__ __forceinline__ unsigned xb_ld(unsigned* p)              { return __hip_atomic_load(p, __ATOMIC_RELAXED, __HIP_MEMORY_SCOPE_AGENT); }
__device__ __forceinline__ unsigned xb_add(unsigned* p, unsigned v) { return __hip_atomic_fetch_add(p, v, __ATOMIC_RELAXED, __HIP_MEMORY_SCOPE_AGENT); }
__device__ __forceinline__ unsigned xb_xcc_id() { return (unsigned)__builtin_amdgcn_s_getreg((3 << 11) | 20) & 0xFu; }
#define XB_SPIN(cond, bar) do { unsigned _sp = 0; while (cond) { __builtin_amdgcn_s_sleep(1); \
    if ((++_sp & 255u) == 0u) { if (xb_ld(&(bar)[XB_TMO])) break; if (_sp > XB_SPIN_CAP) { atomicAdd(&(bar)[XB_TMO], 1u); break; } } } } while (0)

struct XcdBarrier {
    unsigned* bar; unsigned x;
    volatile LAS unsigned* st;
};

__device__ __forceinline__ XcdBarrier xcd_barrier_post(unsigned* bar, volatile LAS unsigned* st) {
    XcdBarrier b; b.bar = bar; b.x = xb_xcc_id(); b.st = st;
    if (xb_tid() == 0) (void)xb_add(&bar[XB_XCNT(b.x)], 1u);
    return b;
}
__device__ __forceinline__ void xcd_barrier_complete(unsigned* bar, unsigned x, unsigned& nloc, unsigned& nx) {
    const unsigned G = gridDim.x * gridDim.y * gridDim.z;
    unsigned sum, cnt, mine, sp = 0u;
    for (;;) {
        sum = 0u; cnt = 0u; mine = 0u;
#pragma unroll
        for (unsigned j = 0; j < 16; ++j) { const unsigned c = xb_ld(&bar[XB_XCNT(j)]); sum += c; cnt += (c > 0u) ? 1u : 0u; mine = (j == x) ? c : mine; }
        if (sum == G) break;
        __builtin_amdgcn_s_sleep(1);
        if ((++sp & 255u) == 0u) { if (xb_ld(&bar[XB_TMO])) break; if (sp > XB_SPIN_CAP) { atomicAdd(&bar[XB_TMO], 1u); break; } }
    }
    nloc = mine > 0u ? mine : 1u; nx = cnt > 0u ? cnt : 1u;
}

__device__ __forceinline__ void xcd_barrier(const XcdBarrier& b) {
    asm volatile("s_waitcnt vmcnt(0)" ::: "memory");
    __syncthreads();
    if (xb_tid() == 0) {
        unsigned* bar = b.bar;
        __builtin_amdgcn_s_waitcnt(0);
        unsigned nloc = b.st[0], nx = b.st[1];
        if (nloc == 0u) { xcd_barrier_complete(bar, b.x, nloc, nx); b.st[0] = nloc; b.st[1] = nx; }
        const unsigned old = xb_add(&bar[XB_XSUB(b.x)], 1u);
        const unsigned gen = old / nloc;
        if (old + 1u == (gen + 1u) * nloc) {
            __builtin_amdgcn_fence(__ATOMIC_RELEASE, "agent");
            asm volatile("s_waitcnt vmcnt(0)" ::: "memory");
            const unsigned og = xb_add(&bar[XB_TOP], 1u);
            const unsigned tg = og / nx;
            if (og + 1u == (tg + 1u) * nx) xb_add(&bar[XB_TOPGEN], 1u);
            else XB_SPIN(xb_ld(&bar[XB_TOPGEN]) == tg, bar);
            __builtin_amdgcn_fence(__ATOMIC_ACQUIRE, "agent");
            xb_add(&bar[XB_XGEN(b.x)], 1u);
            asm volatile("s_waitcnt vmcnt(0)" ::: "memory");
        } else {
            XB_SPIN(xb_ld(&bar[XB_XGEN(b.x)]) == gen, bar);
            __builtin_amdgcn_fence(__ATOMIC_ACQUIRE, "agent");
            asm volatile("s_waitcnt vmcnt(0)" ::: "memory");
        }
    }
    __syncthreads();
}

struct EpiProj {
    static constexpr bool PERM = true, AFTER_DRAIN = false;
    bf16_t* O;
    __device__ __forceinline__ void operator()(const f32x4 (&acc)[2][2][4][2], const pg8::Unit& u, int wr, int wc, int fr, int fq) const {
        const int row0 = u.pm * 256 + wr * 64 + fr, col0 = u.pn * 256 + wc * 32 + 8 * fq;
#pragma unroll
        for (int ai = 0; ai < 2; ++ai)
#pragma unroll
            for (int m = 0; m < 4; ++m) { bf16_t* rowp = O + (size_t)(row0 + ai * 128 + m * 16) * PC;
#pragma unroll
                for (int bj = 0; bj < 2; ++bj) { const int c = col0 + bj * 128; const f32x4 v0 = acc[ai][bj][m][0], v1 = acc[ai][bj][m][1];
                    u32x4 w; w.x = cvt_pk_bf16(v0[0], v0[1]); w.y = cvt_pk_bf16(v0[2], v0[3]); w.z = cvt_pk_bf16(v1[0], v1[1]); w.w = cvt_pk_bf16(v1[2], v1[3]);
                    if (c < PC) *(u32x4*)(rowp + c) = w; } }
    }
};
struct EpiM1 {
    static constexpr bool PERM = true, AFTER_DRAIN = false;
    const bf16_t* proj; bf16_t* T;
    __device__ __forceinline__ void operator()(const f32x4 (&acc)[2][2][4][2], const pg8::Unit& u, int wr, int wc, int fr, int fq) const {
        const int row0 = u.pm * 256 + wr * 64 + fr, col0 = u.pn * 256 + wc * 32 + 8 * fq;
#pragma unroll
        for (int ai = 0; ai < 2; ++ai) {
            u32x4 gq[4][2];
#pragma unroll
            for (int m = 0; m < 4; ++m)
#pragma unroll
                for (int bj = 0; bj < 2; ++bj) gq[m][bj] = *(const u32x4*)(proj + (size_t)(row0 + ai * 128 + m * 16) * PC + C_G1 + col0 + bj * 128);
#pragma unroll
            for (int m = 0; m < 4; ++m) { const int row = row0 + ai * 128 + m * 16;
#pragma unroll
                for (int bj = 0; bj < 2; ++bj) { const int c = col0 + bj * 128; float gv[8], o[8];
                    unpack8(gq[m][bj], gv);
#pragma unroll
                    for (int j = 0; j < 8; ++j) o[j] = sigmoidf_(gv[j]) * acc[ai][bj][m][j >> 2][j & 3];
                    *(u32x4*)(T + (size_t)row * DM + c) = pack8(o); } }
        }
    }
};
struct EpiM2 {
    static constexpr bool PERM = true, AFTER_DRAIN = false;
    const bf16_t* proj; const bf16_t* T; bf16_t* MMo; const float* rssy;
    __device__ __forceinline__ void operator()(const f32x4 (&acc)[2][2][4][2], const pg8::Unit& u, int wr, int wc, int fr, int fq) const {
        const int row0 = u.pm * 256 + wr * 64 + fr, col0 = u.pn * 256 + wc * 32 + 8 * fq;
#pragma unroll
        for (int ai = 0; ai < 2; ++ai)
#pragma unroll
            for (int mh = 0; mh < 2; ++mh) {
                u32x4 gq[2][2], tq[2][2]; float rsv[2];
#pragma unroll
                for (int mm = 0; mm < 2; ++mm) { const int row = row0 + ai * 128 + (2 * mh + mm) * 16; rsv[mm] = rssy[row];
#pragma unroll
                    for (int bj = 0; bj < 2; ++bj) { const int c = col0 + bj * 128; gq[mm][bj] = *(const u32x4*)(proj + (size_t)row * PC + C_G2 + c); tq[mm][bj] = *(const u32x4*)(T + (size_t)row * DM + c); } }
#pragma unroll
                for (int mm = 0; mm < 2; ++mm) { const int m = 2 * mh + mm, row = row0 + ai * 128 + m * 16; const float rs = rsqrtf(rsv[mm] * (1.0f / 1024.0f) + EPS);
#pragma unroll
                    for (int bj = 0; bj < 2; ++bj) { const int c = col0 + bj * 128; float gv[8], tv[8], o[8];
                        unpack8(gq[mm][bj], gv); unpack8(tq[mm][bj], tv);
#pragma unroll
                        for (int j = 0; j < 8; ++j) o[j] = tv[j] + sigmoidf_(gv[j]) * rs * acc[ai][bj][m][j >> 2][j & 3];
                        *(u32x4*)(MMo + (size_t)row * DM + c) = pack8(o); } }
            }
    }
};
struct EpiOut {
    static constexpr bool PERM = true, AFTER_DRAIN = false;
    Params p; int grow0; bf16_t* X1B; float* rss;
    __device__ __forceinline__ void operator()(const f32x4 (&acc)[2][2][4][2], const pg8::Unit& u, int wr, int wc, int fr, int fq) const {
        const int row0 = u.pm * 256 + wr * 64 + fr, col0 = u.pn * 256 + wc * 32 + 8 * fq, ln_ = fq * 16 + fr;
#pragma unroll
        for (int ai = 0; ai < 2; ++ai)
#pragma unroll
            for (int mh = 0; mh < 2; ++mh) {
                f32x4 xa[2][2][2];
#pragma unroll
                for (int mm = 0; mm < 2; ++mm) { const float* xr = xrow(p, grow0 + row0 + ai * 128 + (2 * mh + mm) * 16);
#pragma unroll
                    for (int bj = 0; bj < 2; ++bj) { xa[mm][bj][0] = *(const f32x4*)(xr + col0 + bj * 128); xa[mm][bj][1] = *(const f32x4*)(xr + col0 + bj * 128 + 4); } }
#pragma unroll
                for (int mm = 0; mm < 2; ++mm) { const int m = 2 * mh + mm, row = row0 + ai * 128 + m * 16, grow = grow0 + row; float* orow = p.out + (size_t)grow * DM; float ss = 0.f;
#pragma unroll
                    for (int bj = 0; bj < 2; ++bj) { const int c = col0 + bj * 128;
                        const f32x4 a = xa[mm][bj][0] + acc[ai][bj][m][0], b = xa[mm][bj][1] + acc[ai][bj][m][1];
                        *(f32x4*)(orow + c) = a; *(f32x4*)(orow + c + 4) = b;
                        ss += a[0] * a[0] + a[1] * a[1] + a[2] * a[2] + a[3] * a[3] + b[0] * b[0] + b[1] * b[1] + b[2] * b[2] + b[3] * b[3];
                        u32x4 w; w.x = cvt_pk_bf16(a[0], a[1]); w.y = cvt_pk_bf16(a[2], a[3]); w.z = cvt_pk_bf16(b[0], b[1]); w.w = cvt_pk_bf16(b[2], b[3]);
                        *(u32x4*)(X1B + (size_t)row * DM + c) = w; }
                    ss += shfl_idx(ss, ln_ ^ 16); ss += shfl_idx(ss, ln_ ^ 32);
                    if (fq == 0) atomicAdd(rss + grow, ss); }
            }
    }
};
struct EpiSwi {
    static constexpr bool PERM = true, AFTER_DRAIN = false;
    const float* rss; bf16_t* H;
    __device__ __forceinline__ void operator()(const f32x4 (&acc)[2][2][4][2], const pg8::Unit& u, int wr, int wc, int fr, int fq) const {
        const int row0 = u.pm * 256 + wr * 64 + fr, hc = u.pn * 128 + wc * 32 + 8 * fq;
        float rsv[2][4];
#pragma unroll
        for (int ai = 0; ai < 2; ++ai)
#pragma unroll
            for (int m = 0; m < 4; ++m) rsv[ai][m] = rss[row0 + ai * 128 + m * 16];
#pragma unroll
        for (int ai = 0; ai < 2; ++ai)
#pragma unroll
            for (int m = 0; m < 4; ++m) { const int row = row0 + ai * 128 + m * 16; const float rs = rsqrtf(rsv[ai][m] * (1.0f / 1024.0f) + EPS); float o[8];
#pragma unroll
                for (int j = 0; j < 8; ++j) { const float gt = rs * acc[ai][0][m][j >> 2][j & 3], up = rs * acc[ai][1][m][j >> 2][j & 3]; o[j] = siluf_(gt) * up; }
                *(u32x4*)(H + (size_t)row * DFF + hc) = pack8(o); }
    }
};
struct EpiDown {
    static constexpr bool PERM = true, AFTER_DRAIN = false;
    float* out; int grow0; float* rss;
    __device__ __forceinline__ void operator()(const f32x4 (&acc)[2][2][4][2], const pg8::Unit& u, int wr, int wc, int fr, int fq) const {
        const int row0 = u.pm * 256 + wr * 64 + fr, col0 = u.pn * 256 + wc * 32 + 8 * fq, ln_ = fq * 16 + fr;
#pragma unroll
        for (int ai = 0; ai < 2; ++ai)
#pragma unroll
            for (int mh = 0; mh < 2; ++mh) {
                f32x4 xa[2][2][2];
#pragma unroll
                for (int mm = 0; mm < 2; ++mm) { const float* xr = out + (size_t)(grow0 + row0 + ai * 128 + (2 * mh + mm) * 16) * DM;
#pragma unroll
                    for (int bj = 0; bj < 2; ++bj) { xa[mm][bj][0] = *(const f32x4*)(xr + col0 + bj * 128); xa[mm][bj][1] = *(const f32x4*)(xr + col0 + bj * 128 + 4); } }
#pragma unroll
                for (int mm = 0; mm < 2; ++mm) { const int m = 2 * mh + mm, grow = grow0 + row0 + ai * 128 + m * 16; float* orow = out + (size_t)grow * DM; float ss = 0.f;
#pragma unroll
                    for (int bj = 0; bj < 2; ++bj) { const int c = col0 + bj * 128;
                        const f32x4 a = xa[mm][bj][0] + acc[ai][bj][m][0], b = xa[mm][bj][1] + acc[ai][bj][m][1];
                        *(f32x4*)(orow + c) = a; *(f32x4*)(orow + c + 4) = b;
                        ss += a[0] * a[0] + a[1] * a[1] + a[2] * a[2] + a[3] * a[3] + b[0] * b[0] + b[1] * b[1] + b[2] * b[2] + b[3] * b[3]; }
                    ss += shfl_idx(ss, ln_ ^ 16); ss += shfl_idx(ss, ln_ ^ 32);
                    if (fq == 0) atomicAdd(rss + grow, ss); }
            }
    }
};

__device__ __forceinline__ void transpose_tile(const float* src, int N, int k0, int n0, bf16_t* dst, int K, int mode, const float* kscale, LAS float* tl, int tid) {
    for (int i = tid; i < 1024; i += 512) { const int kk = i >> 4, n4 = (i & 15) * 4; f32x4 v = *(const f32x4*)(src + (size_t)(k0 + kk) * N + n0 + n4); if (kscale) v *= kscale[k0 + kk];
        tl[kk * 65 + n4] = v[0]; tl[kk * 65 + n4 + 1] = v[1]; tl[kk * 65 + n4 + 2] = v[2]; tl[kk * 65 + n4 + 3] = v[3]; }
    __syncthreads();
    for (int i = tid; i < 2048; i += 512) { const int nn = i >> 5, kp = i & 31; const float a = tl[(2 * kp) * 65 + nn], b = tl[(2 * kp + 1) * 65 + nn]; const int n = n0 + nn;
        const int row = mode == 0 ? n : (256 * (n >> 7) + (n & 127) + (mode == 2 ? 128 : 0));
        *(unsigned*)(dst + (size_t)row * K + k0 + 2 * kp) = cvt_pk_bf16(a, b); }
    __syncthreads();
}
__device__ __forceinline__ void phase_weights(const Params& p, LAS unsigned char* l, int tid) {
    unsigned char* ws = p.ws; LAS float* tl = (LAS float*)l;
    for (int j = blockIdx.x; j < 4304; j += gridDim.x) {
        if (j < 1552) transpose_tile(p.w_in, PC, (j / 97) * 64, (j % 97) * 64, (bf16_t*)(ws + WS_WIN), 1024, 0, nullptr, tl, tid);
        else if (j < 1680) { const int t = j - 1552; transpose_tile(p.w_br_gla, 1024, (t / 16) * 64, (t % 16) * 64, (bf16_t*)(ws + WS_WB1), 512, 0, nullptr, tl, tid); }
        else if (j < 1936) { const int t = j - 1680; transpose_tile(p.w_br_ssm, 1024, (t / 16) * 64, (t % 16) * 64, (bf16_t*)(ws + WS_WB2), 1024, 0, p.ssm_norm_w, tl, tid); }
        else if (j < 2192) { const int t = j - 1936; transpose_tile(p.w_out, 1024, (t / 16) * 64, (t % 16) * 64, (bf16_t*)(ws + WS_WOUT), 1024, 0, nullptr, tl, tid); }
        else if (j < 2896) { const int t = j - 2192; transpose_tile(p.w_ffn_gate, DFF, (t / 44) * 64, (t % 44) * 64, (bf16_t*)(ws + WS_WGU), 1024, 1, p.norm_ffn_w, tl, tid); }
        else if (j < 3600) { const int t = j - 2896; transpose_tile(p.w_ffn_up, DFF, (t / 44) * 64, (t % 44) * 64, (bf16_t*)(ws + WS_WGU), 1024, 2, p.norm_ffn_w, tl, tid); }
        else { const int t = j - 3600; transpose_tile(p.w_ffn_down, 1024, (t / 16) * 64, (t % 16) * 64, (bf16_t*)(ws + WS_WD), DFF, 0, nullptr, tl, tid); }
    }
    const int gt = blockIdx.x * 512 + tid, GT = gridDim.x * 512;
    unsigned* zw = (unsigned*)(ws + WS_WIN + (size_t)PC * 1024 * 2);
    for (int i = gt; i < 192 * 1024 / 2; i += GT) zw[i] = 0u;
    float* rs = (float*)(ws + WS_RSS1);
    for (int i = gt; i < 3 * NTOK; i += GT) rs[i] = 0.f;
}
__device__ __forceinline__ void phase_u(const Params& p, int row0, int nrows, int tid) {
    const int wave = tid >> 6, lane = tid & 63; bf16_t* U = (bf16_t*)(p.ws + WS_U);
    const int RST = gridDim.x * 8;
    for (int rb = blockIdx.x * 8 + wave; rb < nrows; rb += 2 * RST) {
        f32x4 v[2][4]; float ss[2] = {0.f, 0.f};
#pragma unroll
        for (int q = 0; q < 2; ++q) { const int r = rb + q * RST; if (r < nrows) { const float* xr = xrow(p, row0 + r);
#pragma unroll
            for (int i = 0; i < 4; ++i) v[q][i] = ((const f32x4*)xr)[lane + 64 * i]; } else {
#pragma unroll
            for (int i = 0; i < 4; ++i) v[q][i] = (f32x4){0.f, 0.f, 0.f, 0.f}; } }
        f32x4 wv[4];
#pragma unroll
        for (int i = 0; i < 4; ++i) wv[i] = ((const f32x4*)p.norm_mix_w)[lane + 64 * i];
#pragma unroll
        for (int q = 0; q < 2; ++q) {
#pragma unroll
            for (int i = 0; i < 4; ++i) ss[q] += v[q][i][0] * v[q][i][0] + v[q][i][1] * v[q][i][1] + v[q][i][2] * v[q][i][2] + v[q][i][3] * v[q][i][3];
#pragma unroll
            for (int o = 1; o < 64; o <<= 1) ss[q] += shfl_idx(ss[q], lane ^ o);
            const float rstd = rsqrtf(ss[q] * (1.0f / 1024.0f) + EPS); const int r = rb + q * RST;
            if (r < nrows) {
#pragma unroll
                for (int i = 0; i < 4; ++i) { u32x2 o; o.x = cvt_pk_bf16(v[q][i][0] * rstd * wv[i][0], v[q][i][1] * rstd * wv[i][1]); o.y = cvt_pk_bf16(v[q][i][2] * rstd * wv[i][2], v[q][i][3] * rstd * wv[i][3]);
                    *(u32x2*)(U + (size_t)r * DM + 4 * (lane + 64 * i)) = o; } }
        }
    }
}

constexpr int G_QF = 0, G_KF = 9216, G_QB = 18432, G_KB = 27648, G_V = 36864, G_ATT = 54272, G_SFT = 63488, G_SBT = 81920, G_SSQ = 100352, G_RS = 144, G_RSV = 272,
              G_UP = 101376, G_BIAS = 109568, G_KR = 110080, G_QR = 119296, G_RFB = 128512, G_RSR = 80, G_OGR = 133632, G_STG3 = 110080, G_STG1 = 63488, G_GNW = 151040;
struct GlaPF { u32x4 k, q, rf; f32x4 up, bias, gnw; unsigned short lg[16]; };
template <bool S3>
__device__ __forceinline__ void gla_pf_load(GlaPF& f, const Params& p, int item, int tid) {
    const int h = item & 3, c = (item >> 2) & 63, seq = item >> 8, r0 = seq * 4096 + c * 64;
    const bf16_t* proj = (const bf16_t*)(p.ws + WS_PROJ);
    { const int row = tid >> 3, ch = tid & 7; const bf16_t* pr = proj + (size_t)(r0 + row) * PC; f.k = *(const u32x4*)(pr + C_K + 64 * h + ch * 8); if (S3) f.q = *(const u32x4*)(pr + C_Q + 64 * h + ch * 8); }
    if (!S3) {
        if (tid < 256) { const int row = tid >> 2, ch = tid & 3; f.rf = *(const u32x4*)(proj + (size_t)(r0 + row) * PC + C_RF + ch * 8); }
        { const int dr = tid >> 8, r = (tid >> 4) & 15, d4 = tid & 15; f.up = *(const f32x4*)((dr ? p.gla_up_b : p.gla_up_f) + r * 256 + 64 * h + 4 * d4); }
        if (tid < 32) f.bias = *(const f32x4*)(((tid >> 4) ? p.gla_bias_b : p.gla_bias_f) + 64 * h + 4 * (tid & 15));
    } else {
        if (tid >= 64 && tid < 96) f.gnw = *(const f32x4*)(p.gla_norm_w + 4 * (tid - 64));
        const unsigned short* lgp = (const unsigned short*)(p.ws + WS_LG) + (size_t)item * 8192 + (size_t)((tid >> 8) * 64 + ((tid >> 6) & 3) * 16) * 64 + (tid & 63);
#pragma unroll
        for (int dd = 0; dd < 16; ++dd) f.lg[dd] = lgp[dd * 64];
    }
}
template <bool S3>
__device__ __forceinline__ void gla_pf_store(const GlaPF& f, LAS unsigned char* l, int tid) {
    { const int row = tid >> 3, ch = tid & 7; *(LAS u32x4*)(l + G_KR + row * G_RS + ch * 16) = f.k; if (S3) *(LAS u32x4*)(l + G_QR + row * G_RS + ch * 16) = f.q; }
    if (!S3) {
        if (tid < 256) { const int row = tid >> 2, ch = tid & 3; *(LAS u32x4*)(l + G_RFB + row * G_RSR + ch * 16) = f.rf; }
        *(LAS f32x4*)(l + G_UP + tid * 16) = f.up;
        if (tid < 32) *(LAS f32x4*)(l + G_BIAS + tid * 16) = f.bias;
    } else if (tid >= 64 && tid < 96) *(LAS f32x4*)(l + G_GNW + (tid - 64) * 16) = f.gnw;
}
#define LBAR() do { asm volatile("s_waitcnt lgkmcnt(0)" ::: "memory"); __builtin_amdgcn_s_barrier(); asm volatile("" ::: "memory"); } while (0)
template <bool S3>
__device__ __forceinline__ void gla_prep(LAS unsigned char* l, int lane, int w, int h, float* gdec_out, const GlaPF& pf, unsigned short* lgbuf) {
    const int dir = w >> 2, dq = w & 3;
    float rv[16];
    if (!S3) { const LAS unsigned char* rp = l + G_RFB + lane * G_RSR + 32 * dir; unpack8(*(const LAS u32x4*)rp, rv); unpack8(*(const LAS u32x4*)(rp + 16), rv + 8); }
    const LAS float* UPL = (const LAS float*)(l + G_UP) + dir * 1024; const LAS float* BIASL = (const LAS float*)(l + G_BIAS) + dir * 64;
#pragma unroll
    for (int grp = 0; grp < 4; ++grp) {
        float lgv[4];
        if (!S3) {
            f32x4 z4 = *(const LAS f32x4*)(BIASL + 16 * dq + 4 * grp);
#pragma unroll
            for (int r = 0; r < 16; ++r) z4 += rv[r] * *(const LAS f32x4*)(UPL + r * 64 + 16 * dq + 4 * grp);
#pragma unroll
            for (int q = 0; q < 4; ++q) { lgv[q] = -(fmaxf(-z4[q], 0.f) + __logf(1.0f + __expf(-fabsf(z4[q])))) * 0.0625f;
                lgbuf[(size_t)(dir * 64 + 16 * dq + 4 * grp + q) * 64 + lane] = __builtin_bit_cast(unsigned short, (_Float16)lgv[q]); }
        } else {
#pragma unroll
            for (int q = 0; q < 4; ++q) lgv[q] = (float)__builtin_bit_cast(_Float16, pf.lg[4 * grp + q]);
        }
        __builtin_amdgcn_sched_barrier(0);
        const u32x2 kraw = *(const LAS u32x2*)(l + G_KR + lane * G_RS + 32 * dq + 8 * grp);
        const float kv[4] = {bflo(kraw.x), bfhi(kraw.x), bflo(kraw.y), bfhi(kraw.y)};
        float qv[4] = {0.f, 0.f, 0.f, 0.f};
        if (S3) { const u32x2 qraw = *(const LAS u32x2*)(l + G_QR + lane * G_RS + 32 * dq + 8 * grp); qv[0] = bflo(qraw.x); qv[1] = bfhi(qraw.x); qv[2] = bflo(qraw.y); qv[3] = bfhi(qraw.y); }
        float qd[4], kd[4];
#pragma unroll
        for (int q = 0; q < 4; ++q) {
            const int d = 16 * dq + 4 * grp + q;
            const float lg = lgv[q];
            float tot;
            const float incl = wave_incl_scan_tot(lg, lane, tot);
            const float G = dir ? (tot - incl + lg) : incl;
            if (!S3) {
                const float kp = kv[q] * __expf(tot - G);
                *(LAS bf16_t*)(l + G_QF + (dir * 64 + d) * G_RS + lane * 2) = f2bf(kp);
                if (lane == 0) gdec_out[dir * 256 + h * 64 + d] = __expf(tot);
            } else {
                qd[q] = qv[q] * 0.125f * __expf(G); kd[q] = kv[q] * __expf(-G);
            }
        }
        if (S3) {
            u32x2 qo, ko; qo.x = cvt_pk_bf16(qd[0], qd[1]); qo.y = cvt_pk_bf16(qd[2], qd[3]); ko.x = cvt_pk_bf16(kd[0], kd[1]); ko.y = cvt_pk_bf16(kd[2], kd[3]);
            *(LAS u32x2*)(l + (dir ? G_QB : G_QF) + lane * G_RS + 32 * dq + 8 * grp) = qo;
            *(LAS u32x2*)(l + (dir ? G_KB : G_KF) + lane * G_RS + 32 * dq + 8 * grp) = ko;
        }
        __builtin_amdgcn_sched_barrier(0);
    }
}
__device__ __forceinline__ void gla_s1_item(const Params& p, int item, int next_item, GlaPF& pf, LAS unsigned char* l, unsigned lbase, int tid) {
    const int lane = tid & 63, w = __builtin_amdgcn_readfirstlane(tid >> 6);
    const int h = item & 3, c = (item >> 2) & 63, seq = item >> 8, r0 = seq * 4096 + c * 64;
    const bf16_t* proj = (const bf16_t*)(p.ws + WS_PROJ);
    float* gdec = (float*)(p.ws + WS_GDEC) + (size_t)((seq * 64 + c) * 2) * 256;
    gla_pf_store<false>(pf, l, tid);
    u32x4 vr[2];
#pragma unroll
    for (int k = 0; k < 2; ++k) { const int i = tid + 512 * k, row = i >> 4, ch = i & 15; vr[k] = *(const u32x4*)(proj + (size_t)(r0 + row) * PC + C_V + 128 * h + ch * 8); }
    LBAR();
    gla_prep<false>(l, lane, w, h, gdec, pf, (unsigned short*)(p.ws + WS_LG) + (size_t)item * 8192);
#pragma unroll
    for (int k = 0; k < 2; ++k) { const int i = tid + 512 * k, row = i >> 4, ch = i & 15; *(LAS u32x4*)(l + G_V + row * G_RSV + ch * 16) = vr[k]; }
    if (next_item >= 0) gla_pf_load<false>(pf, p, next_item, tid);
    LBAR();
    const int dir = w >> 2, dvb0 = (w & 3) * 2, g = lane >> 4, ln = lane & 15;
    LAS unsigned char* stg = l + G_STG1 + w * 4608;
#pragma unroll
    for (int i = 0; i < 2; ++i) {
        bf16x8 A[2];
#pragma unroll
        for (int ks = 0; ks < 2; ++ks) A[ks] = frag_tr(lbase + G_V, G_RSV, 32 * ks, 16 * (dvb0 + i), lane);
#pragma unroll
        for (int n = 0; n < 4; ++n) { f32x4 acc = {0.f, 0.f, 0.f, 0.f};
#pragma unroll
            for (int ks = 0; ks < 2; ++ks) acc = MFMA16(A[ks], frag_row(l + G_QF + dir * 64 * G_RS, G_RS, 16 * n, 32 * ks, lane), acc);
#pragma unroll
            for (int r = 0; r < 4; ++r) *(LAS bf16_t*)(stg + (16 * i + 4 * g + r) * G_RS + (16 * n + ln) * 2) = f2bf(acc[r]); }
    }
    asm volatile("" ::: "memory");
    bf16_t* GS = (bf16_t*)(p.ws + WS_GS) + ((size_t)(((seq * 64 + c) * 2 + dir) * 4 + h)) * 8192 + (size_t)dvb0 * 16 * 64;
#pragma unroll
    for (int k = 0; k < 4; ++k) { const int i = lane + 64 * k, row = i >> 3, ch = i & 7; *(u32x4*)(GS + row * 64 + ch * 8) = *(const LAS u32x4*)(stg + row * G_RS + ch * 16); }
    LBAR();
}
__device__ __forceinline__ void gla_s3_item(const Params& p, int item, int next_item, GlaPF& pf, LAS unsigned char* l, unsigned lbase, int tid) {
    const int lane = tid & 63, w = __builtin_amdgcn_readfirstlane(tid >> 6);
    const int h = item & 3, c = (item >> 2) & 63, seq = item >> 8, r0 = seq * 4096 + c * 64;
    const bf16_t* proj = (const bf16_t*)(p.ws + WS_PROJ);
    gla_pf_store<true>(pf, l, tid);
    u32x4 vr[2], ogr[2], str[4];
    const bf16_t* GSb = (const bf16_t*)(p.ws + WS_GS);
#pragma unroll
    for (int k = 0; k < 2; ++k) { const int i = tid + 512 * k, row = i >> 4, ch = i & 15; const bf16_t* pr = proj + (size_t)(r0 + row) * PC;
        vr[k] = *(const u32x4*)(pr + C_V + 128 * h + ch * 8); ogr[k] = *(const u32x4*)(pr + C_OG + 128 * h + ch * 8); }
#pragma unroll
    for (int k = 0; k < 4; ++k) { const int i = tid + 512 * k, dir = i >> 10, row = (i >> 3) & 127, ch = i & 7;
        str[k] = *(const u32x4*)(GSb + ((size_t)(((seq * 64 + c) * 2 + dir) * 4 + h)) * 8192 + row * 64 + ch * 8); }
    const int g = lane >> 4, ln = lane & 15, tb = w >> 1, dvh = w & 1;
    LBAR();
    gla_prep<true>(l, lane, w, h, nullptr, pf, nullptr);
#pragma unroll
    for (int k = 0; k < 2; ++k) { const int i = tid + 512 * k, row = i >> 4, ch = i & 15; *(LAS u32x4*)(l + G_V + row * G_RSV + ch * 16) = vr[k]; *(LAS u32x4*)(l + G_OGR + row * G_RSV + ch * 16) = ogr[k]; }
#pragma unroll
    for (int k = 0; k < 4; ++k) { const int i = tid + 512 * k, dir = i >> 10, row = (i >> 3) & 127, ch = i & 7; *(LAS u32x4*)(l + (dir ? G_SBT : G_SFT) + row * G_RS + ch * 16) = str[k]; }
    if (next_item >= 0) gla_pf_load<true>(pf, p, next_item, tid);
    LBAR();
    {
        const int ti = w >> 1;
#pragma unroll
        for (int k = 0; k < 2; ++k) { const int si = 2 * (w & 1) + k; f32x4 af = {0.f, 0.f, 0.f, 0.f}, ab = {0.f, 0.f, 0.f, 0.f};
            if (ti >= si) {
#pragma unroll
                for (int ks = 0; ks < 2; ++ks) af = MFMA16(frag_row(l + G_QF, G_RS, 16 * ti, 32 * ks, lane), frag_row(l + G_KF, G_RS, 16 * si, 32 * ks, lane), af); }
            if (ti <= si) {
#pragma unroll
                for (int ks = 0; ks < 2; ++ks) ab = MFMA16(frag_row(l + G_QB, G_RS, 16 * ti, 32 * ks, lane), frag_row(l + G_KB, G_RS, 16 * si, 32 * ks, lane), ab); }
#pragma unroll
            for (int r = 0; r < 4; ++r) { const int t = 16 * ti + 4 * g + r, s = 16 * si + ln; *(LAS bf16_t*)(l + G_ATT + t * G_RS + s * 2) = f2bf(s <= t ? af[r] : ab[r]); }
        }
    }
    LBAR();
    f32x4 acc[4];
#pragma unroll
    for (int i = 0; i < 4; ++i) acc[i] = (f32x4){0.f, 0.f, 0.f, 0.f};
#pragma unroll
    for (int ks = 0; ks < 2; ++ks) {
        const bf16x8 a_att = frag_row(l + G_ATT, G_RS, 16 * tb, 32 * ks, lane), a_qf = frag_row(l + G_QF, G_RS, 16 * tb, 32 * ks, lane), a_qb = frag_row(l + G_QB, G_RS, 16 * tb, 32 * ks, lane);
        bf16x8 vb[4]; frag_tr4(vb, lbase + G_V, G_RSV, 32 * ks, 64 * dvh, 16, lane);
#pragma unroll
        for (int i = 0; i < 4; ++i) { const int dvb = dvh * 4 + i;
            acc[i] = MFMA16(a_att, vb[i], acc[i]);
            acc[i] = MFMA16(a_qf, frag_row(l + G_SFT, G_RS, 16 * dvb, 32 * ks, lane), acc[i]);
            acc[i] = MFMA16(a_qb, frag_row(l + G_SBT, G_RS, 16 * dvb, 32 * ks, lane), acc[i]); }
    }
#pragma unroll
    for (int r = 0; r < 4; ++r) { float s = 0.f;
#pragma unroll
        for (int i = 0; i < 4; ++i) s += acc[i][r] * acc[i][r];
        s += shfl_idx(s, lane ^ 1); s += shfl_idx(s, lane ^ 2); s += shfl_idx(s, lane ^ 4); s += shfl_idx(s, lane ^ 8);
        if (ln == 0) *(LAS float*)(l + G_SSQ + ((16 * tb + 4 * g + r) * 2 + dvh) * 4) = s; }
    LBAR();
    LAS unsigned char* stg = l + G_STG3 + w * 2304;
#pragma unroll
    for (int r = 0; r < 4; ++r) { const int t = 16 * tb + 4 * g + r; const LAS float* sp = (const LAS float*)(l + G_SSQ + t * 8);
        const float rstd = rsqrtf((sp[0] + sp[1]) * (1.0f / 128.0f) + EPS);
#pragma unroll
        for (int i = 0; i < 4; ++i) { const int dvl = 16 * i + ln; const float og = bf2f(*(const LAS bf16_t*)(l + G_OGR + t * G_RSV + (64 * dvh + dvl) * 2));
            *(LAS bf16_t*)(stg + (4 * g + r) * G_RS + dvl * 2) = f2bf(acc[i][r] * rstd * ((const LAS float*)(l + G_GNW))[64 * dvh + dvl] * siluf_(og)); } }
    asm volatile("" ::: "memory");
    bf16_t* OG = (bf16_t*)(p.ws + WS_OG) + (size_t)(r0 + 16 * tb) * 512 + 128 * h + 64 * dvh;
#pragma unroll
    for (int k = 0; k < 2; ++k) { const int i = lane + 64 * k, row = i >> 3, ch = i & 7; *(u32x4*)(OG + (size_t)row * 512 + ch * 8) = *(const LAS u32x4*)(stg + row * G_RS + ch * 16); }
    LBAR();
}

constexpr int S_XS = 0, S_BM = 67584, S_CM = 86016, S_MB = 104448, S_DT = 139264, S_AC = 143360, S_W8 = 147456, S_RSX = 528, S_RS = 144, S_RSM = 272;
template <bool S3>
__device__ __forceinline__ void ssd_prep(const Params& p, const bf16_t* proj, int seq, int c, int gi, LAS unsigned char* l, int tid, float* sdec_out) {
    const int lane = tid & 63, w = __builtin_amdgcn_readfirstlane(tid >> 6);
    const int tok0 = c * 128; constexpr int NV = S3 ? 16 : 40, NST = S3 ? 32 : 12, TS = S3 ? 4 : 11, CV0 = S3 ? 32 : 0;
    bf16_t* XSG = (bf16_t*)(p.ws + WS_Y);
    const int dir = w >> 2, j = w & 3, hd = 4 * gi + j, r0 = seq * 4096 + tok0;
    const int dcol = (dir ? C_DTB : C_DTF) + hd;
    const float raw0 = bf2f(proj[(size_t)(r0 + lane) * PC + dcol]), raw1 = bf2f(proj[(size_t)(r0 + lane + 64) * PC + dcol]);
    const float dtb = (dir ? p.dt_bias_b : p.dt_bias_f)[hd], alog = (dir ? p.a_log_b : p.a_log_f)[hd];
    u32x4 xsr[8];
    if (S3) {
#pragma unroll
        for (int k = 0; k < 8; ++k) { const int i = tid + 512 * k, row = i >> 5, ch = i & 31; xsr[k] = *(const u32x4*)(XSG + (size_t)(r0 + row) * 1024 + 256 * gi + ch * 8); }
    }
    if (tid < NV * NST) {
        const int cv = CV0 + tid % NV, t0 = (tid / NV) * TS;
        const int col = cv < 32 ? C_XBC + 256 * gi + 8 * cv : (cv < 40 ? C_BM + 64 * gi + 8 * (cv - 32) : C_CM + 64 * gi + 8 * (cv - 40));
        const int ch = col - C_XBC;
        u32x4 raw[TS + 4];
#pragma unroll
        for (int i = 0; i < TS + 4; ++i) { const int tt = tok0 + t0 + i - 2; raw[i] = (u32x4){0u, 0u, 0u, 0u};
            if (tt >= 0 && tt < 4096 && t0 + i - 2 < 130) raw[i] = *(const u32x4*)(proj + (size_t)(seq * 4096 + tt) * PC + col); }
        typedef float f32x2 __attribute__((ext_vector_type(2)));
        f32x2 wv[5][4], bv[4];
#pragma unroll
        for (int i = 0; i < 5; ++i) { const f32x4 a = *(const f32x4*)(p.conv_w + i * 1536 + ch), b = *(const f32x4*)(p.conv_w + i * 1536 + ch + 4);
            wv[i][0] = (f32x2){a[0], a[1]}; wv[i][1] = (f32x2){a[2], a[3]}; wv[i][2] = (f32x2){b[0], b[1]}; wv[i][3] = (f32x2){b[2], b[3]}; }
        { const f32x4 a = *(const f32x4*)(p.conv_b + ch), b = *(const f32x4*)(p.conv_b + ch + 4); bv[0] = (f32x2){a[0], a[1]}; bv[1] = (f32x2){a[2], a[3]}; bv[2] = (f32x2){b[0], b[1]}; bv[3] = (f32x2){b[2], b[3]}; }
        LAS unsigned char* dst0 = cv < 32 ? l + S_XS + cv * 16 : (cv < 40 ? l + S_BM + (cv - 32) * 16 : l + S_CM + (cv - 40) * 16); const int drs = cv < 32 ? S_RSX : S_RS;
        f32x2 xw[5][4];
#pragma unroll
        for (int i = 0; i < 4; ++i) { const u32x4 rr = raw[i]; xw[i][0] = (f32x2){bflo(rr.x), bfhi(rr.x)}; xw[i][1] = (f32x2){bflo(rr.y), bfhi(rr.y)}; xw[i][2] = (f32x2){bflo(rr.z), bfhi(rr.z)}; xw[i][3] = (f32x2){bflo(rr.w), bfhi(rr.w)}; }
#pragma unroll
        for (int o = 0; o < TS; ++o) { const int t = t0 + o;
            { const u32x4 rr = raw[o + 4]; xw[4][0] = (f32x2){bflo(rr.x), bfhi(rr.x)}; xw[4][1] = (f32x2){bflo(rr.y), bfhi(rr.y)}; xw[4][2] = (f32x2){bflo(rr.z), bfhi(rr.z)}; xw[4][3] = (f32x2){bflo(rr.w), bfhi(rr.w)}; }
            if (t < 128) { u32x4 pk;
#pragma unroll
                for (int k = 0; k < 4; ++k) { f32x2 a = bv[k];
#pragma unroll
                    for (int i = 0; i < 5; ++i) a = xw[i][k] * wv[i][k] + a;
                    const unsigned pw = cvt_pk_bf16(siluf_(a[0]), siluf_(a[1])); if (k == 0) pk.x = pw; else if (k == 1) pk.y = pw; else if (k == 2) pk.z = pw; else pk.w = pw; }
                *(LAS u32x4*)(dst0 + t * drs) = pk;
                if (!S3 && cv < 32) *(u32x4*)(XSG + (size_t)(r0 + t) * 1024 + 256 * gi + 8 * cv) = pk; }
#pragma unroll
            for (int i = 0; i < 4; ++i)
#pragma unroll
                for (int k = 0; k < 4; ++k) xw[i][k] = xw[i + 1][k];
        }
    }
    if (S3) {
#pragma unroll
        for (int k = 0; k < 8; ++k) { const int i = tid + 512 * k, row = i >> 5, ch = i & 31; *(LAS u32x4*)(l + S_XS + row * S_RSX + ch * 16) = xsr[k]; }
    }
    {
        const float A = -__expf(alog);
        const float dt0 = softplusf_(raw0 + dtb), dt1 = softplusf_(raw1 + dtb);
        const float la0 = dt0 * A, la1 = dt1 * A;
        float tot0, tot1; const float s0 = wave_incl_scan_tot(la0, lane, tot0), s1 = wave_incl_scan_tot(la1, lane, tot1); const float total = tot0 + tot1;
        float ac0, ac1;
        if (dir == 0) { ac0 = s0; ac1 = tot0 + s1; } else { ac0 = total - (s0 - la0); ac1 = total - (tot0 + s1 - la1); }
        LAS float* DT = (LAS float*)(l + S_DT) + (dir * 4 + j) * 128; LAS float* AC = (LAS float*)(l + S_AC) + (dir * 4 + j) * 128;
        DT[lane] = dt0; DT[lane + 64] = dt1; AC[lane] = ac0; AC[lane + 64] = ac1;
        if (!S3) { LAS float* W8 = (LAS float*)(l + S_W8) + (dir * 4 + j) * 128; W8[lane] = dt0 * __expf(total - ac0); W8[lane + 64] = dt1 * __expf(total - ac1);
            if (lane == 0) sdec_out[dir * 16 + hd] = __expf(total); }
    }
}
__device__ __forceinline__ void ssd_s1_item(const Params& p, int item, LAS unsigned char* l, unsigned lbase, int tid) {
    const int lane = tid & 63, w = __builtin_amdgcn_readfirstlane(tid >> 6);
    const int gi = item & 3, c = (item >> 2) & 31, seq = item >> 7;
    const bf16_t* proj = (const bf16_t*)(p.ws + WS_PROJ);
    float* sdec = (float*)(p.ws + WS_SDEC) + (size_t)((seq * 32 + c) * 2) * 16;
    ssd_prep<false>(p, proj, seq, c, gi, l, tid, sdec);
    __syncthreads();
    const int dir = w >> 2, j = w & 3, hd = 4 * gi + j, g = lane >> 4, ln = lane & 15;
    f32x4 acc[4][4];
#pragma unroll
    for (int a = 0; a < 4; ++a)
#pragma unroll
        for (int b = 0; b < 4; ++b) acc[a][b] = (f32x4){0.f, 0.f, 0.f, 0.f};
#pragma unroll
    for (int ks = 0; ks < 4; ++ks) {
        bf16x8 A[4], B[4], Braw[4];
        frag_tr4(A, lbase + S_XS, S_RSX, 32 * ks, 64 * j, 16, lane);
        frag_tr4(Braw, lbase + S_BM, S_RS, 32 * ks, 0, 16, lane);
        const LAS float* wp = (const LAS float*)(l + S_W8) + (dir * 4 + j) * 128 + 32 * ks + 8 * g;
        const f32x4 w0 = *(const LAS f32x4*)wp, w1 = *(const LAS f32x4*)(wp + 4);
#pragma unroll
        for (int ni = 0; ni < 4; ++ni) { const bf16x8 b = Braw[ni]; float o[8];
#pragma unroll
            for (int jj = 0; jj < 8; ++jj) o[jj] = bf2f((unsigned short)b[jj]) * (jj < 4 ? w0[jj & 3] : w1[jj & 3]);
            const u32x4 pk = pack8(o); B[ni] = __builtin_bit_cast(bf16x8, pk); }
#pragma unroll
        for (int pi = 0; pi < 4; ++pi)
#pragma unroll
            for (int ni = 0; ni < 4; ++ni) acc[pi][ni] = MFMA16(A[pi], B[ni], acc[pi][ni]);
    }
    __syncthreads();
    LAS unsigned char* stg = l + S_XS + w * 9216;
#pragma unroll
    for (int pi = 0; pi < 4; ++pi)
#pragma unroll
        for (int ni = 0; ni < 4; ++ni)
#pragma unroll
            for (int r = 0; r < 4; ++r) *(LAS bf16_t*)(stg + (16 * pi + 4 * g + r) * S_RS + (16 * ni + ln) * 2) = f2bf(acc[pi][ni][r]);
    asm volatile("" ::: "memory");
    bf16_t* SS = (bf16_t*)(p.ws + WS_SS) + ((size_t)(((seq * 32 + c) * 2 + dir) * 16 + hd)) * 4096;
#pragma unroll
    for (int k = 0; k < 8; ++k) { const int i = lane + 64 * k, row = i >> 3, ch = i & 7; *(u32x4*)(SS + row * 64 + ch * 8) = *(const LAS u32x4*)(stg + row * S_RS + ch * 16); }
    __syncthreads();
}
__device__ __forceinline__ void ssd_s3_item(const Params& p, int row0, int item, LAS unsigned char* l, unsigned lbase, int tid) {
    const int lane = tid & 63, w = __builtin_amdgcn_readfirstlane(tid >> 6);
    const int gi = item & 3, c = (item >> 2) & 31, seq = item >> 7, r0 = seq * 4096 + c * 128;
    const bf16_t* proj = (const bf16_t*)(p.ws + WS_PROJ);
    const bf16_t* SSb = (const bf16_t*)(p.ws + WS_SS);
    const int sdir = tid >> 8, si_ = tid & 255, srow0 = si_ >> 3, sch = si_ & 7;
    const bf16_t* sp0 = SSb + ((size_t)(((seq * 32 + c) * 2 + sdir) * 16 + 4 * gi)) * 4096 + srow0 * 64 + sch * 8;
    u32x4 sa = *(const u32x4*)sp0, sb = *(const u32x4*)(sp0 + 32 * 64);
    ssd_prep<true>(p, proj, seq, c, gi, l, tid, nullptr);
    __syncthreads();
    const int g = lane >> 4, ln = lane & 15;
    f32x4 cb[8];
#pragma unroll
    for (int si = 0; si < 8; ++si) { cb[si] = (f32x4){0.f, 0.f, 0.f, 0.f};
#pragma unroll
        for (int ks = 0; ks < 2; ++ks) cb[si] = MFMA16(frag_row(l + S_CM, S_RS, 16 * w, 32 * ks, lane), frag_row(l + S_BM, S_RS, 16 * si, 32 * ks, lane), cb[si]); }
    __syncthreads();
    bf16_t* Y = (bf16_t*)(p.ws + WS_Y);
    const int erow = lane >> 2, epc = lane & 3;
    float ssq = 0.f;
    for (int j = 0; j < 4; ++j) {
        const int hd = 4 * gi + j;
        *(LAS u32x4*)(l + S_BM + sdir * 9216 + srow0 * S_RS + sch * 16) = sa; *(LAS u32x4*)(l + S_BM + sdir * 9216 + (srow0 + 32) * S_RS + sch * 16) = sb;
        if (j < 3) { sa = *(const u32x4*)(sp0 + (size_t)(j + 1) * 4096); sb = *(const u32x4*)(sp0 + (size_t)(j + 1) * 4096 + 32 * 64); }
        const bf16_t* zp = proj + (size_t)(r0 + 16 * w + erow) * PC + C_Z + 64 * hd + 16 * epc;
        const u32x4 z0 = *(const u32x4*)zp, z1 = *(const u32x4*)(zp + 8);
        const LAS float* DTf = (const LAS float*)(l + S_DT) + j * 128; const LAS float* DTb = DTf + 512;
        const LAS float* ACf = (const LAS float*)(l + S_AC) + j * 128; const LAS float* ACb = ACf + 512;
        const float dsk = p.d_skip[hd];
        const float Rf = ACf[16 * w], Rb = ACb[16 * w + 15];
        const float Ef = __expf(Rf), Eb = __expf(Rb);
        float rowf[4], rowb[4];
#pragma unroll
        for (int r = 0; r < 4; ++r) { const int lr = 16 * w + 4 * g + r; rowf[r] = __expf(ACf[lr] - Rf); rowb[r] = __expf(ACb[lr] - Rb); }
#pragma unroll
        for (int si = 0; si < 8; ++si) { const int s = 16 * si + ln;
            if (si < w) {
                const float colf = __expf(Rf - ACf[s]) * DTf[s];
#pragma unroll
                for (int r = 0; r < 4; ++r) { const int lr = 16 * w + 4 * g + r; *(LAS bf16_t*)(l + S_MB + lr * S_RSM + s * 2) = f2bf(cb[si][r] * rowf[r] * colf); } }
            else if (si > w) {
                const float colb = __expf(Rb - ACb[s]) * DTb[s];
#pragma unroll
                for (int r = 0; r < 4; ++r) { const int lr = 16 * w + 4 * g + r; *(LAS bf16_t*)(l + S_MB + lr * S_RSM + s * 2) = f2bf(cb[si][r] * rowb[r] * colb); } }
            else { const float afs = ACf[s], abs_ = ACb[s], dfs = DTf[s], dbs = DTb[s];
#pragma unroll
                for (int r = 0; r < 4; ++r) { const int lr = 16 * w + 4 * g + r; const bool fw = (s <= lr);
                    const float wt = __expf(fw ? ACf[lr] - afs : ACb[lr] - abs_) * (fw ? dfs : dbs);
                    const float v = cb[si][r] * wt + (s == lr ? dsk : 0.f);
                    *(LAS bf16_t*)(l + S_MB + lr * S_RSM + s * 2) = f2bf(v); } } }
        __syncthreads();
        f32x4 ay[4], af[4], ab[4];
#pragma unroll
        for (int pi = 0; pi < 4; ++pi) { ay[pi] = (f32x4){0.f, 0.f, 0.f, 0.f}; af[pi] = ay[pi]; ab[pi] = ay[pi]; }
#pragma unroll
        for (int ks = 0; ks < 4; ++ks) { const bf16x8 am = frag_row(l + S_MB, S_RSM, 16 * w, 32 * ks, lane); bf16x8 xb[4]; frag_tr4(xb, lbase + S_XS, S_RSX, 32 * ks, 64 * j, 16, lane);
#pragma unroll
            for (int pi = 0; pi < 4; ++pi) ay[pi] = MFMA16(am, xb[pi], ay[pi]); }
#pragma unroll
        for (int ks = 0; ks < 2; ++ks) { const bf16x8 ac = frag_row(l + S_CM, S_RS, 16 * w, 32 * ks, lane);
#pragma unroll
            for (int pi = 0; pi < 4; ++pi) { af[pi] = MFMA16(ac, frag_row(l + S_BM, S_RS, 16 * pi, 32 * ks, lane), af[pi]);
                ab[pi] = MFMA16(ac, frag_row(l + S_BM + 9216, S_RS, 16 * pi, 32 * ks, lane), ab[pi]); } }
#pragma unroll
        for (int r = 0; r < 4; ++r) { const int lr = 16 * w + 4 * g + r; const float ef = rowf[r] * Ef, eb = rowb[r] * Eb;
#pragma unroll
            for (int pi = 0; pi < 4; ++pi) *(LAS float*)(l + S_MB + lr * S_RSM + (16 * pi + ln) * 4) = ay[pi][r] + ef * af[pi][r] + eb * ab[pi][r]; }
        asm volatile("" ::: "memory");
        {   float zv[16], yv[16];
            unpack8(z0, zv); unpack8(z1, zv + 8);
            const LAS unsigned char* yp = l + S_MB + (16 * w + erow) * S_RSM + epc * 64;
#pragma unroll
            for (int q = 0; q < 4; ++q) { const f32x4 t4 = *(const LAS f32x4*)(yp + 16 * q); yv[4 * q] = t4[0]; yv[4 * q + 1] = t4[1]; yv[4 * q + 2] = t4[2]; yv[4 * q + 3] = t4[3]; }
#pragma unroll
            for (int q = 0; q < 16; ++q) { yv[q] *= siluf_(zv[q]); ssq += yv[q] * yv[q]; }
            bf16_t* yo = Y + (size_t)(r0 + 16 * w + erow) * 1024 + 64 * hd + 16 * epc;
            *(u32x4*)yo = pack8(yv); *(u32x4*)(yo + 8) = pack8(yv + 8); }
        __syncthreads();
    }
    float* rssy = (float*)(p.ws + WS_RSSY) + (size_t)row0;
    ssq += shfl_idx(ssq, lane ^ 1); ssq += shfl_idx(ssq, lane ^ 2);
    if (epc == 0) atomicAdd(rssy + r0 + 16 * w + erow, ssq);
}

template <bool GLA>
__device__ __forceinline__ void scan_job(bf16_t* base, const float* dec, int dir) {
    constexpr int NCH = GLA ? 64 : 32; constexpr size_t CST = GLA ? 65536 : 131072; constexpr int DST = GLA ? 512 : 32; constexpr int UN = 4;
    float run[8];
#pragma unroll
    for (int e = 0; e < 8; ++e) run[e] = 0.f;
    const long long cstep = dir ? -(long long)CST : (long long)CST; const int dstep = dir ? -DST : DST;
    bf16_t* bp = base + (dir ? (size_t)(NCH - 1) * CST : 0); const float* dp = dec + (dir ? (NCH - 1) * DST : 0);
    for (int c0 = 0; c0 < NCH; c0 += UN) {
        u32x4 loc[UN]; f32x4 d0[UN], d1[UN];
#pragma unroll
        for (int u = 0; u < UN; ++u) { loc[u] = *(const u32x4*)(bp + u * cstep);
            if (GLA) { d0[u] = *(const f32x4*)(dp + u * dstep); d1[u] = *(const f32x4*)(dp + u * dstep + 4); } else { const float dv = dp[u * dstep]; d0[u] = (f32x4){dv, dv, dv, dv}; d1[u] = d0[u]; } }
#pragma unroll
        for (int u = 0; u < UN; ++u) { float lv[8]; unpack8(loc[u], lv);
            *(u32x4*)(bp + u * cstep) = pack8(run);
#pragma unroll
            for (int e = 0; e < 8; ++e) run[e] = (e < 4 ? d0[u][e & 3] : d1[u][e & 3]) * run[e] + lv[e]; }
        bp += UN * cstep; dp += UN * dstep;
    }
}
__device__ __forceinline__ void phase_scan(const Params& p, int nseq, int tid) {
    const int NG = nseq * 8192, NS = nseq * 16384;
    const int gt = blockIdx.x * 512 + tid, GT = gridDim.x * 512;
    for (int job = gt; job < NG + NS; job += GT) {
        if (job < NG) { const int e8 = job & 1023, h = (job >> 10) & 3, dir = (job >> 12) & 1, seq = job >> 13;
            scan_job<true>((bf16_t*)(p.ws + WS_GS) + ((size_t)((seq * 64 * 2 + dir) * 4 + h)) * 8192 + e8 * 8, (const float*)(p.ws + WS_GDEC) + (size_t)((seq * 64 * 2 + dir) * 4 + h) * 64 + ((e8 * 8) & 63), dir);
        } else { const int j2 = job - NG, e8 = j2 & 511, hd = (j2 >> 9) & 15, dir = (j2 >> 13) & 1, seq = j2 >> 14;
            scan_job<false>((bf16_t*)(p.ws + WS_SS) + ((size_t)((seq * 32 * 2 + dir) * 16 + hd)) * 4096 + e8 * 8, (const float*)(p.ws + WS_SDEC) + (size_t)((seq * 32 * 2 + dir) * 16 + hd), dir); }
    }
}

constexpr int LDS_BYTES = 160 * 1024;
#if defined(__HIP_DEVICE_COMPILE__)
typedef const __attribute__((address_space(4))) Params* KP;
#define KPARAMS() ({ unsigned long long k_ = (unsigned long long)__builtin_amdgcn_kernarg_segment_ptr(); asm volatile("" : "+s"(k_)); *(KP)k_; })
#define KWS() ({ unsigned long long k_ = (unsigned long long)__builtin_amdgcn_kernarg_segment_ptr(); asm volatile("" : "+s"(k_)); (unsigned char*)*(const __attribute__((address_space(4))) unsigned long long*)(k_ + 26 * 8); })
#else
#define KPARAMS() (p_unused)
#define KWS() (p_unused.ws)
#endif
#define GBAR() do { XcdBarrier b_; b_.bar = (unsigned*)(KWS() + WS_BAR); b_.x = xb_xcc_id(); b_.st = (volatile LAS unsigned*)(l + LDS_BYTES - 16); xcd_barrier(b_); } while (0)
#define OTID() ({ int t_ = threadIdx.x; asm volatile("" : "+v"(t_)); t_; })

template <int hb>
__device__ __forceinline__ void half_pass(const Params& p_unused, LAS unsigned char* l, const unsigned lbase, cg::grid_group& grid, const int G, const int bx) {
        constexpr int ROW0 = PASS_ROW0[hb], NR = PASS_ROWS[hb], NSQ = PASS_SEQ[hb], NSSD = NSQ * 128, NIT = NSQ * 384;
        { const Params q = KPARAMS(); phase_u(q, ROW0, NR, OTID()); }
        if (hb == 0) grid.sync(); else GBAR();
        {
            const Params q = KPARAMS(); unsigned char* ws = q.ws; bf16_t* PROJ = (bf16_t*)(ws + WS_PROJ);
            pg8::Gemm g{(const bf16_t*)(ws + WS_U), (const bf16_t*)(ws + WS_WIN), NR, 6400, 1024}; pg8::StaticOrder S; S.init(NR, 6400, G, bx);
            EpiProj E{PROJ}; pg8::gemm_phase<EpiProj, pg8::StaticOrder, true, true>(l, g, S, E);
        }
        GBAR();
        {   GlaPF pf; const int itg0 = bx + ((NSSD - bx + G - 1) / G) * G;
            if (itg0 < NIT) { const Params p = KPARAMS(); gla_pf_load<false>(pf, p, itg0 - NSSD, OTID()); }
            for (int it = bx; it < NIT; it += G) { const Params p = KPARAMS(); const int tid = OTID(); if (it < NSSD) ssd_s1_item(p, it, l, lbase, tid); else gla_s1_item(p, it - NSSD, it + G < NIT ? it + G - NSSD : -1, pf, l, lbase, tid); }
        }
        GBAR();
        { const Params q = KPARAMS(); phase_scan(q, NSQ, OTID()); }
        GBAR();
        {   GlaPF pf; const int itg0 = bx + ((NSSD - bx + G - 1) / G) * G;
            if (itg0 < NIT) { const Params p = KPARAMS(); gla_pf_load<true>(pf, p, itg0 - NSSD, OTID()); }
            for (int it = bx; it < NIT; it += G) { const Params p = KPARAMS(); const int tid = OTID(); if (it < NSSD) ssd_s3_item(p, ROW0, it, l, lbase, tid); else gla_s3_item(p, it - NSSD, it + G < NIT ? it + G - NSSD : -1, pf, l, lbase, tid); }
        }
        GBAR();
        {
            const Params p = KPARAMS(); unsigned char* ws = p.ws; bf16_t* PROJ = (bf16_t*)(ws + WS_PROJ);
            pg8::StaticOrder S; S.init(NR, 1024, G, bx);
            pg8::Gemm g1{(const bf16_t*)(ws + WS_OG), (const bf16_t*)(ws + WS_WB1), NR, 1024, 512};
            EpiM1 E1{PROJ, (bf16_t*)(ws + WS_T)}; pg8::gemm_phase<EpiM1, pg8::StaticOrder, true, true>(l, g1, S, E1);
            pg8::Gemm g2{(const bf16_t*)(ws + WS_Y), (const bf16_t*)(ws + WS_WB2), NR, 1024, 1024};
            EpiM2 E2{PROJ, (const bf16_t*)(ws + WS_T), (bf16_t*)(ws + WS_MM), (const float*)(ws + WS_RSSY) + (size_t)ROW0}; pg8::gemm_phase<EpiM2, pg8::StaticOrder, true, true>(l, g2, S, E2);
        }
        GBAR();
        {
            const Params p = KPARAMS(); unsigned char* ws = p.ws; bf16_t* PROJ = (bf16_t*)(ws + WS_PROJ);
            pg8::StaticOrder S; S.init(NR, 1024, G, bx);
            pg8::Gemm g{(const bf16_t*)(ws + WS_MM), (const bf16_t*)(ws + WS_WOUT), NR, 1024, 1024};
            EpiOut E{p, ROW0, (bf16_t*)(ws + WS_X1B), (float*)(ws + WS_RSS1)}; pg8::gemm_phase<EpiOut, pg8::StaticOrder, true, true>(l, g, S, E);
        }
        GBAR();
        {
            const Params p = KPARAMS(); unsigned char* ws = p.ws; bf16_t* PROJ = (bf16_t*)(ws + WS_PROJ);
            pg8::StaticOrder S; S.init(NR, 5632, G, bx);
            pg8::Gemm g{(const bf16_t*)(ws + WS_X1B), (const bf16_t*)(ws + WS_WGU), NR, 5632, 1024};
            EpiSwi E{(const float*)(ws + WS_RSS1) + (size_t)ROW0, PROJ}; pg8::gemm_phase<EpiSwi, pg8::StaticOrder, true, true>(l, g, S, E);
        }
        GBAR();
        {
            const Params p = KPARAMS(); unsigned char* ws = p.ws; bf16_t* PROJ = (bf16_t*)(ws + WS_PROJ);
            pg8::StaticOrder S; S.init(NR, 1024, G, bx);
            pg8::Gemm g{(const bf16_t*)PROJ, (const bf16_t*)(ws + WS_WD), NR, 1024, DFF};
            EpiDown E{p.out, ROW0, (float*)(ws + WS_RSS2)}; pg8::gemm_phase<EpiDown, pg8::StaticOrder, true, true>(l, g, S, E);
        }
    __syncthreads();
}

__global__ void __launch_bounds__(512) mega(Params p_unused) {
    extern __shared__ __attribute__((aligned(16))) unsigned char lds_raw[];
    cg::grid_group grid = cg::this_grid();
    LAS unsigned char* l = (LAS unsigned char*)lds_raw;
    const unsigned lbase = (unsigned)(size_t)l;
    const int G = gridDim.x, bx = blockIdx.x;
    volatile LAS unsigned* xst = (volatile LAS unsigned*)(l + LDS_BYTES - 16);
    { const int t0_ = OTID(); if (t0_ < 4) xst[t0_] = 0u; }
    __syncthreads();
    (void)xcd_barrier_post((unsigned*)(KWS() + WS_BAR), xst);
    { const Params q = KPARAMS(); phase_weights(q, l, OTID()); }
    half_pass<0>(p_unused, l, lbase, grid, G, bx);
    half_pass<1>(p_unused, l, lbase, grid, G, bx);
    GBAR();
    {
        const Params p = KPARAMS(); unsigned char* ws = p.ws; const int tid = OTID();
        const float* rss2 = (const float*)(ws + WS_RSS2);
        const size_t GT = (size_t)G * 512;
        for (size_t i0 = (size_t)bx * 512 + tid; i0 < (size_t)NTOK * 256; i0 += 4 * GT) {
            f32x4 v[4]; float rs[4];
#pragma unroll
            for (int k = 0; k < 4; ++k) { const size_t i = i0 + k * GT; if (i < (size_t)NTOK * 256) { v[k] = ((const f32x4*)p.out)[i]; rs[k] = rss2[i >> 8]; } }
#pragma unroll
            for (int k = 0; k < 4; ++k) { const size_t i = i0 + k * GT; if (i < (size_t)NTOK * 256) { const float r = rsqrtf(rs[k] * (1.0f / 1024.0f) + EPS); const f32x4 w = ((const f32x4*)p.norm_final_w)[i & 255];
                f32x4 o = v[k]; o[0] *= r * w[0]; o[1] *= r * w[1]; o[2] *= r * w[2]; o[3] *= r * w[3]; ((f32x4*)p.out)[i] = o; } }
        }
    }
}

extern "C" void kernel_launch(void* const* d_in, const int* in_sizes, int n_in, void* d_out, int out_size, void* d_ws, size_t ws_size, hipStream_t stream) {
    static int grid_blocks = 0;
    if (!grid_blocks) {
        int dev = 0, cus = 0, per_cu = 0;
        (void)hipGetDevice(&dev);
        (void)hipDeviceGetAttribute(&cus, hipDeviceAttributeMultiprocessorCount, dev);
        (void)hipFuncSetAttribute((const void*)mega, hipFuncAttributeMaxDynamicSharedMemorySize, LDS_BYTES);
        (void)hipOccupancyMaxActiveBlocksPerMultiprocessor(&per_cu, (const void*)mega, 512, LDS_BYTES);
        if (per_cu < 1) per_cu = 1;
        grid_blocks = cus * per_cu;
        if (ws_size < WS_END) fprintf(stderr, "workspace too small: %zu < %zu\n", ws_size, (size_t)WS_END);
    }
    Params p{};
    const float** pp = (const float**)&p;
    for (int i = 0; i < 25; ++i) pp[i] = (const float*)d_in[i];
    p.out = (float*)d_out; p.ws = (unsigned char*)d_ws;
    (void)hipMemsetAsync((unsigned char*)d_ws + WS_BAR, 0, (size_t)XCD_BAR_WORDS_ * 4, stream);
    void* args[] = {&p};
    hipError_t e = hipLaunchCooperativeKernel((const void*)mega, dim3(grid_blocks), dim3(512), args, LDS_BYTES, stream);
    if (e != hipSuccess) fprintf(stderr, "cooperative launch failed: %s (grid %d)\n", hipGetErrorString(e), grid_blocks);
}
```
